# Optimizing an MI355X kernel written in HIP

```python
import math
import jax, jax.numpy as jnp
from jax import lax
import numpy as np

D_MODEL = 1024
BATCH = 2
SEQ = 8192
DEPTH = 1
DEC_BATCH = 128
DEC_SEQ = 1
PAST_LEN = 16384
PAGE_SIZE = 128

HEAD_DIM = 64
N_HEADS = D_MODEL // HEAD_DIM
N_KV_HEADS = N_HEADS // 4
GROUP = N_HEADS // N_KV_HEADS
ROT_DIMS = HEAD_DIM // 4
ROPE_THETA = 500000.0
WINDOW = 128
BLOCK = 128
POOL_WIDTH = D_MODEL // 2
POOL_WINDOWS = (2, 4, 8, 16)
POOL_GROUPS = len(POOL_WINDOWS)
POOL_GC = POOL_WIDTH // POOL_GROUPS
POOL_STATE = max(POOL_WINDOWS) - 1
FFN_HIDDEN = -(-8 * D_MODEL // (3 * 256)) * 256
PLE_DIM = 256
EPS = 1e-6
NEG_INF = -1e30

Q_W = N_HEADS * HEAD_DIM
KV_W = N_KV_HEADS * HEAD_DIM
IN_COLS = POOL_WIDTH + Q_W + 2 * KV_W + 2 * D_MODEL
SPLITS = (POOL_WIDTH, POOL_WIDTH + Q_W, POOL_WIDTH + Q_W + KV_W, POOL_WIDTH + Q_W + 2 * KV_W, POOL_WIDTH + Q_W + 2 * KV_W + D_MODEL)

kernel_name = "hybrid_pool_swa_sink_decoder_step"


def _rms_norm(x, g):
    xf = x.astype(jnp.float32)
    y = xf * lax.rsqrt(jnp.mean(xf * xf, axis=-1, keepdims=True) + EPS)
    return (y * g.astype(jnp.float32)).astype(x.dtype)


def _partial_rope(x, pos):
    half = ROT_DIMS // 2
    inv = ROPE_THETA ** (-(jnp.arange(0, ROT_DIMS, 2, dtype=jnp.float32) / ROT_DIMS))
    ang = pos.astype(jnp.float32)[:, None] * inv[None, :]
    cos = jnp.cos(ang)[None, :, None, :]
    sin = jnp.sin(ang)[None, :, None, :]
    xr = x[..., :ROT_DIMS].astype(jnp.float32)
    x1, x2 = xr[..., :half], xr[..., half:]
    rot = jnp.concatenate([x1 * cos - x2 * sin, x2 * cos + x1 * sin], axis=-1)
    return jnp.concatenate([rot.astype(x.dtype), x[..., ROT_DIMS:]], axis=-1)


def _layer_inputs(h, ln1, w_in, pos):
    B, T, _ = h.shape
    z = _rms_norm(h, ln1) @ w_in
    u, q, k, v, gp, ga = jnp.split(z, SPLITS, axis=-1)
    q = _partial_rope(q.reshape(B, T, N_HEADS, HEAD_DIM), pos)
    k = _partial_rope(k.reshape(B, T, N_KV_HEADS, HEAD_DIM), pos)
    v = v.reshape(B, T, N_KV_HEADS, HEAD_DIM)
    return u, q, k, v, gp, ga


def _pool_branch(u_prev, u, pos, group_w, scale):
    T = u.shape[1]
    P = POOL_STATE
    ext = jnp.concatenate([u_prev, u], axis=1)
    extf = ext.astype(jnp.float32)
    cs = jnp.concatenate([jnp.zeros_like(extf[:, :1]), jnp.cumsum(extf, axis=1)], axis=1)
    means = []
    for g, w in enumerate(POOL_WINDOWS):
        c0, c1 = g * POOL_GC, (g + 1) * POOL_GC
        s = cs[:, P + 1:P + 1 + T, c0:c1] - cs[:, P + 1 - w:P + 1 - w + T, c0:c1]
        cnt = jnp.minimum(w, pos + 1).astype(jnp.float32)[None, :, None]
        means.append(s / cnt)
    m = (jnp.concatenate(means, axis=-1) - u.astype(jnp.float32)).astype(u.dtype)
    B = u.shape[0]
    mixed = jnp.einsum('btgc,gcd->btgd', m.reshape(B, T, POOL_GROUPS, POOL_GC), group_w)
    mixed = mixed.reshape(B, T, POOL_WIDTH) * scale
    return mixed, ext[:, -P:]


def _sink_attn(q, k, v, mask, sinks):
    s = jnp.einsum('...qkgd,...skd->...kgqs', q.astype(jnp.float32), k.astype(jnp.float32)) * (HEAD_DIM ** -0.5)
    s = jnp.where(mask, s, jnp.float32(NEG_INF))
    sink = jnp.broadcast_to(sinks.astype(jnp.float32)[:, :, None, None], s.shape[:-1] + (1,))
    pr = jax.nn.softmax(jnp.concatenate([s, sink], axis=-1), axis=-1)[..., :-1]
    o = jnp.einsum('...kgqs,...skd->...qkgd', pr, v.astype(jnp.float32))
    return o.astype(q.dtype)


def _attn_prompt(q, k, v, sinks):
    B, S = q.shape[0], q.shape[1]
    nb = S // BLOCK
    qb = q.reshape(B, nb, BLOCK, N_KV_HEADS, GROUP, HEAD_DIM)
    kb = k.reshape(B, nb, BLOCK, N_KV_HEADS, HEAD_DIM)
    vb = v.reshape(B, nb, BLOCK, N_KV_HEADS, HEAD_DIM)
    kk = jnp.concatenate([jnp.concatenate([jnp.zeros_like(kb[:, :1]), kb[:, :-1]], axis=1), kb], axis=2)
    vv = jnp.concatenate([jnp.concatenate([jnp.zeros_like(vb[:, :1]), vb[:, :-1]], axis=1), vb], axis=2)
    qi = jnp.arange(BLOCK)[:, None]
    si = jnp.arange(2 * BLOCK)[None, :]
    rel = qi + BLOCK - si
    kpos = (jnp.arange(nb)[:, None, None] - 1) * BLOCK + si[None]
    mask = (rel >= 0)[None] & (rel < WINDOW)[None] & (kpos >= 0)
    o = _sink_attn(qb, kk, vv, mask[:, None, None], sinks.reshape(N_KV_HEADS, GROUP))
    return o.reshape(B, S, Q_W)


def _attn_sample(q, k, v, cache_k, cache_v, sinks):
    Bd, T = q.shape[0], q.shape[1]
    w_cache = cache_k.shape[1]
    kk = jnp.concatenate([cache_k, k], axis=1)
    vv = jnp.concatenate([cache_v, v], axis=1)
    qpos = PAST_LEN + jnp.arange(T)
    kpos = jnp.concatenate([PAST_LEN - w_cache + jnp.arange(w_cache), qpos])
    rel = qpos[:, None] - kpos[None, :]
    mask = (rel >= 0) & (rel < WINDOW)
    o = _sink_attn(q.reshape(Bd, T, N_KV_HEADS, GROUP, HEAD_DIM), kk, vv, mask, sinks.reshape(N_KV_HEADS, GROUP))
    return o.reshape(Bd, T, Q_W), kk[:, -w_cache:], vv[:, -w_cache:]


def _layer_outputs(h, p, pooled, attn, gp, ga, w_pool_branch, w_attn_branch, w_out, ln2, w_ffn_in, w_ffn_out, w_ple_proj, ple_norm, w_ple_gate):
    merged = jax.nn.sigmoid(gp) * (pooled @ w_pool_branch) + jax.nn.sigmoid(ga) * (attn @ w_attn_branch)
    h = h + merged @ w_out
    gate, up = jnp.split(_rms_norm(h, ln2) @ w_ffn_in, 2, axis=-1)
    h = h + (jax.nn.silu(gate) * up) @ w_ffn_out
    e = _rms_norm(p @ w_ple_proj, ple_norm)
    return h + jax.nn.sigmoid(h @ w_ple_gate) * e


def setup_inputs(seed: int = 0) -> dict:
    key = jax.random.key(seed)
    ks = jax.random.split(key, 32)
    f32 = jnp.float32
    w_cache = min(WINDOW, PAST_LEN)
    nrm = lambda k, shape, s=1.0: jax.random.normal(k, shape, f32) * s
    return {
        "x_prompt": nrm(ks[0], (BATCH, SEQ, D_MODEL)),
        "x_sample": nrm(ks[1], (DEC_BATCH, DEC_SEQ, D_MODEL)),
        "p_prompt": nrm(ks[2], (DEPTH, BATCH, SEQ, PLE_DIM)),
        "p_sample": nrm(ks[3], (DEPTH, DEC_BATCH, DEC_SEQ, PLE_DIM)),
        "cache_k": nrm(ks[4], (DEPTH, DEC_BATCH, w_cache, N_KV_HEADS, HEAD_DIM)),
        "cache_v": nrm(ks[5], (DEPTH, DEC_BATCH, w_cache, N_KV_HEADS, HEAD_DIM)),
        "state_pool": nrm(ks[6], (DEPTH, DEC_BATCH, POOL_STATE, POOL_WIDTH)),
        "ln1": 1.0 + nrm(ks[7], (DEPTH, D_MODEL), 0.02),
        "w_in": nrm(ks[8], (DEPTH, D_MODEL, IN_COLS), D_MODEL ** -0.5),
        "pool_group_w": nrm(ks[9], (DEPTH, POOL_GROUPS, POOL_GC, POOL_GC), POOL_GC ** -0.5),
        "pool_scale": 1.0 + nrm(ks[10], (DEPTH, POOL_WIDTH), 0.02),
        "attn_sinks": nrm(ks[11], (DEPTH, N_HEADS), 0.5),
        "w_pool_branch": nrm(ks[12], (DEPTH, POOL_WIDTH, D_MODEL), POOL_WIDTH ** -0.5),
        "w_attn_branch": nrm(ks[13], (DEPTH, Q_W, D_MODEL), Q_W ** -0.5),
        "w_out": nrm(ks[14], (DEPTH, D_MODEL, D_MODEL), D_MODEL ** -0.5),
        "ln2": 1.0 + nrm(ks[15], (DEPTH, D_MODEL), 0.02),
        "w_ffn_in": nrm(ks[16], (DEPTH, D_MODEL, 2 * FFN_HIDDEN), D_MODEL ** -0.5),
        "w_ffn_out": nrm(ks[17], (DEPTH, FFN_HIDDEN, D_MODEL), FFN_HIDDEN ** -0.5),
        "w_ple_proj": nrm(ks[18], (DEPTH, PLE_DIM, D_MODEL), PLE_DIM ** -0.5),
        "ple_norm": 1.0 + nrm(ks[19], (DEPTH, D_MODEL), 0.02),
        "w_ple_gate": nrm(ks[20], (DEPTH, D_MODEL, D_MODEL), D_MODEL ** -0.5),
        "final_norm": 1.0 + nrm(ks[21], (D_MODEL,), 0.02),
    }


def reference(x_prompt, x_sample, p_prompt, p_sample, cache_k, cache_v, state_pool, ln1, w_in, pool_group_w, pool_scale, attn_sinks, w_pool_branch, w_attn_branch, w_out, ln2, w_ffn_in, w_ffn_out, w_ple_proj, ple_norm, w_ple_gate, final_norm):
    B, S, _ = x_prompt.shape
    T = x_sample.shape[1]
    w_cache = cache_k.shape[2]
    pos_p = jnp.arange(S, dtype=jnp.int32)
    pos_s = PAST_LEN + jnp.arange(T, dtype=jnp.int32)
    hp, hs = x_prompt, x_sample
    nkp, nvp, npp, nks, nvs, nps = [], [], [], [], [], []
    for i in range(DEPTH):
        u, q, k, v, gp, ga = _layer_inputs(hp, ln1[i], w_in[i], pos_p)
        pooled, st = _pool_branch(jnp.zeros((B, POOL_STATE, POOL_WIDTH), u.dtype), u, pos_p, pool_group_w[i], pool_scale[i])
        att = _attn_prompt(q, k, v, attn_sinks[i])
        hp = _layer_outputs(hp, p_prompt[i], pooled, att, gp, ga, w_pool_branch[i], w_attn_branch[i], w_out[i], ln2[i], w_ffn_in[i], w_ffn_out[i], w_ple_proj[i], ple_norm[i], w_ple_gate[i])
        nkp.append(k[:, -w_cache:])
        nvp.append(v[:, -w_cache:])
        npp.append(st)
        u, q, k, v, gp, ga = _layer_inputs(hs, ln1[i], w_in[i], pos_s)
        pooled, st = _pool_branch(state_pool[i], u, pos_s, pool_group_w[i], pool_scale[i])
        att, kn, vn = _attn_sample(q, k, v, cache_k[i], cache_v[i], attn_sinks[i])
        hs = _layer_outputs(hs, p_sample[i], pooled, att, gp, ga, w_pool_branch[i], w_attn_branch[i], w_out[i], ln2[i], w_ffn_in[i], w_ffn_out[i], w_ple_proj[i], ple_norm[i], w_ple_gate[i])
        nks.append(kn)
        nvs.append(vn)
        nps.append(st)
    y_prompt = _rms_norm(hp, final_norm)
    y_sample = _rms_norm(hs, final_norm)
    return (y_prompt, y_sample, jnp.stack(nkp), jnp.stack(nvp), jnp.stack(npp), jnp.stack(nks), jnp.stack(nvs), jnp.stack(nps))
```

```cpp
#include <hip/hip_runtime.h>
#include <hip/hip_cooperative_groups.h>
#include <cstdio>
#include <cstdint>
namespace cg = cooperative_groups;
namespace pg8 {
#define PG8_LAS __attribute__((address_space(3)))
typedef unsigned short bf16_t;
typedef short bf16x8 __attribute__((ext_vector_type(8)));
typedef float f32x4 __attribute__((ext_vector_type(4)));
typedef unsigned u32x4 __attribute__((ext_vector_type(4)));
constexpr int BM = 256, BK = 64, HALF = 128, HTB = HALF * BK * 2  , STAGE_BYTES = 8 * HTB, NXCD = 8, WGM = 8;

__host__ __device__ __forceinline__ int lds_byte(int r, int c) { const int st = (r >> 4) * 2 + (c >> 5), rr = r & 15, cc = c & 31, ob = rr * 64 + cc * 2; return st * 1024 + (ob ^ (((ob >> 9) & 1) << 5)); }
__host__ __device__ __forceinline__ void stage_rc(int b, int& R, int& C) { const int st = b / 1024, sb = b % 1024, swz = sb ^ (((sb >> 9) & 1) << 5); R = (st >> 1) * 16 + swz / 64; C = (st & 1) * 32 + (swz % 64) / 2; }
__host__ __device__ __forceinline__ int perm32(int rho) { const int n = rho >> 4, i = rho & 15; return 8 * (i >> 2) + 4 * n + (i & 3); }

struct Unit { int pm, pn; };
struct Gemm { const bf16_t* A; const bf16_t* Bt; int M, N, K; };

struct StaticOrder {
    int nM, nN, nwg, G, c;
    __host__ __device__ void init(int M, int N, int G_, int c_) { nM = M / BM; nN = N / BM; nwg = nM * nN; G = G_; c = c_; }
    __host__ __device__ bool next(int i, Unit& u) const {
        const long L = (long)i * G + c; if (L >= nwg) return false;
        int wgid = (int)L; { const int q = nwg / NXCD, r = nwg % NXCD, xcd = wgid % NXCD, off = wgid / NXCD; wgid = (xcd < r ? xcd * (q + 1) : r * (q + 1) + (xcd - r) * q) + off; }
        const int nig = WGM * nN, gid = wgid / nig, fm = gid * WGM, gsz = (nM - fm) < WGM ? (nM - fm) : WGM;
        u.pm = fm + ((wgid % nig) % gsz); u.pn = (wgid % nig) / gsz; return true;
    }
    __device__ __forceinline__ void a_ready(const Unit&) const {}
    __device__ __forceinline__ void done(const Unit&) const {}
};

struct TailOrder {
    int nwg, first, cnt, c;
    __host__ __device__ void init(int M, int N, int G_, int c_, int first_) { nwg = (M / BM) * (N / BM); first = first_ < G_ ? first_ : 0; cnt = G_ - first; c = c_; }
    __host__ __device__ bool next(int i, Unit& u) const {
        if (c < first) return false; const int t = (c - first) + i * cnt; if (t >= nwg) return false;
        u.pm = t >> 2; u.pn = t & 3; return true;
    }
    __device__ __forceinline__ void a_ready(const Unit&) const {}
    __device__ __forceinline__ void done(const Unit&) const {}
};

__device__ __forceinline__ unsigned cvt_pk_bf16(float lo, float hi) { unsigned r; asm volatile("s_nop 0\n\tv_cvt_pk_bf16_f32 %0, %1, %2" : "=v"(r) : "v"(lo), "v"(hi)); return r; }
typedef float f32x2_cv __attribute__((ext_vector_type(2))); typedef __bf16 bf16x2_cv __attribute__((ext_vector_type(2)));
__device__ __forceinline__ unsigned cvt_pk_bf16_v(float lo, float hi) { const f32x2_cv v = {lo, hi}; const bf16x2_cv b = __builtin_convertvector(v, bf16x2_cv); return __builtin_bit_cast(unsigned, b); }
typedef float f32x2 __attribute__((ext_vector_type(2)));

constexpr int DM = 1024, SEQ = 8192, MPR = 16384, MSM = 128, MREAL = MPR + MSM, MPAD = 16640;
constexpr int INC = 4096, FFH = 2816, PLE = 256;
constexpr float EPS = 1e-6f;
constexpr size_t O_Y = 0, O_NKP = (size_t)MREAL * DM, O_NVP = O_NKP + 65536, O_NPP = O_NVP + 65536, O_NKS = O_NPP + 15360, O_NVS = O_NKS + 4194304, O_NPS = O_NVS + 4194304, O_END = O_NPS + 983040;

typedef unsigned u32x2 __attribute__((ext_vector_type(2)));
__device__ __forceinline__ float bflo(unsigned w) { return __builtin_bit_cast(float, w << 16); }
__device__ __forceinline__ float bfhi(unsigned w) { return __builtin_bit_cast(float, w & 0xffff0000u); }
__device__ __forceinline__ u32x4 pack8(const f32x4 a, const f32x4 b) { u32x4 w; w.x = cvt_pk_bf16(a[0], a[1]); w.y = cvt_pk_bf16(a[2], a[3]); w.z = cvt_pk_bf16(b[0], b[1]); w.w = cvt_pk_bf16(b[2], b[3]); return w; }
__device__ __forceinline__ u32x4 pack8v(const f32x4 a, const f32x4 b) { u32x4 w; w.x = cvt_pk_bf16_v(a[0], a[1]); w.y = cvt_pk_bf16_v(a[2], a[3]); w.z = cvt_pk_bf16_v(b[0], b[1]); w.w = cvt_pk_bf16_v(b[2], b[3]); return w; }
__device__ __forceinline__ void unpack8(const u32x4 w, f32x4& a, f32x4& b) { a = (f32x4){bflo(w.x), bfhi(w.x), bflo(w.y), bfhi(w.y)}; b = (f32x4){bflo(w.z), bfhi(w.z), bflo(w.w), bfhi(w.w)}; }
__device__ __forceinline__ float sigm(float x) { return __builtin_amdgcn_rcpf(1.0f + __expf(-x)); }
__device__ __forceinline__ f32x4 sigm4(const f32x4 x) { return (f32x4){sigm(x[0]), sigm(x[1]), sigm(x[2]), sigm(x[3])}; }
__device__ __forceinline__ float sum4(const f32x4 x) { return (x[0] + x[1]) + (x[2] + x[3]); }
__device__ __forceinline__ float row_rs(const float* ss, int row) {
    if (row < MPR) { const f32x4* p = (const f32x4*)(ss + (size_t)row * 16); const f32x4 a = p[0], b = p[1], c = p[2], d = p[3];
        return rsqrtf(((sum4(a) + sum4(b)) + (sum4(c) + sum4(d))) * (1.0f / DM) + EPS); }
    const f32x4* p = (const f32x4*)(ss + (size_t)MPR * 16 + (size_t)(row - MPR) * 64); f32x4 t = p[0];
#pragma unroll
    for (int i = 1; i < 16; ++i) t += p[i];
    return rsqrtf(sum4(t) * (1.0f / DM) + EPS);
}
#define EPI_ROW(ai, m) (u.pm * BM + (ai) * HALF + wr * 64 + (m) * 16 + fr)
#define EPI_LOOP_AM _Pragma("unroll") for (int ai = 0; ai < 2; ++ai) _Pragma("unroll") for (int m = 0; m < 4; ++m)
#define EPI_LOOP_BJ _Pragma("unroll") for (int bj = 0; bj < 2; ++bj)

struct EpiIn {
    static constexpr bool PERM = true, AFTER_DRAIN = false;
    bf16_t *ub, *qb, *kb, *vb, *gb; float* out; const float* rope;
    __device__ __forceinline__ void operator()(const f32x4 (&acc)[2][2][4][2], const Unit& u, int wr, int wc, int fr, int fq) const {
        const int colt = u.pn * BM, cw = wc * 32 + 8 * fq;
        const bool tail = (u.pm == 31) || (u.pm == 63) || (u.pm == 64);
        EPI_LOOP_AM {
            const int row = EPI_ROW(ai, m);
            if (colt >= 2048) {
                EPI_LOOP_BJ { const int col = colt - 2048 + bj * HALF + cw; *(u32x4*)(gb + (size_t)row * 2048 + col) = pack8v(sigm4(acc[ai][bj][m][0]), sigm4(acc[ai][bj][m][1])); }
            } else if (colt < 512) {
                EPI_LOOP_BJ { const int col = colt + bj * HALF + cw; const f32x4 v0 = acc[ai][bj][m][0], v1 = acc[ai][bj][m][1];
                    *(u32x4*)(ub + (size_t)row * 512 + col) = pack8(v0, v1);
                    if (tail) { float* dst = nullptr;
                        if (row >= MPR) { if (row < MREAL) dst = out + O_NPS + ((size_t)(row - MPR) * 15 + 14) * 512 + col; }
                        else { const int t = row & (SEQ - 1); if (t >= SEQ - 15) dst = out + O_NPP + ((size_t)(row >> 13) * 15 + (t - (SEQ - 15))) * 512 + col; }
                        if (dst) { *(f32x4*)dst = v0; *(f32x4*)(dst + 4) = v1; } } }
            } else if (colt < 1792) {
                const bool isq = colt < 1536;
                const int pidx = row < MPR ? (row & (SEQ - 1)) : SEQ;
                EPI_LOOP_BJ { f32x4 v0 = acc[ai][bj][m][0], v1 = acc[ai][bj][m][1];
                    if ((wc & 1) == 0) {
                        f32x4 p0, p1;
#pragma unroll
                        for (int j = 0; j < 4; ++j) { p0[j] = __shfl_xor(v0[j], 16); p1[j] = __shfl_xor(v1[j], 16); }
                        if (fq < 2) { const f32x4* rp = (const f32x4*)(rope + (size_t)pidx * 16); const f32x4 c0 = rp[0], c1 = rp[1]; f32x4 s0 = rp[2], s1 = rp[3];
                            if (fq == 0) { s0 = -s0; s1 = -s1; }
                            v0 = v0 * c0 + p0 * s0; v1 = v1 * c1 + p1 * s1; }
                    }
                    if (isq) { v0 = v0 * 0.125f; v1 = v1 * 0.125f; *(u32x4*)(qb + (size_t)row * 1024 + (colt - 512) + bj * HALF + cw) = pack8(v0, v1); }
                    else { const int col = bj * HALF + cw; *(u32x4*)(kb + (size_t)row * 256 + col) = pack8(v0, v1);
                        if (tail) { float* dst = nullptr;
                            if (row >= MPR) { if (row < MREAL) dst = out + O_NKS + ((size_t)(row - MPR) * 128 + 127) * 256 + col; }
                            else { const int t = row & (SEQ - 1); if (t >= SEQ - 128) dst = out + O_NKP + ((size_t)(row >> 13) * 128 + (t - (SEQ - 128))) * 256 + col; }
                            if (dst) { *(f32x4*)dst = v0; *(f32x4*)(dst + 4) = v1; } } } }
            } else {
                EPI_LOOP_BJ { const int col = bj * HALF + cw; const f32x4 v0 = acc[ai][bj][m][0], v1 = acc[ai][bj][m][1];
                    *(u32x4*)(vb + (size_t)row * 256 + col) = pack8(v0, v1);
                    if (tail) { float* dst = nullptr;
                        if (row >= MPR) { if (row < MREAL) dst = out + O_NVS + ((size_t)(row - MPR) * 128 + 127) * 256 + col; }
                        else { const int t = row & (SEQ - 1); if (t >= SEQ - 128) dst = out + O_NVP + ((size_t)(row >> 13) * 128 + (t - (SEQ - 128))) * 256 + col; }
                        if (dst) { *(f32x4*)dst = v0; *(f32x4*)(dst + 4) = v1; } } }
            }
        }
    }
};
struct EpiMergeA {
    static constexpr bool PERM = true, AFTER_DRAIN = false;
    bf16_t* mg; const bf16_t* gb;
    __device__ __forceinline__ void operator()(const f32x4 (&acc)[2][2][4][2], const Unit& u, int wr, int wc, int fr, int fq) const {
        const int cw = u.pn * BM + wc * 32 + 8 * fq;
        EPI_LOOP_AM { const int row = EPI_ROW(ai, m);
            EPI_LOOP_BJ { const int col = cw + bj * HALF; f32x4 g0, g1; unpack8(*(const u32x4*)(gb + (size_t)row * 2048 + col), g0, g1);
                *(u32x4*)(mg + (size_t)row * DM + col) = pack8(g0 * acc[ai][bj][m][0], g1 * acc[ai][bj][m][1]); } }
    }
};
struct EpiMergeB {
    static constexpr bool PERM = true, AFTER_DRAIN = false;
    bf16_t* mg; const bf16_t* gb;
    __device__ __forceinline__ void operator()(const f32x4 (&acc)[2][2][4][2], const Unit& u, int wr, int wc, int fr, int fq) const {
        const int cw = u.pn * BM + wc * 32 + 8 * fq;
        EPI_LOOP_AM { const int row = EPI_ROW(ai, m);
            EPI_LOOP_BJ { const int col = cw + bj * HALF; f32x4 g0, g1, t0, t1; unpack8(*(const u32x4*)(gb + (size_t)row * 2048 + 1024 + col), g0, g1);
                unpack8(*(const u32x4*)(mg + (size_t)row * DM + col), t0, t1);
                *(u32x4*)(mg + (size_t)row * DM + col) = pack8(t0 + g0 * acc[ai][bj][m][0], t1 + g1 * acc[ai][bj][m][1]); } }
    }
};
struct EpiRes1 {
    static constexpr bool PERM = true, AFTER_DRAIN = false;
    const float *xp; bf16_t* hb; float* ss;
    __device__ __forceinline__ void operator()(const f32x4 (&acc)[2][2][4][2], const Unit& u, int wr, int wc, int fr, int fq) const {
        const int cw = u.pn * BM + wc * 32 + 8 * fq;
        EPI_LOOP_AM { const int row = EPI_ROW(ai, m); const float* xr = xp + (size_t)row * DM; float q = 0.f;
            EPI_LOOP_BJ { const int col = cw + bj * HALF; const f32x4 v0 = acc[ai][bj][m][0] + *(const f32x4*)(xr + col), v1 = acc[ai][bj][m][1] + *(const f32x4*)(xr + col + 4);
                q += sum4(v0 * v0) + sum4(v1 * v1);
                *(u32x4*)(hb + (size_t)row * DM + col) = pack8(v0, v1); }
            q += __shfl_xor(q, 16); q += __shfl_xor(q, 32);
            if (fq == 0) ss[(size_t)row * 16 + u.pn * 4 + wc] = q; }
    }
};
struct EpiSwiglu {
    static constexpr bool PERM = true, AFTER_DRAIN = false;
    bf16_t* act; const float* ss;
    __device__ __forceinline__ void operator()(const f32x4 (&acc)[2][2][4][2], const Unit& u, int wr, int wc, int fr, int fq) const {
        const int cw = u.pn * 128 + wc * 16 + 4 * fq;
        EPI_LOOP_AM { const int row = EPI_ROW(ai, m); const float rs = row_rs(ss, row);
            EPI_LOOP_BJ { const f32x4 g = acc[ai][bj][m][0] * rs, up = acc[ai][bj][m][1] * rs; const f32x4 a = g * sigm4(g) * up;
                u32x2 w; w.x = cvt_pk_bf16(a[0], a[1]); w.y = cvt_pk_bf16(a[2], a[3]);
                *(u32x2*)(act + (size_t)row * FFH + cw + bj * 64) = w; } }
    }
};
struct EpiRes2 {
    static constexpr bool PERM = true, AFTER_DRAIN = false;
    bf16_t* hb;
    __device__ __forceinline__ void operator()(const f32x4 (&acc)[2][2][4][2], const Unit& u, int wr, int wc, int fr, int fq) const {
        const int cw = u.pn * BM + wc * 32 + 8 * fq;
        EPI_LOOP_AM { const int row = EPI_ROW(ai, m);
            EPI_LOOP_BJ { bf16_t* hp = hb + (size_t)row * DM + cw + bj * HALF; f32x4 h0, h1; unpack8(*(const u32x4*)hp, h0, h1);
                *(u32x4*)hp = pack8(h0 + acc[ai][bj][m][0], h1 + acc[ai][bj][m][1]); } }
    }
};
struct EpiEraw {
    static constexpr bool PERM = true, AFTER_DRAIN = false;
    bf16_t* er; float* ss;
    __device__ __forceinline__ void operator()(const f32x4 (&acc)[2][2][4][2], const Unit& u, int wr, int wc, int fr, int fq) const {
        const int cw = u.pn * BM + wc * 32 + 8 * fq;
        EPI_LOOP_AM { const int row = EPI_ROW(ai, m); float q = 0.f;
            EPI_LOOP_BJ { const int col = cw + bj * HALF; const f32x4 v0 = acc[ai][bj][m][0], v1 = acc[ai][bj][m][1];
                q += sum4(v0 * v0) + sum4(v1 * v1); *(u32x4*)(er + (size_t)row * DM + col) = pack8(v0, v1); }
            q += __shfl_xor(q, 16); q += __shfl_xor(q, 32);
            if (fq == 0) ss[(size_t)row * 16 + u.pn * 4 + wc] = q; }
    }
};
struct EpiPle {
    static constexpr bool PERM = true, AFTER_DRAIN = false;
    bf16_t* ob; const bf16_t* hb; const bf16_t* er; const float *sse, *pn; float* sso;
    __device__ __forceinline__ void operator()(const f32x4 (&acc)[2][2][4][2], const Unit& u, int wr, int wc, int fr, int fq) const {
        const int cw = u.pn * BM + wc * 32 + 8 * fq;
        EPI_LOOP_AM { const int row = EPI_ROW(ai, m); const float rs = row_rs(sse, row); float q = 0.f;
            EPI_LOOP_BJ { const int col = cw + bj * HALF; f32x4 e0, e1, h0, h1; unpack8(*(const u32x4*)(er + (size_t)row * DM + col), e0, e1); unpack8(*(const u32x4*)(hb + (size_t)row * DM + col), h0, h1);
                const f32x4 n0 = *(const f32x4*)(pn + col), n1 = *(const f32x4*)(pn + col + 4);
                const f32x4 v0 = h0 + sigm4(acc[ai][bj][m][0]) * (e0 * rs * n0), v1 = h1 + sigm4(acc[ai][bj][m][1]) * (e1 * rs * n1);
                *(u32x4*)(ob + (size_t)row * DM + col) = pack8(v0, v1);
                q += sum4(v0 * v0) + sum4(v1 * v1); }
            q += __shfl_xor(q, 16); q += __shfl_xor(q, 32);
            if (fq == 0) sso[(size_t)row * 16 + u.pn * 4 + wc] = q; }
    }
};
template <class Epi, class Sched, bool ALIGN_EPI = false, bool SP2 = false, int KC = 0>
__device__ __forceinline__ void gemm_phase(PG8_LAS unsigned char* lds, const Gemm g, const Sched& S, const Epi& E, const int wave_s) {
    int lane_ = (int)__builtin_amdgcn_mbcnt_hi(~0u, __builtin_amdgcn_mbcnt_lo(~0u, 0u)); asm volatile("" : "+v"(lane_));
    const int wid = wave_s, lane = lane_, tid = wid * 64 + lane, wr = wid >> 2, wc = wid & 3, fr = lane & 15, fq = lane >> 4;
    const int K = KC > 0 ? KC : g.K, nt = K / BK;
    unsigned voffA[2], voffB[2];
#pragma unroll
    for (int i = 0; i < 2; ++i) { int R, C; stage_rc(tid * 16 + i * 8192, R, C); const int Rb = Epi::PERM ? ((R & ~31) + perm32(R & 31)) : R;
        voffA[i] = (unsigned)(R * K + C) * 2u; voffB[i] = (unsigned)(Rb * K + C) * 2u; }
    const size_t kstep = (size_t)(BK * 2);
    const size_t hstep = (size_t)HALF * K * 2;
    const size_t tstep = 2 * hstep;
    const unsigned ldsw = (unsigned)wid * 1024u;
    const int aoff = lds_byte(wr * 64 + fr, fq * 8), boff = lds_byte(wc * 32 + fr, fq * 8);
#define PG8_SA(b, h) (((b) * 2 + (h)) * HTB)
#define PG8_SB(b, h) ((4 + (b) * 2 + (h)) * HTB)
#define PG8_STAGE(bufoff, gbase, voff) do { _Pragma("unroll") for (int _i = 0; _i < 2; ++_i) \
        __builtin_amdgcn_global_load_lds((const unsigned*)((const char*)(gbase) + (voff)[_i]), (PG8_LAS unsigned*)(lds + (bufoff) + ldsw + _i * 8192), 16, 0, 0); } while (0)
#define PG8_LDA(dst, b, h) do { _Pragma("unroll") for (int m = 0; m < 4; ++m) _Pragma("unroll") for (int k = 0; k < 2; ++k) dst[m][k] = *(const PG8_LAS bf16x8*)(lds + PG8_SA(b, h) + aoff + m * 2048 + k * 1024); } while (0)
#define PG8_LDB(dst, b, h) do { _Pragma("unroll") for (int n = 0; n < 2; ++n) _Pragma("unroll") for (int k = 0; k < 2; ++k) dst[n][k] = *(const PG8_LAS bf16x8*)(lds + PG8_SB(b, h) + boff + n * 2048 + k * 1024); } while (0)
#define PG8_MMA(ai, bj, At, Bt) do { __builtin_amdgcn_s_setprio(1); _Pragma("unroll") for (int m = 0; m < 4; ++m) _Pragma("unroll") for (int n = 0; n < 2; ++n) _Pragma("unroll") for (int k = 0; k < 2; ++k) \
        acc[ai][bj][m][n] = __builtin_amdgcn_mfma_f32_16x16x32_bf16(Bt[n][k], At[m][k], acc[ai][bj][m][n], 0, 0, 0); __builtin_amdgcn_s_setprio(0); } while (0)
#define PG8_WAIT_V(n) asm volatile("s_waitcnt vmcnt(" #n ")" ::: "memory")
#define PG8_WAIT_L(n) asm volatile("s_waitcnt lgkmcnt(" #n ")" ::: "memory")
#define PG8_BAR __builtin_amdgcn_s_barrier()
#define PG8_SCHED __builtin_amdgcn_sched_barrier(0)
    Unit cur, nxt; int ui = 0;
    if (!S.next(0, cur)) return;
    f32x4 acc[2][2][4][2];
#pragma unroll
    for (int a = 0; a < 2; ++a)
#pragma unroll
        for (int b = 0; b < 2; ++b)
#pragma unroll
            for (int m = 0; m < 4; ++m)
#pragma unroll
                for (int n = 0; n < 2; ++n) acc[a][b][m][n] = (f32x4){0.f, 0.f, 0.f, 0.f};
    bf16x8 At[4][2], B0[2][2], B1[2][2];
    const char* cA = (const char*)g.A + (size_t)cur.pm * tstep; const char* cB = (const char*)g.Bt + (size_t)cur.pn * tstep;
    S.a_ready(cur);
    if constexpr (SP2) {
        PG8_STAGE(PG8_SB(0, 0), cB, voffB); PG8_STAGE(PG8_SB(0, 1), cB + hstep, voffB); PG8_STAGE(PG8_SA(0, 0), cA, voffA); PG8_STAGE(PG8_SA(0, 1), cA + hstep, voffA);
        if (wr == 1) PG8_BAR;
        PG8_WAIT_V(2); PG8_BAR;
        PG8_STAGE(PG8_SB(1, 0), cB + kstep, voffB); PG8_STAGE(PG8_SA(1, 0), cA + kstep, voffA); PG8_STAGE(PG8_SB(1, 1), cB + hstep + kstep, voffB);
        PG8_WAIT_V(6); PG8_BAR;
    } else {
        PG8_STAGE(PG8_SB(0, 0), cB, voffB); PG8_STAGE(PG8_SA(0, 0), cA, voffA); PG8_STAGE(PG8_SB(0, 1), cB + hstep, voffB); PG8_STAGE(PG8_SA(0, 1), cA + hstep, voffA);
        if (wr == 1) PG8_BAR;
        PG8_WAIT_V(4); PG8_BAR;
        PG8_STAGE(PG8_SB(1, 0), cB + kstep, voffB); PG8_STAGE(PG8_SA(1, 0), cA + kstep, voffA); PG8_STAGE(PG8_SB(1, 1), cB + hstep + kstep, voffB);
        PG8_WAIT_V(6); PG8_BAR;
    }
    for (;;) {
        const bool has_next = S.next(ui + 1, nxt);
        const char* nA = has_next ? (const char*)g.A + (size_t)nxt.pm * tstep : cA; const char* nB = has_next ? (const char*)g.Bt + (size_t)nxt.pn * tstep : cB;
        for (int t = 0; t < nt; t += 2) {
            const bool last = (t == nt - 2);
            const char* a1 = cA + (size_t)(t + 1) * kstep;
            const char* a2 = last ? nA : cA + (size_t)(t + 2) * kstep; const char* b2 = last ? nB : cB + (size_t)(t + 2) * kstep;
            const char* a3 = a2 + kstep; const char* b3 = b2 + kstep;
            if (last && has_next) S.a_ready(nxt);
            if constexpr (SP2) {
            PG8_LDB(B0, 0, 0); PG8_LDB(B1, 0, 1); PG8_SCHED; PG8_LDA(At, 0, 0); PG8_STAGE(PG8_SA(1, 1), a1 + hstep, voffA);
            PG8_WAIT_V(8); PG8_WAIT_L(0); PG8_BAR; PG8_MMA(0, 0, At, B0); PG8_MMA(0, 1, At, B1); PG8_BAR; PG8_SCHED;
            PG8_LDA(At, 0, 1); PG8_STAGE(PG8_SB(0, 0), b2, voffB); PG8_STAGE(PG8_SB(0, 1), b2 + hstep, voffB); PG8_STAGE(PG8_SA(0, 0), a2, voffA);
            PG8_WAIT_V(8); PG8_WAIT_L(0); PG8_BAR; PG8_MMA(1, 0, At, B0); PG8_MMA(1, 1, At, B1); PG8_BAR; PG8_SCHED;
            PG8_LDB(B0, 1, 0); PG8_LDB(B1, 1, 1); PG8_SCHED; PG8_LDA(At, 1, 0); PG8_STAGE(PG8_SA(0, 1), a2 + hstep, voffA);
            PG8_WAIT_V(8); PG8_WAIT_L(0); PG8_BAR; PG8_MMA(0, 0, At, B0); PG8_MMA(0, 1, At, B1); PG8_BAR; PG8_SCHED;
            PG8_LDA(At, 1, 1); PG8_STAGE(PG8_SB(1, 0), b3, voffB); PG8_STAGE(PG8_SB(1, 1), b3 + hstep, voffB); PG8_STAGE(PG8_SA(1, 0), a3, voffA);
            PG8_WAIT_V(8); PG8_WAIT_L(0); PG8_BAR; PG8_MMA(1, 0, At, B0); PG8_MMA(1, 1, At, B1); PG8_BAR; PG8_SCHED;
            } else {
            PG8_LDB(B0, 0, 0); PG8_SCHED; PG8_LDA(At, 0, 0); PG8_STAGE(PG8_SA(1, 1), a1 + hstep, voffA);
            PG8_WAIT_L(8); PG8_BAR; PG8_WAIT_L(0); PG8_MMA(0, 0, At, B0); PG8_BAR; PG8_SCHED;
            PG8_LDB(B1, 0, 1); PG8_STAGE(PG8_SB(0, 0), b2, voffB);
            PG8_BAR; PG8_WAIT_L(0); PG8_MMA(0, 1, At, B1); PG8_BAR;
            PG8_LDA(At, 0, 1); PG8_STAGE(PG8_SA(0, 0), a2, voffA);
            PG8_BAR; PG8_WAIT_L(0); PG8_MMA(1, 0, At, B0); PG8_BAR; PG8_SCHED;
            PG8_STAGE(PG8_SB(0, 1), b2 + hstep, voffB);
            PG8_WAIT_V(6); PG8_BAR; PG8_MMA(1, 1, At, B1); PG8_BAR;
            PG8_LDB(B0, 1, 0); PG8_SCHED; PG8_LDA(At, 1, 0); PG8_STAGE(PG8_SA(0, 1), a2 + hstep, voffA);
            PG8_WAIT_L(8); PG8_BAR; PG8_WAIT_L(0); PG8_MMA(0, 0, At, B0); PG8_BAR; PG8_SCHED;
            PG8_LDB(B1, 1, 1); PG8_STAGE(PG8_SB(1, 0), b3, voffB);
            PG8_BAR; PG8_WAIT_L(0); PG8_MMA(0, 1, At, B1); PG8_BAR;
            PG8_LDA(At, 1, 1); PG8_STAGE(PG8_SA(1, 0), a3, voffA);
            PG8_BAR; PG8_WAIT_L(0); PG8_MMA(1, 0, At, B0); PG8_BAR; PG8_SCHED;
            PG8_STAGE(PG8_SB(1, 1), b3 + hstep, voffB);
            PG8_WAIT_V(6); PG8_BAR; PG8_MMA(1, 1, At, B1); PG8_BAR;
            }
        }
        if constexpr (ALIGN_EPI) { if (wr == 0) PG8_BAR; }
        if constexpr (!Epi::AFTER_DRAIN) { E(acc, cur, wr, wc, fr, fq); S.done(cur); }
        if (!has_next) break;
#pragma unroll
        for (int a = 0; a < 2; ++a)
#pragma unroll
            for (int b = 0; b < 2; ++b)
#pragma unroll
                for (int m = 0; m < 4; ++m)
#pragma unroll
                    for (int n = 0; n < 2; ++n) acc[a][b][m][n] = (f32x4){0.f, 0.f, 0.f, 0.f};
        cur = nxt; cA = nA; cB = nB; ++ui;
        if constexpr (ALIGN_EPI) { if (wr == 1) PG8_BAR; }
    }
    PG8_WAIT_V(0);
    if constexpr (!ALIGN_EPI) { if (wr == 0) PG8_BAR; }
    PG8_BAR;
    if constexpr (Epi::AFTER_DRAIN) { E.fused(acc, cur, wr, wc, fr, fq, lds, wid, lane); S.done(cur); }
#undef PG8_SA
#undef PG8_SB
#undef PG8_STAGE
#undef PG8_LDA
#undef PG8_LDB
#undef PG8_MMA
#undef PG8_WAIT_V
#undef PG8_WAIT_L
#undef PG8_BAR
#undef PG8_SCHED
}
}

using namespace pg8;
#define LAS __attribute__((address_space(3)))
typedef short s16x4 __attribute__((ext_vector_type(4)));
#ifndef N_LAUNCH
#define N_LAUNCH 1
#endif
constexpr int NPHASE = 9;
constexpr int LDS_BYTES = 135168;
constexpr size_t MiB = 1u << 20;
constexpr size_t WS_SS2 = 0, WS_SSE = 1310720, WS_SSO = 2621440, WS_ROPE = 3932160;
constexpr size_t WS_WIN = 6 * MiB, WS_WEFF = 14 * MiB, WS_WAB = 15 * MiB, WS_WOUT = 17 * MiB, WS_WFI = 19 * MiB, WS_WFO = 30 * MiB, WS_WPP = 35 * MiB + 524288, WS_WPG = 36 * MiB;
constexpr size_t WS_PB = 38 * MiB;
constexpr size_t WS_RA = 47 * MiB;
constexpr size_t WS_RG = 80 * MiB;
constexpr size_t WS_UB = 145 * MiB, WS_QB = 161 * MiB + 262144, WS_KB = 193 * MiB + 786432, WS_VB = 201 * MiB + 917504, WS_MB = 210 * MiB;
constexpr size_t WS_MG = WS_QB;
constexpr size_t WS_ACT = 145 * MiB;
constexpr size_t WS_END = 256 * MiB;
static_assert(WS_UB + (size_t)MPAD * 512 * 2 == WS_QB && WS_QB + (size_t)MPAD * 1024 * 2 == WS_KB && WS_KB + (size_t)MPAD * 256 * 2 == WS_VB && WS_VB + (size_t)MPAD * 256 * 2 == WS_MB, "ws map");
static_assert(WS_MB + (size_t)MPAD * 512 * 2 <= WS_END && WS_ACT + (size_t)MPAD * FFH * 2 <= WS_END && WS_RA + (size_t)MPAD * 2048 <= WS_RG && WS_RG + (size_t)MPAD * 4096 <= WS_UB && WS_PB + (size_t)MPAD * 512 <= WS_RA, "ws map 2");
static_assert(WS_ROPE + 8193 * 64 <= WS_WIN && (size_t)MPAD * 64 <= WS_SSE, "ws map 3");

__device__ const float ROPE_INV[8] = {1.0f, 0.19392274474868576f, 0.03760603093086393f, 0.007292664737217109f, 0.001414213562373095f, 0.0002742481756762073f, 5.318295896944988e-05f, 1.031338537721246e-05f};

__device__ __forceinline__ unsigned f2bf(float f) { unsigned u = __builtin_bit_cast(unsigned, f); return (u + 0x7fffu + ((u >> 16) & 1u)) >> 16; }
__device__ __forceinline__ unsigned pk2(float lo, float hi) { return f2bf(lo) | (f2bf(hi) << 16); }
__device__ __forceinline__ float wave_sum(float v) {
#pragma unroll
    for (int o = 1; o < 64; o <<= 1) v += __shfl_xor(v, o);
    return v;
}
__device__ __forceinline__ float wave_max(float v) {
#pragma unroll
    for (int o = 1; o < 64; o <<= 1) v = fmaxf(v, __shfl_xor(v, o));
    return v;
}
#define LDS_WAIT() asm volatile("s_waitcnt lgkmcnt(0)" ::: "memory")

struct Args { const float* in[22]; float* out; unsigned char* ws; int ph_lo, ph_hi; };
typedef const float* cfp_t;
__device__ __forceinline__ cfp_t karg_in(int k) { const __attribute__((address_space(4))) char* kp = (const __attribute__((address_space(4))) char*)__builtin_amdgcn_kernarg_segment_ptr(); return *(const volatile __attribute__((address_space(4))) cfp_t*)(kp + 8 * k); }
__device__ __forceinline__ float* karg_out() { return (float*)karg_in(22); }
__device__ __forceinline__ unsigned char* karg_ws() { return (unsigned char*)karg_in(23); }
struct TItem { const float* W; bf16_t* WT; int K, N, mode, r; };
__device__ __forceinline__ TItem p0_item(unsigned char* ws, int it) {
    constexpr int I_IN = 16 * 128, I_AB = 16 * 32, I_OUT = 16 * 32, I_FI = 16 * 176, I_FO = 44 * 32, I_PP = 4 * 32;
    int r = it;
    if (r < I_IN) return TItem{karg_in(8), (bf16_t*)(ws + WS_WIN), 1024, INC, 0, r}; r -= I_IN;
    if (r < I_AB) return TItem{karg_in(13), (bf16_t*)(ws + WS_WAB), 1024, 1024, 0, r}; r -= I_AB;
    if (r < I_OUT) return TItem{karg_in(14), (bf16_t*)(ws + WS_WOUT), 1024, 1024, 0, r}; r -= I_OUT;
    if (r < I_FI) return TItem{karg_in(16), (bf16_t*)(ws + WS_WFI), 1024, 2 * FFH, 1, r}; r -= I_FI;
    if (r < I_FO) return TItem{karg_in(17), (bf16_t*)(ws + WS_WFO), FFH, 1024, 0, r}; r -= I_FO;
    if (r < I_PP) return TItem{karg_in(18), (bf16_t*)(ws + WS_WPP), PLE, 1024, 0, r}; r -= I_PP;
    return TItem{karg_in(20), (bf16_t*)(ws + WS_WPG), 1024, 1024, 0, r};
}
__device__ __forceinline__ void p0_item_load(const TItem& t, float (&wv)[32], int lane) {
    const int nblk = t.N / 32, kb = t.r / nblk, nb = t.r % nblk, k0 = 64 * kb, n0 = 32 * nb;
#pragma unroll
    for (int i = 0; i < 32; ++i) wv[i] = t.W[(size_t)(k0 + 2 * i + (lane >> 5)) * t.N + n0 + (lane & 31)];
}
__device__ __forceinline__ void p0_item_finish(const TItem& t, const float (&wv)[32], LAS float* scr, int lane, const float* kscale) {
    const int nblk = t.N / 32, kb = t.r / nblk, nb = t.r % nblk, k0 = 64 * kb, n0 = 32 * nb;
    if (t.mode == 1) {
#pragma unroll
        for (int i = 0; i < 32; ++i) scr[(2 * i + (lane >> 5)) * 33 + (lane & 31)] = wv[i] * kscale[k0 + 2 * i + (lane >> 5)];
    } else {
#pragma unroll
        for (int i = 0; i < 32; ++i) scr[(2 * i + (lane >> 5)) * 33 + (lane & 31)] = wv[i];
    }
    LDS_WAIT();
    const int c = lane & 7;
#pragma unroll
    for (int j = 0; j < 4; ++j) { const int n = (lane >> 3) + 8 * j; const LAS float* s = scr + (8 * c) * 33 + n;
        u32x4 o; o.x = pk2(s[0 * 33], s[1 * 33]); o.y = pk2(s[2 * 33], s[3 * 33]); o.z = pk2(s[4 * 33], s[5 * 33]); o.w = pk2(s[6 * 33], s[7 * 33]);
        int nn = n0 + n;
        if (t.mode == 1) { const int up = nn >= FFH ? 1 : 0; const int jj = nn - up * FFH; nn = 8 * (jj >> 2) + 4 * up + (jj & 3); }
        *(u32x4*)(t.WT + (size_t)nn * t.K + k0 + 8 * c) = o; }
    LDS_WAIT();
}
__device__ __forceinline__ void rms_row_to_bf16(const float* xrow, const float* gamma, bf16_t* orow, int lane) {
    const f32x4* xr = (const f32x4*)xrow + lane; f32x4 v[4]; float s = 0.f;
#pragma unroll
    for (int j = 0; j < 4; ++j) { v[j] = xr[64 * j]; s += sum4(v[j] * v[j]); }
    const float rs = rsqrtf(wave_sum(s) * (1.0f / DM) + EPS);
    u32x2* o8 = (u32x2*)orow + lane;
#pragma unroll
    for (int j = 0; j < 4; ++j) { const f32x4 g = ((const f32x4*)gamma)[lane + 64 * j]; const f32x4 y = v[j] * rs * g; u32x2 w; w.x = pk2(y[0], y[1]); w.y = pk2(y[2], y[3]); o8[64 * j] = w; }
}


template <int PART>
__device__ __forceinline__ void p0_prologue(LAS unsigned char* lds, int tid, int wave, int lane, int cidx, int cnum) {
    unsigned char* ws = karg_ws(); float* const aout = karg_out(); (void)aout;
    LAS float* scr = (LAS float*)(lds + wave * 16384);
    const int gw = cidx * 8 + wave, NGW = cnum * 8;
    const int gt = cidx * 512 + tid, NGT = cnum * 512;
    constexpr int I_IN = 16 * 128, I_AB = 16 * 32, I_OUT = 16 * 32, I_FI = 16 * 176, I_FO = 44 * 32, I_PP = 4 * 32, I_PG = 16 * 32;
    constexpr int NITEMS = I_IN + I_AB + I_OUT + I_FI + I_FO + I_PP + I_PG;
    {
        const int it_end = (PART == 0 ? I_IN : NITEMS); int it = (PART == 0 ? gw : I_IN + gw); const float* const ln2_ = karg_in(15);
        if (it < it_end) {
            TItem cur = p0_item(ws, it); float wv[32]; p0_item_load(cur, wv, lane);
            for (;;) {
                const int nx = it + NGW; const bool more = nx < it_end; TItem nxt = cur; float wn[32];
                if (more) { nxt = p0_item(ws, nx); p0_item_load(nxt, wn, lane); }
                p0_item_finish(cur, wv, scr, lane, ln2_);
                if (!more) break;
                cur = nxt; it = nx;
#pragma unroll
                for (int i = 0; i < 32; ++i) wv[i] = wn[i];
            }
        }
    }
    if (PART == 1) {
        const float* gwt = karg_in(9); const float* sc = karg_in(10); const float* wpb = karg_in(12); bf16_t* weff = (bf16_t*)(ws + WS_WEFF);
        const int fr = lane & 15, fq = lane >> 4;
        for (int t = gw; t < 4 * 8 * 64; t += NGW) {
            const int nt = t & 63, kt = (t >> 6) & 7, g = t >> 9;
            const float* ga = gwt + (size_t)(g * 128 + kt * 16 + fr) * 128 + fq * 8;
            const float* wb = wpb + (size_t)(g * 128 + fq * 8) * 1024 + nt * 16 + fr;
            const float* sg = sc + g * 128 + fq * 8;
            f32x4 a0[4], a1[4]; float bv[4][8], sv[4][8];
#pragma unroll
            for (int cs = 0; cs < 4; ++cs) { a0[cs] = *(const f32x4*)(ga + cs * 32); a1[cs] = *(const f32x4*)(ga + cs * 32 + 4);
#pragma unroll
                for (int e = 0; e < 8; ++e) { bv[cs][e] = wb[(size_t)(cs * 32 + e) * 1024]; sv[cs][e] = sg[cs * 32 + e]; } }
            f32x4 acc = {0.f, 0.f, 0.f, 0.f};
#pragma unroll
            for (int cs = 0; cs < 4; ++cs) {
                u32x4 aw; aw.x = pk2(a0[cs][0], a0[cs][1]); aw.y = pk2(a0[cs][2], a0[cs][3]); aw.z = pk2(a1[cs][0], a1[cs][1]); aw.w = pk2(a1[cs][2], a1[cs][3]);
                u32x4 bw; bw.x = pk2(bv[cs][0] * sv[cs][0], bv[cs][1] * sv[cs][1]); bw.y = pk2(bv[cs][2] * sv[cs][2], bv[cs][3] * sv[cs][3]); bw.z = pk2(bv[cs][4] * sv[cs][4], bv[cs][5] * sv[cs][5]); bw.w = pk2(bv[cs][6] * sv[cs][6], bv[cs][7] * sv[cs][7]);
                acc = __builtin_amdgcn_mfma_f32_16x16x32_bf16(__builtin_bit_cast(bf16x8, aw), __builtin_bit_cast(bf16x8, bw), acc, 0, 0, 0); }
            u32x2 o; o.x = pk2(acc[0], acc[1]); o.y = pk2(acc[2], acc[3]);
            *(u32x2*)(weff + (size_t)(nt * 16 + fr) * 512 + g * 128 + kt * 16 + 4 * fq) = o;
        }
    }
    if (PART == 0) { const float* const xp_ = karg_in(0); const float* const xs_ = karg_in(1); const float* const ln1_ = karg_in(7);
    for (int m = gw * 2; m < MREAL; m += NGW * 2) {
        const int m1 = m + 1;
        const f32x4* x0 = (const f32x4*)(m < MPR ? xp_ + (size_t)m * DM : xs_ + (size_t)(m - MPR) * DM) + lane;
        const f32x4* x1 = (const f32x4*)(m1 < MPR ? xp_ + (size_t)m1 * DM : xs_ + (size_t)(m1 - MPR) * DM) + lane;
        f32x4 v0[4], v1[4]; float s0 = 0.f, s1 = 0.f;
#pragma unroll
        for (int j = 0; j < 4; ++j) { v0[j] = x0[64 * j]; v1[j] = x1[64 * j]; }
#pragma unroll
        for (int j = 0; j < 4; ++j) { s0 += sum4(v0[j] * v0[j]); s1 += sum4(v1[j] * v1[j]); }
        const float r0 = rsqrtf(wave_sum(s0) * (1.0f / DM) + EPS), r1 = rsqrtf(wave_sum(s1) * (1.0f / DM) + EPS);
        u32x2* o0 = (u32x2*)((bf16_t*)(ws + WS_RA) + (size_t)m * DM) + lane; u32x2* o1 = (u32x2*)((bf16_t*)(ws + WS_RA) + (size_t)m1 * DM) + lane;
#pragma unroll
        for (int j = 0; j < 4; ++j) { const f32x4 g = ((const f32x4*)ln1_)[lane + 64 * j]; const f32x4 y0 = v0[j] * r0 * g, y1 = v1[j] * r1 * g;
            u32x2 w0, w1; w0.x = pk2(y0[0], y0[1]); w0.y = pk2(y0[2], y0[3]); w1.x = pk2(y1[0], y1[1]); w1.y = pk2(y1[2], y1[3]); o0[64 * j] = w0; o1[64 * j] = w1; }
    } }
    if (PART == 1) { const float* const pp_ = karg_in(2); const float* const ps_ = karg_in(3);
    for (int idx0 = gt; idx0 < MREAL * 32; idx0 += NGT * 4) {
        f32x4 v0[4], v1[4];
#pragma unroll
        for (int q = 0; q < 4; ++q) { const int idx = idx0 + q * NGT; if (idx < MREAL * 32) { const int m = idx >> 5, c = (idx & 31) * 8; const float* pr = (m < MPR ? pp_ + (size_t)m * PLE : ps_ + (size_t)(m - MPR) * PLE) + c; v0[q] = *(const f32x4*)pr; v1[q] = *(const f32x4*)(pr + 4); } }
#pragma unroll
        for (int q = 0; q < 4; ++q) { const int idx = idx0 + q * NGT; if (idx < MREAL * 32) { const int m = idx >> 5, c = (idx & 31) * 8;
            u32x4 w; w.x = pk2(v0[q][0], v0[q][1]); w.y = pk2(v0[q][2], v0[q][3]); w.z = pk2(v1[q][0], v1[q][1]); w.w = pk2(v1[q][2], v1[q][3]);
            *(u32x4*)((bf16_t*)(ws + WS_PB) + (size_t)m * PLE + c) = w; } }
    } }
    if (PART == 0) for (int idx = gt; idx < 8193 * 8; idx += NGT) {
        const int pi = idx >> 3, i = idx & 7; const float pos = pi < SEQ ? (float)pi : 16384.0f; const float ang = pos * ROPE_INV[i];
        const double tw = 6.283185307179586476925; const double kq = __builtin_rint((double)ang * (1.0 / tw)); const float r = (float)((double)ang - kq * tw);
        float* rp = (float*)(ws + WS_ROPE) + (size_t)pi * 16; rp[i] = __cosf(r); rp[8 + i] = __sinf(r);
    }
    if (PART == 1) { const float* const st_ = karg_in(6);
    for (int idx = gt; idx < MSM * 14 * 128; idx += NGT) {
        const int b = idx / (14 * 128), rem = idx % (14 * 128), r = rem >> 7, c = (rem & 127) * 4;
        *(f32x4*)(aout + O_NPS + ((size_t)b * 15 + r) * 512 + c) = *(const f32x4*)(st_ + ((size_t)b * 15 + r + 1) * 512 + c);
    } }
}

__device__ __forceinline__ f32x4 ld4bf(const bf16_t* p) { const u32x2 w = *(const u32x2*)p; return (f32x4){bflo(w.x), bfhi(w.x), bflo(w.y), bfhi(w.y)}; }
__device__ __forceinline__ f32x4 mfma16(const bf16x8 a, const bf16x8 b, const f32x4 c) { return __builtin_amdgcn_mfma_f32_16x16x32_bf16(a, b, c, 0, 0, 0); }

struct KVRegs { u32x4 k[4], v[4]; };
__device__ __forceinline__ void attn_kv_load(KVRegs& r, int unit, const bf16_t* kb, const bf16_t* vb, int tid) {
    const int kvh = unit & 3, nb = (unit >> 2) & 63, b = unit >> 8, R0 = b * SEQ + nb * 128;
#pragma unroll
    for (int i = 0; i < 4; ++i) { const int c = tid + 512 * i, s = c >> 3, seg = c & 7; const bool ok = (nb > 0) || (s >= 128);
        r.k[i] = (u32x4){0u, 0u, 0u, 0u}; r.v[i] = (u32x4){0u, 0u, 0u, 0u};
        if (ok) { const size_t go = (size_t)(R0 - 128 + s) * 256 + kvh * 64 + seg * 8; r.k[i] = *(const u32x4*)(kb + go); r.v[i] = *(const u32x4*)(vb + go); } }
}
__device__ __forceinline__ void attn_kv_store(const KVRegs& r, LAS unsigned char* lds, int tid) {
    LAS bf16_t* Ks = (LAS bf16_t*)lds; LAS bf16_t* Vt = (LAS bf16_t*)(lds + 256 * 72 * 2);
#pragma unroll
    for (int i = 0; i < 4; ++i) { const int c = tid + 512 * i, s = c >> 3, seg = c & 7;
        *(LAS u32x4*)(Ks + s * 72 + seg * 8) = r.k[i];
        LAS bf16_t* vp = Vt + (seg * 8) * 264 + (s ^ (seg * 8)); const u32x4 vv = r.v[i];
        vp[0 * 264] = (bf16_t)(vv.x & 0xffffu); vp[1 * 264] = (bf16_t)(vv.x >> 16); vp[2 * 264] = (bf16_t)(vv.y & 0xffffu); vp[3 * 264] = (bf16_t)(vv.y >> 16);
        vp[4 * 264] = (bf16_t)(vv.z & 0xffffu); vp[5 * 264] = (bf16_t)(vv.z >> 16); vp[6 * 264] = (bf16_t)(vv.w & 0xffffu); vp[7 * 264] = (bf16_t)(vv.w >> 16); }
}
__device__ __forceinline__ void attn_prompt_math(LAS unsigned char* lds, int unit, const bf16_t* qb, bf16_t* ob, const float* sinks, int wave, int lane) {
    const int kvh = unit & 3, nb = (unit >> 2) & 63, b = unit >> 8, R0 = b * SEQ + nb * 128;
    const LAS bf16_t* Ks = (const LAS bf16_t*)lds; const LAS bf16_t* Vt = (const LAS bf16_t*)(lds + 256 * 72 * 2);
    const int g = wave >> 1, half = wave & 1, h = kvh * 4 + g, fr = lane & 15, fq = lane >> 4;
    const float sink = sinks[h];
    bf16x8 qf[4][2];
#pragma unroll
    for (int sb = 0; sb < 4; ++sb) { const bf16_t* qp = qb + (size_t)(R0 + half * 64 + sb * 16 + fr) * 1024 + h * 64 + fq * 8; qf[sb][0] = *(const bf16x8*)qp; qf[sb][1] = *(const bf16x8*)(qp + 32); }
#pragma unroll
    for (int sb = 0; sb < 4; ++sb) {
        const int qi0 = half * 64 + sb * 16, kt0 = qi0 >> 4, q = qi0 + fr;
        f32x4 S[9];
#pragma unroll
        for (int j = 0; j < 9; ++j) { const LAS bf16_t* kp = Ks + ((kt0 + j) * 16 + fr) * 72 + fq * 8;
            f32x4 acc = {0.f, 0.f, 0.f, 0.f}; acc = mfma16(*(const LAS bf16x8*)kp, qf[sb][0], acc); acc = mfma16(*(const LAS bf16x8*)(kp + 32), qf[sb][1], acc); S[j] = acc; }
        float mx = sink; const int e = fr - 4 * fq;
#pragma unroll
        for (int j = 0; j < 9; ++j) { const bool tok = (nb > 0) || (kt0 + j >= 8);
#pragma unroll
            for (int jj = 0; jj < 4; ++jj) { bool valid = tok; if (j == 0) valid = valid && (e < jj); if (j == 8) valid = valid && (e >= jj);
                const float v = valid ? S[j][jj] : -1e30f; S[j][jj] = v; mx = fmaxf(mx, v); } }
        mx = fmaxf(mx, __shfl_xor(mx, 16)); mx = fmaxf(mx, __shfl_xor(mx, 32));
        float l = 0.f;
#pragma unroll
        for (int j = 0; j < 9; ++j)
#pragma unroll
            for (int jj = 0; jj < 4; ++jj) { const float p = __expf(S[j][jj] - mx); S[j][jj] = p; l += p; }
        l += __shfl_xor(l, 16); l += __shfl_xor(l, 32); l += __expf(sink - mx);
        const float inv = 1.0f / l;
        f32x4 O[4];
#pragma unroll
        for (int dt = 0; dt < 4; ++dt) O[dt] = (f32x4){0.f, 0.f, 0.f, 0.f};
#pragma unroll
        for (int jp = 0; jp < 5; ++jp) {
            u32x4 pw; pw.x = cvt_pk_bf16_v(S[2 * jp][0], S[2 * jp][1]); pw.y = cvt_pk_bf16_v(S[2 * jp][2], S[2 * jp][3]);
            if (jp < 4) { pw.z = cvt_pk_bf16_v(S[2 * jp + 1 < 9 ? 2 * jp + 1 : 8][0], S[2 * jp + 1 < 9 ? 2 * jp + 1 : 8][1]); pw.w = cvt_pk_bf16_v(S[2 * jp + 1 < 9 ? 2 * jp + 1 : 8][2], S[2 * jp + 1 < 9 ? 2 * jp + 1 : 8][3]); } else { pw.z = 0u; pw.w = 0u; }
            const bf16x8 pf = __builtin_bit_cast(bf16x8, pw);
#pragma unroll
            for (int dt = 0; dt < 4; ++dt) { const int d = dt * 16 + fr, sw = ((d >> 3) & 7) * 8, s0 = (kt0 + 2 * jp) * 16 + fq * 4; const LAS bf16_t* vr = Vt + d * 264;
                const s16x4 lo = *(const LAS s16x4*)(vr + (s0 ^ sw)); s16x4 hi = {0, 0, 0, 0}; if (jp < 4) hi = *(const LAS s16x4*)(vr + ((s0 + 16) ^ sw));
                const bf16x8 vf = {lo[0], lo[1], lo[2], lo[3], hi[0], hi[1], hi[2], hi[3]};
                O[dt] = mfma16(vf, pf, O[dt]); }
        }
        bf16_t* op = ob + (size_t)(R0 + q) * 1024 + h * 64 + fq * 4;
#pragma unroll
        for (int dt = 0; dt < 4; ++dt) { const f32x4 o = O[dt] * inv; u32x2 w; w.x = cvt_pk_bf16(o[0], o[1]); w.y = cvt_pk_bf16(o[2], o[3]); *(u32x2*)(op + dt * 16) = w; }
    }
}
__device__ __forceinline__ void attn_prompt_all(LAS unsigned char* lds, const bf16_t* qb, const bf16_t* kb, const bf16_t* vb, bf16_t* ob, const float* sinks, int tid, int wave, int lane) {
    const int G = gridDim.x; int unit = blockIdx.x; if (unit >= 512) return;
    KVRegs r; attn_kv_load(r, unit, kb, vb, tid);
    for (;;) {
        attn_kv_store(r, lds, tid);
        __syncthreads();
        const int nxt = unit + G;
        if (nxt < 512) attn_kv_load(r, nxt, kb, vb, tid);
        attn_prompt_math(lds, unit, qb, ob, sinks, wave, lane);
        __syncthreads();
        if (nxt >= 512) break;
        unit = nxt;
    }
}

__device__ __forceinline__ void attn_sample_unit(LAS unsigned char* lds, int unit, const bf16_t* qb, const bf16_t* kb, const bf16_t* vb, bf16_t* ob, const float* cache_k, const float* cache_v, const float* sinks, float* out, int tid, int wave, int lane) {
    const int kvh = unit & 3, b = unit >> 2; const size_t row = MPR + b;
    LAS float* sc = (LAS float*)lds;
    LAS float* lsum = sc + 4 * 132;
    LAS float* opart = sc + 4 * 132 + 16;
    const int jq = lane >> 4, dq = lane & 15;
    f32x4 qv[4];
#pragma unroll
    for (int g = 0; g < 4; ++g) qv[g] = ld4bf(qb + row * 1024 + (kvh * 4 + g) * 64 + dq * 4);
    f32x4 kv[4], vv[4];
#pragma unroll
    for (int i = 0; i < 4; ++i) { const int j = wave * 16 + i * 4 + jq; const size_t off = ((size_t)(b * 128 + j) * 4 + kvh) * 64 + dq * 4;
        kv[i] = *(const f32x4*)(cache_k + off); vv[i] = *(const f32x4*)(cache_v + off); }
    const f32x4 knew = ld4bf(kb + row * 256 + kvh * 64 + dq * 4);
#pragma unroll
    for (int i = 0; i < 4; ++i) { const int j = wave * 16 + i * 4 + jq;
        if (j >= 1) { const size_t off = ((size_t)(b * 128 + j - 1) * 4 + kvh) * 64 + dq * 4; *(f32x4*)(out + O_NKS + off) = kv[i]; *(f32x4*)(out + O_NVS + off) = vv[i]; } }
#pragma unroll
    for (int i = 0; i < 5; ++i) { const f32x4 kk = i < 4 ? kv[i < 4 ? i : 0] : knew; float mine = 0.f;
#pragma unroll
        for (int g = 0; g < 4; ++g) { float p = sum4(kk * qv[g]); p += __shfl_xor(p, 1); p += __shfl_xor(p, 2); p += __shfl_xor(p, 4); p += __shfl_xor(p, 8); if (dq == g) mine = p; }
        if (i < 4) { if (dq < 4) sc[dq * 132 + wave * 16 + i * 4 + jq] = mine; }
        else if (wave == 0 && jq == 0 && dq < 4) sc[dq * 132 + 128] = mine; }
    __syncthreads();
    if (wave < 4) { const int g = wave; float a = sc[g * 132 + lane]; const float b2 = sc[g * 132 + 64 + lane], n = sc[g * 132 + 128], sink = sinks[kvh * 4 + g];
        if (lane == 0) a = -1e30f;
        const float mx = fmaxf(fmaxf(wave_max(fmaxf(a, b2)), n), sink);
        const float pa = __expf(a - mx), pb = __expf(b2 - mx), pnw = __expf(n - mx); const float l = wave_sum(pa + pb) + pnw + __expf(sink - mx);
        sc[g * 132 + lane] = pa; sc[g * 132 + 64 + lane] = pb; if (lane == 0) { sc[g * 132 + 128] = pnw; lsum[g] = 1.0f / l; } }
    __syncthreads();
    f32x4 o[4];
#pragma unroll
    for (int g = 0; g < 4; ++g) o[g] = (f32x4){0.f, 0.f, 0.f, 0.f};
#pragma unroll
    for (int i = 0; i < 4; ++i) { const int j = wave * 16 + i * 4 + jq;
#pragma unroll
        for (int g = 0; g < 4; ++g) o[g] += vv[i] * sc[g * 132 + j]; }
#pragma unroll
    for (int g = 0; g < 4; ++g)
#pragma unroll
        for (int e = 0; e < 4; ++e) { float t = o[g][e]; t += __shfl_xor(t, 16); t += __shfl_xor(t, 32); o[g][e] = t; }
    if (jq == 0) {
#pragma unroll
        for (int g = 0; g < 4; ++g) *(LAS f32x4*)(opart + (wave * 4 + g) * 64 + dq * 4) = o[g]; }
    __syncthreads();
    if (tid < 256) { const int g = tid >> 6, d = tid & 63; float acc = 0.f;
#pragma unroll
        for (int w = 0; w < 8; ++w) acc += opart[(w * 4 + g) * 64 + d];
        acc += sc[g * 132 + 128] * bflo((unsigned)vb[row * 256 + kvh * 64 + d]);
        ob[row * 1024 + (kvh * 4 + g) * 64 + d] = (bf16_t)f2bf(acc * lsum[g]); }
    __syncthreads();
}

template <int W>
__device__ __forceinline__ void pool_item(const bf16_t* __restrict__ ub, bf16_t* __restrict__ mb, const float* __restrict__ state, int row, int ch) {
    f32x4 u0, u1; unpack8(*(const u32x4*)(ub + (size_t)row * 512 + ch), u0, u1);
    f32x4 s0 = u0, s1 = u1; float cnt;
    if (row < MPR) { const int t = row & (SEQ - 1); cnt = (float)((t + 1 < W) ? t + 1 : W);
        u32x4 w[W - 1];
#pragma unroll
        for (int i = 1; i < W; ++i) { w[i - 1] = (u32x4){0u, 0u, 0u, 0u}; if (i <= t) w[i - 1] = *(const u32x4*)(ub + (size_t)(row - i) * 512 + ch); }
#pragma unroll
        for (int i = 1; i < W; ++i) { f32x4 a0, a1; unpack8(w[i - 1], a0, a1); s0 += a0; s1 += a1; } }
    else { const int b = row - MPR; cnt = (float)W;
#pragma unroll
        for (int i = 1; i < W; ++i) { const float* sp = state + ((size_t)b * 15 + 15 - i) * 512 + ch; s0 += *(const f32x4*)sp; s1 += *(const f32x4*)(sp + 4); } }
    const float ic = 1.0f / cnt;
    *(u32x4*)(mb + (size_t)row * 512 + ch) = pack8(s0 * ic - u0, s1 * ic - u1);
}
template <int W>
__device__ __forceinline__ void pool_block4(const bf16_t* __restrict__ ub, bf16_t* __restrict__ mb, const float* __restrict__ state, int row0, int ch) {
    if (row0 >= MPR) {
#pragma unroll
        for (int r = 0; r < 4; ++r) pool_item<W>(ub, mb, state, row0 + r, ch);
        return;
    }
    const int t0 = row0 & (SEQ - 1);
    u32x4 w[W + 3];
#pragma unroll
    for (int j = 0; j < W + 3; ++j) { w[j] = (u32x4){0u, 0u, 0u, 0u}; if (t0 + j - (W - 1) >= 0) w[j] = *(const u32x4*)(ub + (size_t)(row0 + j - (W - 1)) * 512 + ch); }
    f32x4 s0 = {0.f, 0.f, 0.f, 0.f}, s1 = {0.f, 0.f, 0.f, 0.f};
#pragma unroll
    for (int j = 0; j < W - 1; ++j) { f32x4 a0, a1; unpack8(w[j], a0, a1); s0 += a0; s1 += a1; }
#pragma unroll
    for (int r = 0; r < 4; ++r) {
        f32x4 u0, u1; unpack8(w[W - 1 + r], u0, u1); s0 += u0; s1 += u1;
        const int n = (t0 + r + 1 < W) ? t0 + r + 1 : W; const float ic = 1.0f / (float)n;
        *(u32x4*)(mb + (size_t)(row0 + r) * 512 + ch) = pack8(s0 * ic - u0, s1 * ic - u1);
        f32x4 o0, o1; unpack8(w[r], o0, o1); s0 -= o0; s1 -= o1;
    }
}
__device__ __forceinline__ void pool_items(unsigned char* ws, const float* __restrict__ state, int tid) {
    const bf16_t* __restrict__ ub = (const bf16_t*)(ws + WS_UB); bf16_t* __restrict__ mb = (bf16_t*)(ws + WS_MB);
    for (int idx = blockIdx.x * 512 + tid; idx < (MREAL / 4) * 64; idx += gridDim.x * 512) {
        const int cgk = idx & 15, g = (idx >> 6) & 3, rb = (idx >> 8) * 4 + ((idx >> 4) & 3), row0 = rb * 4, ch = g * 128 + cgk * 8;
        if (g == 0) pool_block4<2>(ub, mb, state, row0, ch); else if (g == 1) pool_block4<4>(ub, mb, state, row0, ch); else if (g == 2) pool_block4<8>(ub, mb, state, row0, ch); else pool_block4<16>(ub, mb, state, row0, ch);
    }
}

template <int K, class F>
__device__ __forceinline__ void skinny_gemm(LAS unsigned char* lds, const bf16_t* A, const bf16_t* Bt, int wave, int lane, const F& f) {
    constexpr int KQ = K / 4;
    const int fr = lane & 15, fq = lane >> 4, ks = wave & 3;
    for (int tp = blockIdx.x; tp < 256; tp += gridDim.x) {
        const int t = tp * 2 + (wave >> 2), cb = t & 63, rb = t >> 6;
        const bf16_t* ap = A + (size_t)(rb * 16 + fr) * K + ks * KQ + fq * 8;
        const bf16_t* bp = Bt + (size_t)(cb * 16 + fr) * K + ks * KQ + fq * 8;
        f32x4 acc = {0.f, 0.f, 0.f, 0.f};
#pragma unroll 8
        for (int k = 0; k < KQ; k += 32) acc = mfma16(*(const bf16x8*)(bp + k), *(const bf16x8*)(ap + k), acc);
        LAS f32x4* red = (LAS f32x4*)lds;
        red[wave * 64 + lane] = acc;
        __syncthreads();
        if (ks == 0) { acc = (red[wave * 64 + lane] + red[(wave + 1) * 64 + lane]) + (red[(wave + 2) * 64 + lane] + red[(wave + 3) * 64 + lane]);
            f(MPR + rb * 16 + fr, cb * 16 + fq * 4, acc, fq, cb); }
        __syncthreads();
    }
}
__device__ __forceinline__ void st4bf(bf16_t* p, const f32x4 v) { u32x2 w; w.x = cvt_pk_bf16(v[0], v[1]); w.y = cvt_pk_bf16(v[2], v[3]); *(u32x2*)p = w; }
__device__ __forceinline__ void ss_part(float* ss, int row, int cb, int fq, float q) { q += __shfl_xor(q, 16); q += __shfl_xor(q, 32); if (fq == 0) ss[(size_t)MPR * 16 + (size_t)(row - MPR) * 64 + cb] = q; }
struct SMergeA { bf16_t* mg; const bf16_t* gb;
    __device__ __forceinline__ void operator()(int row, int col, f32x4 v, int, int) const { st4bf(mg + (size_t)row * DM + col, ld4bf(gb + (size_t)row * 2048 + col) * v); } };
struct SMergeB { bf16_t* mg; const bf16_t* gb;
    __device__ __forceinline__ void operator()(int row, int col, f32x4 v, int, int) const { bf16_t* p = mg + (size_t)row * DM + col; st4bf(p, ld4bf(p) + ld4bf(gb + (size_t)row * 2048 + 1024 + col) * v); } };
struct SRes1 { const float *xs; bf16_t* hb; float* ss;
    __device__ __forceinline__ void operator()(int row, int col, f32x4 v, int fq, int cb) const {
        v += *(const f32x4*)(xs + (size_t)(row - MPR) * DM + col); st4bf(hb + (size_t)row * DM + col, v); ss_part(ss, row, cb, fq, sum4(v * v)); } };
struct SRes2 { bf16_t* hb;
    __device__ __forceinline__ void operator()(int row, int col, f32x4 v, int, int) const { bf16_t* hp = hb + (size_t)row * DM + col; st4bf(hp, ld4bf(hp) + v); } };
struct SEraw { bf16_t* er; float* ss;
    __device__ __forceinline__ void operator()(int row, int col, f32x4 v, int fq, int cb) const { st4bf(er + (size_t)row * DM + col, v); ss_part(ss, row, cb, fq, sum4(v * v)); } };
struct SPle { bf16_t* ob; const bf16_t* hb; const bf16_t* er; const float *sse, *pn; float* sso;
    __device__ __forceinline__ void operator()(int row, int col, f32x4 v, int fq, int cb) const {
        const float rs = row_rs(sse, row);
        v = ld4bf(hb + (size_t)row * DM + col) + sigm4(v) * (ld4bf(er + (size_t)row * DM + col) * rs * *(const f32x4*)(pn + col)); st4bf(ob + (size_t)row * DM + col, v); ss_part(sso, row, cb, fq, sum4(v * v)); } };

#define XB_TMO      128
#define XB_XCNT(j)  (256  + 64 * (j))
#define XB_XSUB(j)  (1280 + 64 * (j))
#define XB_XGEN(j)  (2304 + 64 * (j))
#define XB_TOP      3328
#define XB_TOPGEN   3392
#define XCD_BAR_WORDS 3456
#define XB_SPIN_CAP (1u << 18)

__device__ __forceinline__ unsigned xb_ld(unsigned* p)              { return __hip_atomic_load(p, __ATOMIC_RELAXED, __HIP_MEMORY_SCOPE_AGENT); }
__device__ __forceinline__ unsigned xb_add(unsigned* p, unsigned v) { return __hip_atomic_fetch_add(p, v, __ATOMIC_RELAXED, __HIP_MEMORY_SCOPE_AGENT); }
__device__ __forceinline__ unsigned xb_xcc_id() { return (unsigned)__builtin_amdgcn_s_getreg((3 << 11) | 20) & 0xFu; }
#define XB_SPIN(cond, bar) do { unsigned _sp = 0; while (cond) { __builtin_amdgcn_s_sleep(1); \
    if ((++_sp & 255u) == 0u) { if (xb_ld(&(bar)[XB_TMO])) break; if (_sp > XB_SPIN_CAP) { atomicAdd(&(bar)[XB_TMO], 1u); break; } } } } while (0)

__device__ __forceinline__ bool is_thread0(int wave_s) { int l = (int)__builtin_amdgcn_mbcnt_hi(~0u, __builtin_amdgcn_mbcnt_lo(~0u, 0u)); asm volatile("" : "+v"(l)); return wave_s == 0 && l == 0; }
struct XcdBarrier {
    unsigned* bar; unsigned x;
    volatile LAS unsigned* st;
};

__device__ __forceinline__ XcdBarrier xcd_barrier_post(unsigned* bar, volatile LAS unsigned* st) {
    XcdBarrier b; b.bar = bar; b.x = xb_xcc_id(); b.st = st;
    if (threadIdx.x == 0) (void)xb_add(&bar[XB_XCNT(b.x)], 1u);
    return b;
}
__device__ __forceinline__ void xcd_barrier_complete(unsigned* bar, unsigned x, unsigned& nloc, unsigned& nx) {
    const unsigned G = gridDim.x * gridDim.y * gridDim.z;
    unsigned sum, cnt, mine, sp = 0u;
    for (;;) {
        sum = 0u; cnt = 0u; mine = 0u;
#pragma unroll
        for (unsigned j = 0; j < 16; ++j) { const unsigned c = xb_ld(&bar[XB_XCNT(j)]); sum += c; cnt += (c > 0u) ? 1u : 0u; mine = (j == x) ? c : mine; }
        if (sum == G) break;
        __builtin_amdgcn_s_sleep(1);
        if ((++sp & 255u) == 0u) { if (xb_ld(&bar[XB_TMO])) break; if (sp > XB_SPIN_CAP) { atomicAdd(&bar[XB_TMO], 1u); break; } }
    }
    nloc = mine > 0u ? mine : 1u; nx = cnt > 0u ? cnt : 1u;
}

__device__ __forceinline__ void xcd_barrier(const XcdBarrier& b, const int wave_s) {
    asm volatile("s_waitcnt vmcnt(0)" ::: "memory");
    __syncthreads();
    if (is_thread0(wave_s)) {
        unsigned* bar = b.bar;
        __builtin_amdgcn_s_waitcnt(0);
        unsigned nloc = b.st[0], nx = b.st[1];
        if (nloc == 0u) { xcd_barrier_complete(bar, b.x, nloc, nx); b.st[0] = nloc; b.st[1] = nx; }
        const unsigned old = xb_add(&bar[XB_XSUB(b.x)], 1u);
        const unsigned gen = old / nloc;
        if (old + 1u == (gen + 1u) * nloc) {
            __builtin_amdgcn_fence(__ATOMIC_RELEASE, "agent");
            asm volatile("s_waitcnt vmcnt(0)" ::: "memory");
            const unsigned og = xb_add(&bar[XB_TOP], 1u);
            const unsigned tg = og / nx;
            if (og + 1u == (tg + 1u) * nx) xb_add(&bar[XB_TOPGEN], 1u);
            else XB_SPIN(xb_ld(&bar[XB_TOPGEN]) == tg, bar);
            __builtin_amdgcn_fence(__ATOMIC_ACQUIRE, "agent");
            xb_add(&bar[XB_XGEN(b.x)], 1u);
            asm volatile("s_waitcnt vmcnt(0)" ::: "memory");
        } else {
            XB_SPIN(xb_ld(&bar[XB_XGEN(b.x)]) == gen, bar);
            __builtin_amdgcn_fence(__ATOMIC_ACQUIRE, "agent");
            asm volatile("s_waitcnt vmcnt(0)" ::: "memory");
        }
    }
    __syncthreads();
}

constexpr size_t WS_BAR = 5 * MiB; constexpr int BAR_BYTES = 16384;
__global__ void __launch_bounds__(512, 2) fwd_kernel(Args a) {
    extern __shared__ __attribute__((aligned(16))) unsigned char lds_raw[];
    LAS unsigned char* lds = (LAS unsigned char*)lds_raw;
    const int wave = __builtin_amdgcn_readfirstlane((int)threadIdx.x >> 6);
    if (threadIdx.x < 64) ((volatile LAS unsigned*)(lds + 131072))[threadIdx.x] = 0u;
    __syncthreads();
    XcdBarrier xbar; xbar.bar = (unsigned*)(karg_ws() + WS_BAR); xbar.x = 0; xbar.st = nullptr;
    if (a.ph_hi - a.ph_lo > 1) xbar = xcd_barrier_post((unsigned*)(karg_ws() + WS_BAR), (volatile LAS unsigned*)(lds + 131072) + 8);
#define TID_LANE() int lane = (int)__builtin_amdgcn_mbcnt_hi(~0u, __builtin_amdgcn_mbcnt_lo(~0u, 0u)); asm volatile("" : "+v"(lane)); const int tid = wave * 64 + lane; (void)tid
    const int lo = a.ph_lo, hi = a.ph_hi;
#define IN(k) (lo <= (k) && (k) < hi)
#define SEAM(k) do { if (IN(k) && IN((k) + 1)) { xcd_barrier(xbar, wave); } } while (0)
    const int G = gridDim.x, c = blockIdx.x;

    if (a.ph_hi > NPHASE) cg::this_grid().sync();
    if (IN(0)) { TID_LANE(); p0_prologue<0>(lds, tid, wave, lane, (int)blockIdx.x, (int)gridDim.x); }
    SEAM(0);
    if (IN(1)) {
        unsigned char* ws = karg_ws();
        bf16_t* RA = (bf16_t*)(ws + WS_RA); bf16_t* GB = (bf16_t*)(ws + WS_RG); bf16_t* ER = (bf16_t*)(ws + WS_RG);
        bf16_t* UB = (bf16_t*)(ws + WS_UB); bf16_t* QB = (bf16_t*)(ws + WS_QB); bf16_t* KB = (bf16_t*)(ws + WS_KB); bf16_t* VB = (bf16_t*)(ws + WS_VB);
        bf16_t* MB = (bf16_t*)(ws + WS_MB); bf16_t* MG = (bf16_t*)(ws + WS_MG); bf16_t* ACT = (bf16_t*)(ws + WS_ACT);
        float* SS2 = (float*)(ws + WS_SS2); float* SSE = (float*)(ws + WS_SSE); float* SSO = (float*)(ws + WS_SSO);
        (void)RA; (void)GB; (void)ER; (void)UB; (void)QB; (void)KB; (void)VB; (void)MB; (void)MG; (void)ACT; (void)SS2; (void)SSE; (void)SSO;
        Gemm g{RA, (const bf16_t*)(ws + WS_WIN), MPAD, INC, 1024}; StaticOrder S; S.init(MPAD, INC, G, c);
        EpiIn E{UB, QB, KB, VB, GB, karg_out(), (const float*)(ws + WS_ROPE)};
        gemm_phase<EpiIn, StaticOrder, true, true, 1024>(lds, g, S, E, wave);
        { const int nwg = (MPAD / 256) * (INC / 256), extra = nwg % G;
          TID_LANE(); if (extra == 0) p0_prologue<1>(lds, tid, wave, lane, c, G); else if (c >= extra) p0_prologue<1>(lds, tid, wave, lane, c - extra, G - extra); }
    }
    SEAM(1);
    if (IN(2)) {
        TID_LANE();
        unsigned char* ws = karg_ws();
        bf16_t* RA = (bf16_t*)(ws + WS_RA); bf16_t* GB = (bf16_t*)(ws + WS_RG); bf16_t* ER = (bf16_t*)(ws + WS_RG);
        bf16_t* UB = (bf16_t*)(ws + WS_UB); bf16_t* QB = (bf16_t*)(ws + WS_QB); bf16_t* KB = (bf16_t*)(ws + WS_KB); bf16_t* VB = (bf16_t*)(ws + WS_VB);
        bf16_t* MB = (bf16_t*)(ws + WS_MB); bf16_t* MG = (bf16_t*)(ws + WS_MG); bf16_t* ACT = (bf16_t*)(ws + WS_ACT);
        float* SS2 = (float*)(ws + WS_SS2); float* SSE = (float*)(ws + WS_SSE); float* SSO = (float*)(ws + WS_SSO);
        (void)RA; (void)GB; (void)ER; (void)UB; (void)QB; (void)KB; (void)VB; (void)MB; (void)MG; (void)ACT; (void)SS2; (void)SSE; (void)SSO;
        { const float* const sinks_ = karg_in(11); const float* const ck_ = karg_in(4); const float* const cv_ = karg_in(5); float* const out_ = karg_out();
        attn_prompt_all(lds, QB, KB, VB, RA, sinks_, tid, wave, lane);
        for (int unit = c; unit < 512; unit += G) attn_sample_unit(lds, unit, QB, KB, VB, RA, ck_, cv_, sinks_, out_, tid, wave, lane); }
        pool_items(ws, karg_in(6), tid);
        __syncthreads();
    }
    SEAM(2);
    if (IN(3)) {
        unsigned char* ws = karg_ws();
        bf16_t* RA = (bf16_t*)(ws + WS_RA); bf16_t* GB = (bf16_t*)(ws + WS_RG); bf16_t* ER = (bf16_t*)(ws + WS_RG);
        bf16_t* UB = (bf16_t*)(ws + WS_UB); bf16_t* QB = (bf16_t*)(ws + WS_QB); bf16_t* KB = (bf16_t*)(ws + WS_KB); bf16_t* VB = (bf16_t*)(ws + WS_VB);
        bf16_t* MB = (bf16_t*)(ws + WS_MB); bf16_t* MG = (bf16_t*)(ws + WS_MG); bf16_t* ACT = (bf16_t*)(ws + WS_ACT);
        float* SS2 = (float*)(ws + WS_SS2); float* SSE = (float*)(ws + WS_SSE); float* SSO = (float*)(ws + WS_SSO);
        (void)RA; (void)GB; (void)ER; (void)UB; (void)QB; (void)KB; (void)VB; (void)MB; (void)MG; (void)ACT; (void)SS2; (void)SSE; (void)SSO;
        TID_LANE();
        { const bf16_t* mbs = MB + (size_t)MPR * 512; const bf16_t* ras = RA + (size_t)MPR * DM;
          SMergeA Ea{MG, GB}; skinny_gemm<512>(lds, mbs, (const bf16_t*)(ws + WS_WEFF), wave, lane, Ea);
          SMergeB Eb{MG, GB}; skinny_gemm<1024>(lds, ras, (const bf16_t*)(ws + WS_WAB), wave, lane, Eb); }
        StaticOrder S; S.init(MPR, 1024, G, c);
        { Gemm g{MB, (const bf16_t*)(ws + WS_WEFF), MPR, 1024, 512}; EpiMergeA E{MG, GB}; gemm_phase<EpiMergeA, StaticOrder, true, true, 512>(lds, g, S, E, wave); }
        { Gemm g{RA, (const bf16_t*)(ws + WS_WAB), MPR, 1024, 1024}; EpiMergeB E{MG, GB}; gemm_phase<EpiMergeB, StaticOrder, true, true, 1024>(lds, g, S, E, wave); }
    }
    SEAM(3);
    if (IN(4)) {
        unsigned char* ws = karg_ws();
        bf16_t* RA = (bf16_t*)(ws + WS_RA); bf16_t* GB = (bf16_t*)(ws + WS_RG); bf16_t* ER = (bf16_t*)(ws + WS_RG);
        bf16_t* UB = (bf16_t*)(ws + WS_UB); bf16_t* QB = (bf16_t*)(ws + WS_QB); bf16_t* KB = (bf16_t*)(ws + WS_KB); bf16_t* VB = (bf16_t*)(ws + WS_VB);
        bf16_t* MB = (bf16_t*)(ws + WS_MB); bf16_t* MG = (bf16_t*)(ws + WS_MG); bf16_t* ACT = (bf16_t*)(ws + WS_ACT);
        float* SS2 = (float*)(ws + WS_SS2); float* SSE = (float*)(ws + WS_SSE); float* SSO = (float*)(ws + WS_SSO);
        (void)RA; (void)GB; (void)ER; (void)UB; (void)QB; (void)KB; (void)VB; (void)MB; (void)MG; (void)ACT; (void)SS2; (void)SSE; (void)SSO;
        TID_LANE();
        { SRes1 Es{karg_in(1), RA, SS2}; skinny_gemm<1024>(lds, MG + (size_t)MPR * DM, (const bf16_t*)(ws + WS_WOUT), wave, lane, Es); }
        Gemm g{MG, (const bf16_t*)(ws + WS_WOUT), MPR, 1024, 1024}; StaticOrder S; S.init(MPR, 1024, G, c);
        EpiRes1 E{karg_in(0), RA, SS2};
        gemm_phase<EpiRes1, StaticOrder, true, true, 1024>(lds, g, S, E, wave);
    }
    SEAM(4);
    if (IN(5)) {
        unsigned char* ws = karg_ws();
        bf16_t* RA = (bf16_t*)(ws + WS_RA); bf16_t* GB = (bf16_t*)(ws + WS_RG); bf16_t* ER = (bf16_t*)(ws + WS_RG);
        bf16_t* UB = (bf16_t*)(ws + WS_UB); bf16_t* QB = (bf16_t*)(ws + WS_QB); bf16_t* KB = (bf16_t*)(ws + WS_KB); bf16_t* VB = (bf16_t*)(ws + WS_VB);
        bf16_t* MB = (bf16_t*)(ws + WS_MB); bf16_t* MG = (bf16_t*)(ws + WS_MG); bf16_t* ACT = (bf16_t*)(ws + WS_ACT);
        float* SS2 = (float*)(ws + WS_SS2); float* SSE = (float*)(ws + WS_SSE); float* SSO = (float*)(ws + WS_SSO);
        (void)RA; (void)GB; (void)ER; (void)UB; (void)QB; (void)KB; (void)VB; (void)MB; (void)MG; (void)ACT; (void)SS2; (void)SSE; (void)SSO;
        Gemm g{RA, (const bf16_t*)(ws + WS_WFI), MPAD, 2 * FFH, 1024}; StaticOrder S; S.init(MPAD, 2 * FFH, G, c);
        EpiSwiglu E{ACT, SS2};
        gemm_phase<EpiSwiglu, StaticOrder, true, true, 1024>(lds, g, S, E, wave);
        { const int nwg5 = (MPAD / 256) * (2 * FFH / 256), extra5 = nwg5 % G;
          TailOrder T; T.init(MPR, 1024, G, c, extra5); Gemm gp{(const bf16_t*)(ws + WS_PB), (const bf16_t*)(ws + WS_WPP), MPR, 1024, PLE}; EpiEraw Ee{ER, SSE};
          gemm_phase<EpiEraw, TailOrder, true, true, PLE>(lds, gp, T, Ee, wave); }
    }
    SEAM(5);
    if (IN(6)) {
        unsigned char* ws = karg_ws();
        bf16_t* RA = (bf16_t*)(ws + WS_RA); bf16_t* GB = (bf16_t*)(ws + WS_RG); bf16_t* ER = (bf16_t*)(ws + WS_RG);
        bf16_t* UB = (bf16_t*)(ws + WS_UB); bf16_t* QB = (bf16_t*)(ws + WS_QB); bf16_t* KB = (bf16_t*)(ws + WS_KB); bf16_t* VB = (bf16_t*)(ws + WS_VB);
        bf16_t* MB = (bf16_t*)(ws + WS_MB); bf16_t* MG = (bf16_t*)(ws + WS_MG); bf16_t* ACT = (bf16_t*)(ws + WS_ACT);
        float* SS2 = (float*)(ws + WS_SS2); float* SSE = (float*)(ws + WS_SSE); float* SSO = (float*)(ws + WS_SSO);
        (void)RA; (void)GB; (void)ER; (void)UB; (void)QB; (void)KB; (void)VB; (void)MB; (void)MG; (void)ACT; (void)SS2; (void)SSE; (void)SSO;
        TID_LANE();
        { SRes2 Es{RA}; skinny_gemm<FFH>(lds, ACT + (size_t)MPR * FFH, (const bf16_t*)(ws + WS_WFO), wave, lane, Es);
          SEraw Ee{ER, SSE}; skinny_gemm<PLE>(lds, (const bf16_t*)(ws + WS_PB) + (size_t)MPR * PLE, (const bf16_t*)(ws + WS_WPP), wave, lane, Ee); }
        StaticOrder S; S.init(MPR, 1024, G, c);
        { Gemm g{ACT, (const bf16_t*)(ws + WS_WFO), MPR, 1024, FFH}; EpiRes2 E{RA}; gemm_phase<EpiRes2, StaticOrder, true, true, FFH>(lds, g, S, E, wave); }
    }
    SEAM(6);
    if (IN(7)) {
        unsigned char* ws = karg_ws();
        bf16_t* RA = (bf16_t*)(ws + WS_RA); bf16_t* GB = (bf16_t*)(ws + WS_RG); bf16_t* ER = (bf16_t*)(ws + WS_RG);
        bf16_t* UB = (bf16_t*)(ws + WS_UB); bf16_t* QB = (bf16_t*)(ws + WS_QB); bf16_t* KB = (bf16_t*)(ws + WS_KB); bf16_t* VB = (bf16_t*)(ws + WS_VB);
        bf16_t* MB = (bf16_t*)(ws + WS_MB); bf16_t* MG = (bf16_t*)(ws + WS_MG); bf16_t* ACT = (bf16_t*)(ws + WS_ACT);
        float* SS2 = (float*)(ws + WS_SS2); float* SSE = (float*)(ws + WS_SSE); float* SSO = (float*)(ws + WS_SSO);
        (void)RA; (void)GB; (void)ER; (void)UB; (void)QB; (void)KB; (void)VB; (void)MB; (void)MG; (void)ACT; (void)SS2; (void)SSE; (void)SSO;
        TID_LANE();
        { SPle Es{ACT, RA, ER, SSE, karg_in(19), SSO}; skinny_gemm<1024>(lds, RA + (size_t)MPR * DM, (const bf16_t*)(ws + WS_WPG), wave, lane, Es); }
        Gemm g{RA, (const bf16_t*)(ws + WS_WPG), MPR, 1024, 1024}; StaticOrder S; S.init(MPR, 1024, G, c);
        EpiPle E{ACT, RA, ER, SSE, karg_in(19), SSO};
        gemm_phase<EpiPle, StaticOrder, true, true, 1024>(lds, g, S, E, wave);
    }
    SEAM(7);
    if (IN(8)) {
        TID_LANE();
        unsigned char* ws = karg_ws();
        bf16_t* RA = (bf16_t*)(ws + WS_RA); bf16_t* GB = (bf16_t*)(ws + WS_RG); bf16_t* ER = (bf16_t*)(ws + WS_RG);
        bf16_t* UB = (bf16_t*)(ws + WS_UB); bf16_t* QB = (bf16_t*)(ws + WS_QB); bf16_t* KB = (bf16_t*)(ws + WS_KB); bf16_t* VB = (bf16_t*)(ws + WS_VB);
        bf16_t* MB = (bf16_t*)(ws + WS_MB); bf16_t* MG = (bf16_t*)(ws + WS_MG); bf16_t* ACT = (bf16_t*)(ws + WS_ACT);
        float* SS2 = (float*)(ws + WS_SS2); float* SSE = (float*)(ws + WS_SSE); float* SSO = (float*)(ws + WS_SSO);
        (void)RA; (void)GB; (void)ER; (void)UB; (void)QB; (void)KB; (void)VB; (void)MB; (void)MG; (void)ACT; (void)SS2; (void)SSE; (void)SSO;
        const float* fn = karg_in(21); float* const out_ = karg_out();
        f32x4 f0[2], f1[2];
#pragma unroll
        for (int hh = 0; hh < 2; ++hh) { f0[hh] = *(const f32x4*)(fn + hh * 512 + lane * 8); f1[hh] = *(const f32x4*)(fn + hh * 512 + lane * 8 + 4); }
        for (int m = (c * 8 + wave) * 2; m < MREAL; m += G * 16) {
            u32x4 w[2][2];
#pragma unroll
            for (int r = 0; r < 2; ++r)
#pragma unroll
                for (int hh = 0; hh < 2; ++hh) w[r][hh] = *(const u32x4*)(ACT + (size_t)(m + r) * DM + hh * 512 + lane * 8);
#pragma unroll
            for (int r = 0; r < 2; ++r) { const float rs = row_rs(SSO, m + r);
#pragma unroll
                for (int hh = 0; hh < 2; ++hh) { f32x4 v0, v1; unpack8(w[r][hh], v0, v1); float* yp = out_ + (size_t)(m + r) * DM + hh * 512 + lane * 8;
                    *(f32x4*)yp = v0 * rs * f0[hh]; *(f32x4*)(yp + 4) = v1 * rs * f1[hh]; } }
        }
    }
#undef IN
#undef SEAM
}

extern "C" void kernel_launch(void* const* d_in, const int* in_sizes, int n_in, void* d_out, int out_size, void* d_ws, size_t ws_size, hipStream_t stream) {
    static int grid = 0;
    if (grid == 0) {
        if (n_in != 22 || out_size != (int)O_END || ws_size < WS_END) { fprintf(stderr, "kernel_launch: unexpected sizes: n_in %d out %d ws %zu (need %zu)\n", n_in, out_size, ws_size, (size_t)WS_END); grid = -1; return; }
        int dev = 0, cus = 0, per_cu = 0;
        hipGetDevice(&dev); hipDeviceGetAttribute(&cus, hipDeviceAttributeMultiprocessorCount, dev);
        if (hipFuncSetAttribute((const void*)fwd_kernel, hipFuncAttributeMaxDynamicSharedMemorySize, LDS_BYTES) != hipSuccess) { fprintf(stderr, "kernel_launch: hipFuncSetAttribute failed\n"); grid = -1; return; }
        if (hipOccupancyMaxActiveBlocksPerMultiprocessor(&per_cu, (const void*)fwd_kernel, 512, LDS_BYTES) != hipSuccess || per_cu < 1) { fprintf(stderr, "kernel_launch: occupancy query failed (%d)\n", per_cu); grid = -1; return; }
        grid = cus * per_cu;
        fprintf(stderr, "kernel_launch: cus %d per_cu %d grid %d\n", cus, per_cu, grid);
    }
    if (grid < 0) return;
    Args a{};
    for (int i = 0; i < 22; ++i) a.in[i] = (const float*)d_in[i];
    a.out = (float*)d_out; a.ws = (unsigned char*)d_ws;
#if N_LAUNCH == 1
    if (hipMemsetAsync((char*)d_ws + WS_BAR, 0, BAR_BYTES, stream) != hipSuccess) { fprintf(stderr, "kernel_launch: memset failed\n"); return; }
    a.ph_lo = 0; a.ph_hi = NPHASE;
    void* args[] = {&a};
    hipError_t e = hipLaunchCooperativeKernel((const void*)fwd_kernel, dim3(grid), dim3(512), args, LDS_BYTES, stream);
    if (e != hipSuccess) fprintf(stderr, "cooperative launch failed: %s (grid %d)\n", hipGetErrorString(e), grid);
#else
    for (int p = 0; p < NPHASE; ++p) { a.ph_lo = p; a.ph_hi = p + 1; hipLaunchKernelGGL(fwd_kernel, dim3(grid), dim3(512), LDS_BYTES, stream, a); }
#endif
}
```

```cpp
#include <hip/hip_runtime.h>
#include <hip/hip_cooperative_groups.h>
#include <cstdio>
#include <cstdint>
namespace cg = cooperative_groups;
namespace pg8 {
#define PG8_LAS __attribute__((address_space(3)))
typedef unsigned short bf16_t;
typedef short bf16x8 __attribute__((ext_vector_type(8)));
typedef float f32x4 __attribute__((ext_vector_type(4)));
typedef unsigned u32x4 __attribute__((ext_vector_type(4)));
constexpr int BM = 256, BK = 64, HALF = 128, HTB = HALF * BK * 2  , STAGE_BYTES = 8 * HTB, NXCD = 8, WGM = 8;

__host__ __device__ __forceinline__ int lds_byte(int r, int c) { const int st = (r >> 4) * 2 + (c >> 5), rr = r & 15, cc = c & 31, ob = rr * 64 + cc * 2; return st * 1024 + (ob ^ (((ob >> 9) & 1) << 5)); }
__host__ __device__ __forceinline__ void stage_rc(int b, int& R, int& C) { const int st = b / 1024, sb = b % 1024, swz = sb ^ (((sb >> 9) & 1) << 5); R = (st >> 1) * 16 + swz / 64; C = (st & 1) * 32 + (swz % 64) / 2; }
__host__ __device__ __forceinline__ int perm32(int rho) { const int n = rho >> 4, i = rho & 15; return 8 * (i >> 2) + 4 * n + (i & 3); }

struct Unit { int pm, pn; };
struct Gemm { const bf16_t* A; const bf16_t* Bt; int M, N, K; };

struct StaticOrder {
    int nM, nN, nwg, G, c;
    __host__ __device__ void init(int M, int N, int G_, int c_) { nM = M / BM; nN = N / BM; nwg = nM * nN; G = G_; c = c_; }
    __host__ __device__ bool next(int i, Unit& u) const {
        const long L = (long)i * G + c; if (L >= nwg) return false;
        int wgid = (int)L; { const int q = nwg / NXCD, r = nwg % NXCD, xcd = wgid % NXCD, off = wgid / NXCD; wgid = (xcd < r ? xcd * (q + 1) : r * (q + 1) + (xcd - r) * q) + off; }
        const int nig = WGM * nN, gid = wgid / nig, fm = gid * WGM, gsz = (nM - fm) < WGM ? (nM - fm) : WGM;
        u.pm = fm + ((wgid % nig) % gsz); u.pn = (wgid % nig) / gsz; return true;
    }
    __device__ __forceinline__ void a_ready(const Unit&) const {}
    __device__ __forceinline__ void done(const Unit&) const {}
};

struct TailOrder {
    int nwg, first, cnt, c;
    __host__ __device__ void init(int M, int N, int G_, int c_, int first_) { nwg = (M / BM) * (N / BM); first = first_ < G_ ? first_ : 0; cnt = G_ - first; c = c_; }
    __host__ __device__ bool next(int i, Unit& u) const {
        if (c < first) return false; const int t = (c - first) + i * cnt; if (t >= nwg) return false;
        u.pm = t >> 2; u.pn = t & 3; return true;
    }
    __device__ __forceinline__ void a_ready(const Unit&) const {}
    __device__ __forceinline__ void done(const Unit&) const {}
};

__device__ __forceinline__ unsigned cvt_pk_bf16(float lo, float hi) { unsigned r; asm volatile("s_nop 0\n\tv_cvt_pk_bf16_f32 %0, %1, %2" : "=v"(r) : "v"(lo), "v"(hi)); return r; }
typedef float f32x2_cv __attribute__((ext_vector_type(2))); typedef __bf16 bf16x2_cv __attribute__((ext_vector_type(2)));
__device__ __forceinline__ unsigned cvt_pk_bf16_v(float lo, float hi) { const f32x2_cv v = {lo, hi}; const bf16x2_cv b = __builtin_convertvector(v, bf16x2_cv); return __builtin_bit_cast(unsigned, b); }
typedef float f32x2 __attribute__((ext_vector_type(2)));

constexpr int DM = 1024, SEQ = 8192, MPR = 16384, MSM = 128, MREAL = MPR + MSM, MPAD = 16640;
constexpr int INC = 4096, FFH = 2816, PLE = 256;
constexpr float EPS = 1e-6f;
constexpr size_t O_Y = 0, O_NKP = (size_t)MREAL * DM, O_NVP = O_NKP + 65536, O_NPP = O_NVP + 65536, O_NKS = O_NPP + 15360, O_NVS = O_NKS + 4194304, O_NPS = O_NVS + 4194304, O_END = O_NPS + 983040;

typedef unsigned u32x2 __attribute__((ext_vector_type(2)));
__device__ __forceinline__ float bflo(unsigned w) { return __builtin_bit_cast(float, w << 16); }
__device__ __forceinline__ float bfhi(unsigned w) { return __builtin_bit_cast(float, w & 0xffff0000u); }
__device__ __forceinline__ u32x4 pack8(const f32x4 a, const f32x4 b) { u32x4 w; w.x = cvt_pk_bf16(a[0], a[1]); w.y = cvt_pk_bf16(a[2], a[3]); w.z = cvt_pk_bf16(b[0], b[1]); w.w = cvt_pk_bf16(b[2], b[3]); return w; }
__device__ __forceinline__ u32x4 pack8v(const f32x4 a, const f32x4 b) { u32x4 w; w.x = cvt_pk_bf16_v(a[0], a[1]); w.y = cvt_pk_bf16_v(a[2], a[3]); w.z = cvt_pk_bf16_v(b[0], b[1]); w.w = cvt_pk_bf16_v(b[2], b[3]); return w; }
__device__ __forceinline__ void unpack8(const u32x4 w, f32x4& a, f32x4& b) { a = (f32x4){bflo(w.x), bfhi(w.x), bflo(w.y), bfhi(w.y)}; b = (f32x4){bflo(w.z), bfhi(w.z), bflo(w.w), bfhi(w.w)}; }
__device__ __forceinline__ float sigm(float x) { return __builtin_amdgcn_rcpf(1.0f + __expf(-x)); }
__device__ __forceinline__ f32x4 sigm4(const f32x4 x) { return (f32x4){sigm(x[0]), sigm(x[1]), sigm(x[2]), sigm(x[3])}; }
__device__ __forceinline__ float sum4(const f32x4 x) { return (x[0] + x[1]) + (x[2] + x[3]); }
__device__ __forceinline__ float row_rs(const float* ss, int row) {
    if (row < MPR) { const f32x4* p = (const f32x4*)(ss + (size_t)row * 16); const f32x4 a = p[0], b = p[1], c = p[2], d = p[3];
        return rsqrtf(((sum4(a) + sum4(b)) + (sum4(c) + sum4(d))) * (1.0f / DM) + EPS); }
    const f32x4* p = (const f32x4*)(ss + (size_t)MPR * 16 + (size_t)(row - MPR) * 64); f32x4 t = p[0];
#pragma unroll
    for (int i = 1; i < 16; ++i) t += p[i];
    return rsqrtf(sum4(t) * (1.0f / DM) + EPS);
}
#define EPI_ROW(ai, m) (u.pm * BM + (ai) * HALF + wr * 64 + (m) * 16 + fr)
#define EPI_LOOP_AM _Pragma("unroll") for (int ai = 0; ai < 2; ++ai) _Pragma("unroll") for (int m = 0; m < 4; ++m)
#define EPI_LOOP_BJ _Pragma("unroll") for (int bj = 0; bj < 2; ++bj)

struct EpiIn {
    static constexpr bool PERM = true, AFTER_DRAIN = false;
    bf16_t *ub, *qb, *kb, *vb, *gb; float* out; const float* rope;
    __device__ __forceinline__ void operator()(const f32x4 (&acc)[2][2][4][2], const Unit& u, int wr, int wc, int fr, int fq) const {
        const int colt = u.pn * BM, cw = wc * 32 + 8 * fq;
        const bool tail = (u.pm == 31) || (u.pm == 63) || (u.pm == 64);
        EPI_LOOP_AM {
            const int row = EPI_ROW(ai, m);
            if (colt >= 2048) {
                EPI_LOOP_BJ { const int col = colt - 2048 + bj * HALF + cw; *(u32x4*)(gb + (size_t)row * 2048 + col) = pack8v(sigm4(acc[ai][bj][m][0]), sigm4(acc[ai][bj][m][1])); }
            } else if (colt < 512) {
                EPI_LOOP_BJ { const int col = colt + bj * HALF + cw; const f32x4 v0 = acc[ai][bj][m][0], v1 = acc[ai][bj][m][1];
                    *(u32x4*)(ub + (size_t)row * 512 + col) = pack8(v0, v1);
                    if (tail) { float* dst = nullptr;
                        if (row >= MPR) { if (row < MREAL) dst = out + O_NPS + ((size_t)(row - MPR) * 15 + 14) * 512 + col; }
                        else { const int t = row & (SEQ - 1); if (t >= SEQ - 15) dst = out + O_NPP + ((size_t)(row >> 13) * 15 + (t - (SEQ - 15))) * 512 + col; }
                        if (dst) { *(f32x4*)dst = v0; *(f32x4*)(dst + 4) = v1; } } }
            } else if (colt < 1792) {
                const bool isq = colt < 1536;
                const int pidx = row < MPR ? (row & (SEQ - 1)) : SEQ;
                EPI_LOOP_BJ { f32x4 v0 = acc[ai][bj][m][0], v1 = acc[ai][bj][m][1];
                    if ((wc & 1) == 0) {
                        f32x4 p0, p1;
#pragma unroll
                        for (int j = 0; j < 4; ++j) { p0[j] = __shfl_xor(v0[j], 16); p1[j] = __shfl_xor(v1[j], 16); }
                        if (fq < 2) { const f32x4* rp = (const f32x4*)(rope + (size_t)pidx * 16); const f32x4 c0 = rp[0], c1 = rp[1]; f32x4 s0 = rp[2], s1 = rp[3];
                            if (fq == 0) { s0 = -s0; s1 = -s1; }
                            v0 = v0 * c0 + p0 * s0; v1 = v1 * c1 + p1 * s1; }
                    }
                    if (isq) { v0 = v0 * 0.125f; v1 = v1 * 0.125f; *(u32x4*)(qb + (size_t)row * 1024 + (colt - 512) + bj * HALF + cw) = pack8(v0, v1); }
                    else { const int col = bj * HALF + cw; *(u32x4*)(kb + (size_t)row * 256 + col) = pack8(v0, v1);
                        if (tail) { float* dst = nullptr;
                            if (row >= MPR) { if (row < MREAL) dst = out + O_NKS + ((size_t)(row - MPR) * 128 + 127) * 256 + col; }
                            else { const int t = row & (SEQ - 1); if (t >= SEQ - 128) dst = out + O_NKP + ((size_t)(row >> 13) * 128 + (t - (SEQ - 128))) * 256 + col; }
                            if (dst) { *(f32x4*)dst = v0; *(f32x4*)(dst + 4) = v1; } } } }
            } else {
                EPI_LOOP_BJ { const int col = bj * HALF + cw; const f32x4 v0 = acc[ai][bj][m][0], v1 = acc[ai][bj][m][1];
                    *(u32x4*)(vb + (size_t)row * 256 + col) = pack8(v0, v1);
                    if (tail) { float* dst = nullptr;
                        if (row >= MPR) { if (row < MREAL) dst = out + O_NVS + ((size_t)(row - MPR) * 128 + 127) * 256 + col; }
                        else { const int t = row & (SEQ - 1); if (t >= SEQ - 128) dst = out + O_NVP + ((size_t)(row >> 13) * 128 + (t - (SEQ - 128))) * 256 + col; }
                        if (dst) { *(f32x4*)dst = v0; *(f32x4*)(dst + 4) = v1; } } }
            }
        }
    }
};
struct EpiMergeA {
    static constexpr bool PERM = true, AFTER_DRAIN = false;
    bf16_t* mg; const bf16_t* gb;
    __device__ __forceinline__ void operator()(const f32x4 (&acc)[2][2][4][2], const Unit& u, int wr, int wc, int fr, int fq) const {
        const int cw = u.pn * BM + wc * 32 + 8 * fq;
        EPI_LOOP_AM { const int row = EPI_ROW(ai, m);
            EPI_LOOP_BJ { const int col = cw + bj * HALF; f32x4 g0, g1; unpack8(*(const u32x4*)(gb + (size_t)row * 2048 + col), g0, g1);
                *(u32x4*)(mg + (size_t)row * DM + col) = pack8(g0 * acc[ai][bj][m][0], g1 * acc[ai][bj][m][1]); } }
    }
};
struct EpiMergeB {
    static constexpr bool PERM = true, AFTER_DRAIN = false;
    bf16_t* mg; const bf16_t* gb;
    __device__ __forceinline__ void operator()(const f32x4 (&acc)[2][2][4][2], const Unit& u, int wr, int wc, int fr, int fq) const {
        const int cw = u.pn * BM + wc * 32 + 8 * fq;
        EPI_LOOP_AM { const int row = EPI_ROW(ai, m);
            EPI_LOOP_BJ { const int col = cw + bj * HALF; f32x4 g0, g1, t0, t1; unpack8(*(const u32x4*)(gb + (size_t)row * 2048 + 1024 + col), g0, g1);
                unpack8(*(const u32x4*)(mg + (size_t)row * DM + col), t0, t1);
                *(u32x4*)(mg + (size_t)row * DM + col) = pack8(t0 + g0 * acc[ai][bj][m][0], t1 + g1 * acc[ai][bj][m][1]); } }
    }
};
struct EpiRes1 {
    static constexpr bool PERM = true, AFTER_DRAIN = false;
    const float *xp; bf16_t* hb; float* ss;
    __device__ __forceinline__ void operator()(const f32x4 (&acc)[2][2][4][2], const Unit& u, int wr, int wc, int fr, int fq) const {
        const int cw = u.pn * BM + wc * 32 + 8 * fq;
        EPI_LOOP_AM { const int row = EPI_ROW(ai, m); const float* xr = xp + (size_t)row * DM; float q = 0.f;
            EPI_LOOP_BJ { const int col = cw + bj * HALF; const f32x4 v0 = acc[ai][bj][m][0] + __builtin_nontemporal_load((const f32x4*)(xr + col)), v1 = acc[ai][bj][m][1] + __builtin_nontemporal_load((const f32x4*)(xr + col + 4));
                q += sum4(v0 * v0) + sum4(v1 * v1);
                *(u32x4*)(hb + (size_t)row * DM + col) = pack8(v0, v1); }
            q += __shfl_xor(q, 16); q += __shfl_xor(q, 32);
            if (fq == 0) ss[(size_t)row * 16 + u.pn * 4 + wc] = q; }
    }
};
struct EpiSwiglu {
    static constexpr bool PERM = true, AFTER_DRAIN = false;
    bf16_t* act; const float* ss;
    __device__ __forceinline__ void operator()(const f32x4 (&acc)[2][2][4][2], const Unit& u, int wr, int wc, int fr, int fq) const {
        const int cw = u.pn * 128 + wc * 16 + 4 * fq;
        EPI_LOOP_AM { const int row = EPI_ROW(ai, m); const float rs = row_rs(ss, row);
            EPI_LOOP_BJ { const f32x4 g = acc[ai][bj][m][0] * rs, up = acc[ai][bj][m][1] * rs; const f32x4 a = g * sigm4(g) * up;
                u32x2 w; w.x = cvt_pk_bf16(a[0], a[1]); w.y = cvt_pk_bf16(a[2], a[3]);
                *(u32x2*)(act + (size_t)row * FFH + cw + bj * 64) = w; } }
    }
};
struct EpiRes2 {
    static constexpr bool PERM = true, AFTER_DRAIN = false;
    bf16_t* hb;
    __device__ __forceinline__ void operator()(const f32x4 (&acc)[2][2][4][2], const Unit& u, int wr, int wc, int fr, int fq) const {
        const int cw = u.pn * BM + wc * 32 + 8 * fq;
        EPI_LOOP_AM { const int row = EPI_ROW(ai, m);
            EPI_LOOP_BJ { bf16_t* hp = hb + (size_t)row * DM + cw + bj * HALF; f32x4 h0, h1; unpack8(*(const u32x4*)hp, h0, h1);
                *(u32x4*)hp = pack8(h0 + acc[ai][bj][m][0], h1 + acc[ai][bj][m][1]); } }
    }
};
struct EpiEraw {
    static constexpr bool PERM = true, AFTER_DRAIN = false;
    bf16_t* er; float* ss;
    __device__ __forceinline__ void operator()(const f32x4 (&acc)[2][2][4][2], const Unit& u, int wr, int wc, int fr, int fq) const {
        const int cw = u.pn * BM + wc * 32 + 8 * fq;
        EPI_LOOP_AM { const int row = EPI_ROW(ai, m); float q = 0.f;
            EPI_LOOP_BJ { const int col = cw + bj * HALF; const f32x4 v0 = acc[ai][bj][m][0], v1 = acc[ai][bj][m][1];
                q += sum4(v0 * v0) + sum4(v1 * v1); *(u32x4*)(er + (size_t)row * DM + col) = pack8(v0, v1); }
            q += __shfl_xor(q, 16); q += __shfl_xor(q, 32);
            if (fq == 0) ss[(size_t)row * 16 + u.pn * 4 + wc] = q; }
    }
};
struct EpiPle {
    static constexpr bool PERM = true, AFTER_DRAIN = false;
    bf16_t* ob; const bf16_t* hb; const bf16_t* er; const float *sse, *pn; float* sso;
    __device__ __forceinline__ void operator()(const f32x4 (&acc)[2][2][4][2], const Unit& u, int wr, int wc, int fr, int fq) const {
        const int cw = u.pn * BM + wc * 32 + 8 * fq;
        EPI_LOOP_AM { const int row = EPI_ROW(ai, m); const float rs = row_rs(sse, row); float q = 0.f;
            EPI_LOOP_BJ { const int col = cw + bj * HALF; f32x4 e0, e1, h0, h1; unpack8(*(const u32x4*)(er + (size_t)row * DM + col), e0, e1); unpack8(*(const u32x4*)(hb + (size_t)row * DM + col), h0, h1);
                const f32x4 n0 = *(const f32x4*)(pn + col), n1 = *(const f32x4*)(pn + col + 4);
                const f32x4 v0 = h0 + sigm4(acc[ai][bj][m][0]) * (e0 * rs * n0), v1 = h1 + sigm4(acc[ai][bj][m][1]) * (e1 * rs * n1);
                *(u32x4*)(ob + (size_t)row * DM + col) = pack8(v0, v1);
                q += sum4(v0 * v0) + sum4(v1 * v1); }
            q += __shfl_xor(q, 16); q += __shfl_xor(q, 32);
            if (fq == 0) sso[(size_t)row * 16 + u.pn * 4 + wc] = q; }
    }
};
template <class Epi, class Sched, bool ALIGN_EPI = false, bool SP2 = false, int KC = 0>
__device__ __forceinline__ void gemm_phase(PG8_LAS unsigned char* lds, const Gemm g, const Sched& S, const Epi& E, const int wave_s) {
    int lane_ = (int)__builtin_amdgcn_mbcnt_hi(~0u, __builtin_amdgcn_mbcnt_lo(~0u, 0u)); asm volatile("" : "+v"(lane_));
    const int wid = wave_s, lane = lane_, tid = wid * 64 + lane, wr = wid >> 2, wc = wid & 3, fr = lane & 15, fq = lane >> 4;
    const int K = KC > 0 ? KC : g.K, nt = K / BK;
    unsigned voffA[2], voffB[2];
#pragma unroll
    for (int i = 0; i < 2; ++i) { int R, C; stage_rc(tid * 16 + i * 8192, R, C); const int Rb = Epi::PERM ? ((R & ~31) + perm32(R & 31)) : R;
        voffA[i] = (unsigned)(R * K + C) * 2u; voffB[i] = (unsigned)(Rb * K + C) * 2u; }
    const size_t kstep = (size_t)(BK * 2);
    const size_t hstep = (size_t)HALF * K * 2;
    const size_t tstep = 2 * hstep;
    const unsigned ldsw = (unsigned)wid * 1024u;
    const int aoff = lds_byte(wr * 64 + fr, fq * 8), boff = lds_byte(wc * 32 + fr, fq * 8);
#define PG8_SA(b, h) (((b) * 2 + (h)) * HTB)
#define PG8_SB(b, h) ((4 + (b) * 2 + (h)) * HTB)
#define PG8_STAGE(bufoff, gbase, voff) do { _Pragma("unroll") for (int _i = 0; _i < 2; ++_i) \
        __builtin_amdgcn_global_load_lds((const unsigned*)((const char*)(gbase) + (voff)[_i]), (PG8_LAS unsigned*)(lds + (bufoff) + ldsw + _i * 8192), 16, 0, 0); } while (0)
#define PG8_LDA(dst, b, h) do { _Pragma("unroll") for (int m = 0; m < 4; ++m) _Pragma("unroll") for (int k = 0; k < 2; ++k) dst[m][k] = *(const PG8_LAS bf16x8*)(lds + PG8_SA(b, h) + aoff + m * 2048 + k * 1024); } while (0)
#define PG8_LDB(dst, b, h) do { _Pragma("unroll") for (int n = 0; n < 2; ++n) _Pragma("unroll") for (int k = 0; k < 2; ++k) dst[n][k] = *(const PG8_LAS bf16x8*)(lds + PG8_SB(b, h) + boff + n * 2048 + k * 1024); } while (0)
#define PG8_MMA(ai, bj, At, Bt) do { __builtin_amdgcn_s_setprio(1); _Pragma("unroll") for (int m = 0; m < 4; ++m) _Pragma("unroll") for (int n = 0; n < 2; ++n) _Pragma("unroll") for (int k = 0; k < 2; ++k) \
        acc[ai][bj][m][n] = __builtin_amdgcn_mfma_f32_16x16x32_bf16(Bt[n][k], At[m][k], acc[ai][bj][m][n], 0, 0, 0); __builtin_amdgcn_s_setprio(0); } while (0)
#define PG8_WAIT_V(n) asm volatile("s_waitcnt vmcnt(" #n ")" ::: "memory")
#define PG8_WAIT_L(n) asm volatile("s_waitcnt lgkmcnt(" #n ")" ::: "memory")
#define PG8_BAR __builtin_amdgcn_s_barrier()
#define PG8_SCHED __builtin_amdgcn_sched_barrier(0)
    Unit cur, nxt; int ui = 0;
    if (!S.next(0, cur)) return;
    f32x4 acc[2][2][4][2];
#pragma unroll
    for (int a = 0; a < 2; ++a)
#pragma unroll
        for (int b = 0; b < 2; ++b)
#pragma unroll
            for (int m = 0; m < 4; ++m)
#pragma unroll
                for (int n = 0; n < 2; ++n) acc[a][b][m][n] = (f32x4){0.f, 0.f, 0.f, 0.f};
    bf16x8 At[4][2], B0[2][2], B1[2][2];
    const char* cA = (const char*)g.A + (size_t)cur.pm * tstep; const char* cB = (const char*)g.Bt + (size_t)cur.pn * tstep;
    S.a_ready(cur);
    if constexpr (SP2) {
        PG8_STAGE(PG8_SB(0, 0), cB, voffB); PG8_STAGE(PG8_SB(0, 1), cB + hstep, voffB); PG8_STAGE(PG8_SA(0, 0), cA, voffA); PG8_STAGE(PG8_SA(0, 1), cA + hstep, voffA);
        if (wr == 1) PG8_BAR;
        PG8_WAIT_V(2); PG8_BAR;
        PG8_STAGE(PG8_SB(1, 0), cB + kstep, voffB); PG8_STAGE(PG8_SA(1, 0), cA + kstep, voffA); PG8_STAGE(PG8_SB(1, 1), cB + hstep + kstep, voffB);
        PG8_WAIT_V(6); PG8_BAR;
    } else {
        PG8_STAGE(PG8_SB(0, 0), cB, voffB); PG8_STAGE(PG8_SA(0, 0), cA, voffA); PG8_STAGE(PG8_SB(0, 1), cB + hstep, voffB); PG8_STAGE(PG8_SA(0, 1), cA + hstep, voffA);
        if (wr == 1) PG8_BAR;
        PG8_WAIT_V(4); PG8_BAR;
        PG8_STAGE(PG8_SB(1, 0), cB + kstep, voffB); PG8_STAGE(PG8_SA(1, 0), cA + kstep, voffA); PG8_STAGE(PG8_SB(1, 1), cB + hstep + kstep, voffB);
        PG8_WAIT_V(6); PG8_BAR;
    }
    for (;;) {
        const bool has_next = S.next(ui + 1, nxt);
        const char* nA = has_next ? (const char*)g.A + (size_t)nxt.pm * tstep : cA; const char* nB = has_next ? (const char*)g.Bt + (size_t)nxt.pn * tstep : cB;
        for (int t = 0; t < nt; t += 2) {
            const bool last = (t == nt - 2);
            const char* a1 = cA + (size_t)(t + 1) * kstep;
            const char* a2 = last ? nA : cA + (size_t)(t + 2) * kstep; const char* b2 = last ? nB : cB + (size_t)(t + 2) * kstep;
            const char* a3 = a2 + kstep; const char* b3 = b2 + kstep;
            if (last && has_next) S.a_ready(nxt);
            if constexpr (SP2) {
            PG8_LDB(B0, 0, 0); PG8_LDB(B1, 0, 1); PG8_SCHED; PG8_LDA(At, 0, 0); PG8_STAGE(PG8_SA(1, 1), a1 + hstep, voffA);
            PG8_WAIT_V(8); PG8_WAIT_L(0); PG8_BAR; PG8_MMA(0, 0, At, B0); PG8_MMA(0, 1, At, B1); PG8_BAR; PG8_SCHED;
            PG8_LDA(At, 0, 1); PG8_STAGE(PG8_SB(0, 0), b2, voffB); PG8_STAGE(PG8_SB(0, 1), b2 + hstep, voffB); PG8_STAGE(PG8_SA(0, 0), a2, voffA);
            PG8_WAIT_V(8); PG8_WAIT_L(0); PG8_BAR; PG8_MMA(1, 0, At, B0); PG8_MMA(1, 1, At, B1); PG8_BAR; PG8_SCHED;
            PG8_LDB(B0, 1, 0); PG8_LDB(B1, 1, 1); PG8_SCHED; PG8_LDA(At, 1, 0); PG8_STAGE(PG8_SA(0, 1), a2 + hstep, voffA);
            PG8_WAIT_V(8); PG8_WAIT_L(0); PG8_BAR; PG8_MMA(0, 0, At, B0); PG8_MMA(0, 1, At, B1); PG8_BAR; PG8_SCHED;
            PG8_LDA(At, 1, 1); PG8_STAGE(PG8_SB(1, 0), b3, voffB); PG8_STAGE(PG8_SB(1, 1), b3 + hstep, voffB); PG8_STAGE(PG8_SA(1, 0), a3, voffA);
            PG8_WAIT_V(8); PG8_WAIT_L(0); PG8_BAR; PG8_MMA(1, 0, At, B0); PG8_MMA(1, 1, At, B1); PG8_BAR; PG8_SCHED;
            } else {
            PG8_LDB(B0, 0, 0); PG8_SCHED; PG8_LDA(At, 0, 0); PG8_STAGE(PG8_SA(1, 1), a1 + hstep, voffA);
            PG8_WAIT_L(8); PG8_BAR; PG8_WAIT_L(0); PG8_MMA(0, 0, At, B0); PG8_BAR; PG8_SCHED;
            PG8_LDB(B1, 0, 1); PG8_STAGE(PG8_SB(0, 0), b2, voffB);
            PG8_BAR; PG8_WAIT_L(0); PG8_MMA(0, 1, At, B1); PG8_BAR;
            PG8_LDA(At, 0, 1); PG8_STAGE(PG8_SA(0, 0), a2, voffA);
            PG8_BAR; PG8_WAIT_L(0); PG8_MMA(1, 0, At, B0); PG8_BAR; PG8_SCHED;
            PG8_STAGE(PG8_SB(0, 1), b2 + hstep, voffB);
            PG8_WAIT_V(6); PG8_BAR; PG8_MMA(1, 1, At, B1); PG8_BAR;
            PG8_LDB(B0, 1, 0); PG8_SCHED; PG8_LDA(At, 1, 0); PG8_STAGE(PG8_SA(0, 1), a2 + hstep, voffA);
            PG8_WAIT_L(8); PG8_BAR; PG8_WAIT_L(0); PG8_MMA(0, 0, At, B0); PG8_BAR; PG8_SCHED;
            PG8_LDB(B1, 1, 1); PG8_STAGE(PG8_SB(1, 0), b3, voffB);
            PG8_BAR; PG8_WAIT_L(0); PG8_MMA(0, 1, At, B1); PG8_BAR;
            PG8_LDA(At, 1, 1); PG8_STAGE(PG8_SA(1, 0), a3, voffA);
            PG8_BAR; PG8_WAIT_L(0); PG8_MMA(1, 0, At, B0); PG8_BAR; PG8_SCHED;
            PG8_STAGE(PG8_SB(1, 1), b3 + hstep, voffB);
            PG8_WAIT_V(6); PG8_BAR; PG8_MMA(1, 1, At, B1); PG8_BAR;
            }
        }
        if constexpr (ALIGN_EPI) { if (wr == 0) PG8_BAR; }
        if constexpr (!Epi::AFTER_DRAIN) { E(acc, cur, wr, wc, fr, fq); S.done(cur); }
        if (!has_next) break;
#pragma unroll
        for (int a = 0; a < 2; ++a)
#pragma unroll
            for (int b = 0; b < 2; ++b)
#pragma unroll
                for (int m = 0; m < 4; ++m)
#pragma unroll
                    for (int n = 0; n < 2; ++n) acc[a][b][m][n] = (f32x4){0.f, 0.f, 0.f, 0.f};
        cur = nxt; cA = nA; cB = nB; ++ui;
        if constexpr (ALIGN_EPI) { if (wr == 1) PG8_BAR; }
    }
    PG8_WAIT_V(0);
    if constexpr (!ALIGN_EPI) { if (wr == 0) PG8_BAR; }
    PG8_BAR;
    if constexpr (Epi::AFTER_DRAIN) { E.fused(acc, cur, wr, wc, fr, fq, lds, wid, lane); S.done(cur); }
#undef PG8_SA
#undef PG8_SB
#undef PG8_STAGE
#undef PG8_LDA
#undef PG8_LDB
#undef PG8_MMA
#undef PG8_WAIT_V
#undef PG8_WAIT_L
#undef PG8_BAR
#undef PG8_SCHED
}
}

using namespace pg8;
#define LAS __attribute__((address_space(3)))
typedef short s16x4 __attribute__((ext_vector_type(4)));
#ifndef N_LAUNCH
#define N_LAUNCH 1
#endif
constexpr int NPHASE = 9;
constexpr int LDS_BYTES = 135168;
constexpr size_t MiB = 1u << 20;
constexpr size_t WS_SS2 = 0, WS_SSE = 1310720, WS_SSO = 2621440, WS_ROPE = 3932160;
constexpr size_t WS_WIN = 6 * MiB, WS_WEFF = 14 * MiB, WS_WAB = 15 * MiB, WS_WOUT = 17 * MiB, WS_WFI = 19 * MiB, WS_WFO = 30 * MiB, WS_WPP = 35 * MiB + 524288, WS_WPG = 36 * MiB;
constexpr size_t WS_PB = 38 * MiB;
constexpr size_t WS_RA = 47 * MiB;
constexpr size_t WS_RG = 80 * MiB;
constexpr size_t WS_UB = 145 * MiB, WS_QB = 161 * MiB + 262144, WS_KB = 193 * MiB + 786432, WS_VB = 201 * MiB + 917504, WS_MB = 210 * MiB;
constexpr size_t WS_MG = WS_QB;
constexpr size_t WS_ACT = 145 * MiB;
constexpr size_t WS_END = 256 * MiB;
static_assert(WS_UB + (size_t)MPAD * 512 * 2 == WS_QB && WS_QB + (size_t)MPAD * 1024 * 2 == WS_KB && WS_KB + (size_t)MPAD * 256 * 2 == WS_VB && WS_VB + (size_t)MPAD * 256 * 2 == WS_MB, "ws map");
static_assert(WS_MB + (size_t)MPAD * 512 * 2 <= WS_END && WS_ACT + (size_t)MPAD * FFH * 2 <= WS_END && WS_RA + (size_t)MPAD * 2048 <= WS_RG && WS_RG + (size_t)MPAD * 4096 <= WS_UB && WS_PB + (size_t)MPAD * 512 <= WS_RA, "ws map 2");
static_assert(WS_ROPE + 8193 * 64 <= WS_WIN && (size_t)MPAD * 64 <= WS_SSE, "ws map 3");

__device__ const float ROPE_INV[8] = {1.0f, 0.19392274474868576f, 0.03760603093086393f, 0.007292664737217109f, 0.001414213562373095f, 0.0002742481756762073f, 5.318295896944988e-05f, 1.031338537721246e-05f};

__device__ __forceinline__ unsigned f2bf(float f) { unsigned u = __builtin_bit_cast(unsigned, f); return (u + 0x7fffu + ((u >> 16) & 1u)) >> 16; }
__device__ __forceinline__ unsigned pk2(float lo, float hi) { return f2bf(lo) | (f2bf(hi) << 16); }
__device__ __forceinline__ float wave_sum(float v) {
#pragma unroll
    for (int o = 1; o < 64; o <<= 1) v += __shfl_xor(v, o);
    return v;
}
__device__ __forceinline__ float wave_max(float v) {
#pragma unroll
    for (int o = 1; o < 64; o <<= 1) v = fmaxf(v, __shfl_xor(v, o));
    return v;
}
#define LDS_WAIT() asm volatile("s_waitcnt lgkmcnt(0)" ::: "memory")

struct Args { const float* in[22]; float* out; unsigned char* ws; int ph_lo, ph_hi; };
typedef const float* cfp_t;
__device__ __forceinline__ cfp_t karg_in(int k) { const __attribute__((address_space(4))) char* kp = (const __attribute__((address_space(4))) char*)__builtin_amdgcn_kernarg_segment_ptr(); return *(const volatile __attribute__((address_space(4))) cfp_t*)(kp + 8 * k); }
__device__ __forceinline__ float* karg_out() { return (float*)karg_in(22); }
__device__ __forceinline__ unsigned char* karg_ws() { return (unsigned char*)karg_in(23); }
struct TItem { const float* W; bf16_t* WT; int K, N, mode, r; };
__device__ __forceinline__ TItem p0_item(unsigned char* ws, int it) {
    constexpr int I_IN = 16 * 128, I_AB = 16 * 32, I_OUT = 16 * 32, I_FI = 16 * 176, I_FO = 44 * 32, I_PP = 4 * 32;
    int r = it;
    if (r < I_IN) return TItem{karg_in(8), (bf16_t*)(ws + WS_WIN), 1024, INC, 0, r}; r -= I_IN;
    if (r < I_AB) return TItem{karg_in(13), (bf16_t*)(ws + WS_WAB), 1024, 1024, 0, r}; r -= I_AB;
    if (r < I_OUT) return TItem{karg_in(14), (bf16_t*)(ws + WS_WOUT), 1024, 1024, 0, r}; r -= I_OUT;
    if (r < I_FI) return TItem{karg_in(16), (bf16_t*)(ws + WS_WFI), 1024, 2 * FFH, 1, r}; r -= I_FI;
    if (r < I_FO) return TItem{karg_in(17), (bf16_t*)(ws + WS_WFO), FFH, 1024, 0, r}; r -= I_FO;
    if (r < I_PP) return TItem{karg_in(18), (bf16_t*)(ws + WS_WPP), PLE, 1024, 0, r}; r -= I_PP;
    return TItem{karg_in(20), (bf16_t*)(ws + WS_WPG), 1024, 1024, 0, r};
}
__device__ __forceinline__ void p0_item_load(const TItem& t, float (&wv)[32], int lane) {
    const int nblk = t.N / 32, kb = t.r / nblk, nb = t.r % nblk, k0 = 64 * kb, n0 = 32 * nb;
#pragma unroll
    for (int i = 0; i < 32; ++i) wv[i] = __builtin_nontemporal_load(t.W + (size_t)(k0 + 2 * i + (lane >> 5)) * t.N + n0 + (lane & 31));
}
__device__ __forceinline__ void p0_item_finish(const TItem& t, const float (&wv)[32], LAS float* scr, int lane, const float* kscale) {
    const int nblk = t.N / 32, kb = t.r / nblk, nb = t.r % nblk, k0 = 64 * kb, n0 = 32 * nb;
    if (t.mode == 1) {
#pragma unroll
        for (int i = 0; i < 32; ++i) scr[(2 * i + (lane >> 5)) * 33 + (lane & 31)] = wv[i] * kscale[k0 + 2 * i + (lane >> 5)];
    } else {
#pragma unroll
        for (int i = 0; i < 32; ++i) scr[(2 * i + (lane >> 5)) * 33 + (lane & 31)] = wv[i];
    }
    LDS_WAIT();
    const int c = lane & 7;
#pragma unroll
    for (int j = 0; j < 4; ++j) { const int n = (lane >> 3) + 8 * j; const LAS float* s = scr + (8 * c) * 33 + n;
        u32x4 o; o.x = pk2(s[0 * 33], s[1 * 33]); o.y = pk2(s[2 * 33], s[3 * 33]); o.z = pk2(s[4 * 33], s[5 * 33]); o.w = pk2(s[6 * 33], s[7 * 33]);
        int nn = n0 + n;
        if (t.mode == 1) { const int up = nn >= FFH ? 1 : 0; const int jj = nn - up * FFH; nn = 8 * (jj >> 2) + 4 * up + (jj & 3); }
        *(u32x4*)(t.WT + (size_t)nn * t.K + k0 + 8 * c) = o; }
    LDS_WAIT();
}
__device__ __forceinline__ void rms_row_to_bf16(const float* xrow, const float* gamma, bf16_t* orow, int lane) {
    const f32x4* xr = (const f32x4*)xrow + lane; f32x4 v[4]; float s = 0.f;
#pragma unroll
    for (int j = 0; j < 4; ++j) { v[j] = xr[64 * j]; s += sum4(v[j] * v[j]); }
    const float rs = rsqrtf(wave_sum(s) * (1.0f / DM) + EPS);
    u32x2* o8 = (u32x2*)orow + lane;
#pragma unroll
    for (int j = 0; j < 4; ++j) { const f32x4 g = ((const f32x4*)gamma)[lane + 64 * j]; const f32x4 y = v[j] * rs * g; u32x2 w; w.x = pk2(y[0], y[1]); w.y = pk2(y[2], y[3]); o8[64 * j] = w; }
}


template <int PART>
__device__ __forceinline__ void p0_prologue(LAS unsigned char* lds, int tid, int wave, int lane, int cidx, int cnum) {
    unsigned char* ws = karg_ws(); float* const aout = karg_out(); (void)aout;
    LAS float* scr = (LAS float*)(lds + wave * 16384);
    const int gw = cidx * 8 + wave, NGW = cnum * 8;
    const int gt = cidx * 512 + tid, NGT = cnum * 512;
    constexpr int I_IN = 16 * 128, I_AB = 16 * 32, I_OUT = 16 * 32, I_FI = 16 * 176, I_FO = 44 * 32, I_PP = 4 * 32, I_PG = 16 * 32;
    constexpr int NITEMS = I_IN + I_AB + I_OUT + I_FI + I_FO + I_PP + I_PG;
    {
        const int it_end = (PART == 0 ? I_IN : NITEMS); int it = (PART == 0 ? gw : I_IN + gw); const float* const ln2_ = karg_in(15);
        if (it < it_end) {
            TItem cur = p0_item(ws, it); float wv[32]; p0_item_load(cur, wv, lane);
            for (;;) {
                const int nx = it + NGW; const bool more = nx < it_end; TItem nxt = cur; float wn[32];
                if (more) { nxt = p0_item(ws, nx); p0_item_load(nxt, wn, lane); }
                p0_item_finish(cur, wv, scr, lane, ln2_);
                if (!more) break;
                cur = nxt; it = nx;
#pragma unroll
                for (int i = 0; i < 32; ++i) wv[i] = wn[i];
            }
        }
    }
    if (PART == 1) {
        const float* gwt = karg_in(9); const float* sc = karg_in(10); const float* wpb = karg_in(12); bf16_t* weff = (bf16_t*)(ws + WS_WEFF);
        const int fr = lane & 15, fq = lane >> 4;
        for (int t = gw; t < 4 * 8 * 64; t += NGW) {
            const int nt = t & 63, kt = (t >> 6) & 7, g = t >> 9;
            const float* ga = gwt + (size_t)(g * 128 + kt * 16 + fr) * 128 + fq * 8;
            const float* wb = wpb + (size_t)(g * 128 + fq * 8) * 1024 + nt * 16 + fr;
            const float* sg = sc + g * 128 + fq * 8;
            f32x4 a0[4], a1[4]; float bv[4][8], sv[4][8];
#pragma unroll
            for (int cs = 0; cs < 4; ++cs) { a0[cs] = *(const f32x4*)(ga + cs * 32); a1[cs] = *(const f32x4*)(ga + cs * 32 + 4);
#pragma unroll
                for (int e = 0; e < 8; ++e) { bv[cs][e] = wb[(size_t)(cs * 32 + e) * 1024]; sv[cs][e] = sg[cs * 32 + e]; } }
            f32x4 acc = {0.f, 0.f, 0.f, 0.f};
#pragma unroll
            for (int cs = 0; cs < 4; ++cs) {
                u32x4 aw; aw.x = pk2(a0[cs][0], a0[cs][1]); aw.y = pk2(a0[cs][2], a0[cs][3]); aw.z = pk2(a1[cs][0], a1[cs][1]); aw.w = pk2(a1[cs][2], a1[cs][3]);
                u32x4 bw; bw.x = pk2(bv[cs][0] * sv[cs][0], bv[cs][1] * sv[cs][1]); bw.y = pk2(bv[cs][2] * sv[cs][2], bv[cs][3] * sv[cs][3]); bw.z = pk2(bv[cs][4] * sv[cs][4], bv[cs][5] * sv[cs][5]); bw.w = pk2(bv[cs][6] * sv[cs][6], bv[cs][7] * sv[cs][7]);
                acc = __builtin_amdgcn_mfma_f32_16x16x32_bf16(__builtin_bit_cast(bf16x8, aw), __builtin_bit_cast(bf16x8, bw), acc, 0, 0, 0); }
            u32x2 o; o.x = pk2(acc[0], acc[1]); o.y = pk2(acc[2], acc[3]);
            *(u32x2*)(weff + (size_t)(nt * 16 + fr) * 512 + g * 128 + kt * 16 + 4 * fq) = o;
        }
    }
    if (PART == 0) { const float* const xp_ = karg_in(0); const float* const xs_ = karg_in(1); const float* const ln1_ = karg_in(7);
    for (int m = gw * 2; m < MREAL; m += NGW * 2) {
        const int m1 = m + 1;
        const f32x4* x0 = (const f32x4*)(m < MPR ? xp_ + (size_t)m * DM : xs_ + (size_t)(m - MPR) * DM) + lane;
        const f32x4* x1 = (const f32x4*)(m1 < MPR ? xp_ + (size_t)m1 * DM : xs_ + (size_t)(m1 - MPR) * DM) + lane;
        f32x4 v0[4], v1[4]; float s0 = 0.f, s1 = 0.f;
#pragma unroll
        for (int j = 0; j < 4; ++j) { v0[j] = __builtin_nontemporal_load(x0 + 64 * j); v1[j] = __builtin_nontemporal_load(x1 + 64 * j); }
#pragma unroll
        for (int j = 0; j < 4; ++j) { s0 += sum4(v0[j] * v0[j]); s1 += sum4(v1[j] * v1[j]); }
        const float r0 = rsqrtf(wave_sum(s0) * (1.0f / DM) + EPS), r1 = rsqrtf(wave_sum(s1) * (1.0f / DM) + EPS);
        u32x2* o0 = (u32x2*)((bf16_t*)(ws + WS_RA) + (size_t)m * DM) + lane; u32x2* o1 = (u32x2*)((bf16_t*)(ws + WS_RA) + (size_t)m1 * DM) + lane;
#pragma unroll
        for (int j = 0; j < 4; ++j) { const f32x4 g = ((const f32x4*)ln1_)[lane + 64 * j]; const f32x4 y0 = v0[j] * r0 * g, y1 = v1[j] * r1 * g;
            u32x2 w0, w1; w0.x = pk2(y0[0], y0[1]); w0.y = pk2(y0[2], y0[3]); w1.x = pk2(y1[0], y1[1]); w1.y = pk2(y1[2], y1[3]); o0[64 * j] = w0; o1[64 * j] = w1; }
    } }
    if (PART == 1) { const float* const pp_ = karg_in(2); const float* const ps_ = karg_in(3);
    for (int idx0 = gt; idx0 < MREAL * 32; idx0 += NGT * 4) {
        f32x4 v0[4], v1[4];
#pragma unroll
        for (int q = 0; q < 4; ++q) { const int idx = idx0 + q * NGT; if (idx < MREAL * 32) { const int m = idx >> 5, c = (idx & 31) * 8; const float* pr = (m < MPR ? pp_ + (size_t)m * PLE : ps_ + (size_t)(m - MPR) * PLE) + c; v0[q] = __builtin_nontemporal_load((const f32x4*)pr); v1[q] = __builtin_nontemporal_load((const f32x4*)(pr + 4)); } }
#pragma unroll
        for (int q = 0; q < 4; ++q) { const int idx = idx0 + q * NGT; if (idx < MREAL * 32) { const int m = idx >> 5, c = (idx & 31) * 8;
            u32x4 w; w.x = pk2(v0[q][0], v0[q][1]); w.y = pk2(v0[q][2], v0[q][3]); w.z = pk2(v1[q][0], v1[q][1]); w.w = pk2(v1[q][2], v1[q][3]);
            *(u32x4*)((bf16_t*)(ws + WS_PB) + (size_t)m * PLE + c) = w; } }
    } }
    if (PART == 0) for (int idx = gt; idx < 8193 * 8; idx += NGT) {
        const int pi = idx >> 3, i = idx & 7; const float pos = pi < SEQ ? (float)pi : 16384.0f; const float ang = pos * ROPE_INV[i];
        const double tw = 6.283185307179586476925; const double kq = __builtin_rint((double)ang * (1.0 / tw)); const float r = (float)((double)ang - kq * tw);
        float* rp = (float*)(ws + WS_ROPE) + (size_t)pi * 16; rp[i] = __cosf(r); rp[8 + i] = __sinf(r);
    }
    if (PART == 1) { const float* const st_ = karg_in(6);
    for (int idx = gt; idx < MSM * 14 * 128; idx += NGT) {
        const int b = idx / (14 * 128), rem = idx % (14 * 128), r = rem >> 7, c = (rem & 127) * 4;
        *(f32x4*)(aout + O_NPS + ((size_t)b * 15 + r) * 512 + c) = *(const f32x4*)(st_ + ((size_t)b * 15 + r + 1) * 512 + c);
    } }
}

__device__ __forceinline__ f32x4 ld4bf(const bf16_t* p) { const u32x2 w = *(const u32x2*)p; return (f32x4){bflo(w.x), bfhi(w.x), bflo(w.y), bfhi(w.y)}; }
__device__ __forceinline__ f32x4 mfma16(const bf16x8 a, const bf16x8 b, const f32x4 c) { return __builtin_amdgcn_mfma_f32_16x16x32_bf16(a, b, c, 0, 0, 0); }

struct KVRegs { u32x4 k[4], v[4]; };
__device__ __forceinline__ void attn_kv_load(KVRegs& r, int unit, const bf16_t* kb, const bf16_t* vb, int tid) {
    const int kvh = unit & 3, nb = (unit >> 2) & 63, b = unit >> 8, R0 = b * SEQ + nb * 128;
#pragma unroll
    for (int i = 0; i < 4; ++i) { const int c = tid + 512 * i, s = c >> 3, seg = c & 7; const bool ok = (nb > 0) || (s >= 128);
        r.k[i] = (u32x4){0u, 0u, 0u, 0u}; r.v[i] = (u32x4){0u, 0u, 0u, 0u};
        if (ok) { const size_t go = (size_t)(R0 - 128 + s) * 256 + kvh * 64 + seg * 8; r.k[i] = *(const u32x4*)(kb + go); r.v[i] = *(const u32x4*)(vb + go); } }
}
__device__ __forceinline__ void attn_kv_store(const KVRegs& r, LAS unsigned char* lds, int tid) {
    LAS bf16_t* Ks = (LAS bf16_t*)lds; LAS bf16_t* Vt = (LAS bf16_t*)(lds + 256 * 72 * 2);
#pragma unroll
    for (int i = 0; i < 4; ++i) { const int c = tid + 512 * i, s = c >> 3, seg = c & 7;
        *(LAS u32x4*)(Ks + s * 72 + seg * 8) = r.k[i];
        LAS bf16_t* vp = Vt + (seg * 8) * 264 + (s ^ (seg * 8)); const u32x4 vv = r.v[i];
        vp[0 * 264] = (bf16_t)(vv.x & 0xffffu); vp[1 * 264] = (bf16_t)(vv.x >> 16); vp[2 * 264] = (bf16_t)(vv.y & 0xffffu); vp[3 * 264] = (bf16_t)(vv.y >> 16);
        vp[4 * 264] = (bf16_t)(vv.z & 0xffffu); vp[5 * 264] = (bf16_t)(vv.z >> 16); vp[6 * 264] = (bf16_t)(vv.w & 0xffffu); vp[7 * 264] = (bf16_t)(vv.w >> 16); }
}
__device__ __forceinline__ void attn_prompt_math(LAS unsigned char* lds, int unit, const bf16_t* qb, bf16_t* ob, const float* sinks, int wave, int lane) {
    const int kvh = unit & 3, nb = (unit >> 2) & 63, b = unit >> 8, R0 = b * SEQ + nb * 128;
    const LAS bf16_t* Ks = (const LAS bf16_t*)lds; const LAS bf16_t* Vt = (const LAS bf16_t*)(lds + 256 * 72 * 2);
    const int g = wave >> 1, half = wave & 1, h = kvh * 4 + g, fr = lane & 15, fq = lane >> 4;
    const float sink = sinks[h];
    bf16x8 qf[4][2];
#pragma unroll
    for (int sb = 0; sb < 4; ++sb) { const bf16_t* qp = qb + (size_t)(R0 + half * 64 + sb * 16 + fr) * 1024 + h * 64 + fq * 8; qf[sb][0] = *(const bf16x8*)qp; qf[sb][1] = *(const bf16x8*)(qp + 32); }
#pragma unroll
    for (int sb = 0; sb < 4; ++sb) {
        const int qi0 = half * 64 + sb * 16, kt0 = qi0 >> 4, q = qi0 + fr;
        f32x4 S[9];
#pragma unroll
        for (int j = 0; j < 9; ++j) { const LAS bf16_t* kp = Ks + ((kt0 + j) * 16 + fr) * 72 + fq * 8;
            f32x4 acc = {0.f, 0.f, 0.f, 0.f}; acc = mfma16(*(const LAS bf16x8*)kp, qf[sb][0], acc); acc = mfma16(*(const LAS bf16x8*)(kp + 32), qf[sb][1], acc); S[j] = acc; }
        float mx = sink; const int e = fr - 4 * fq;
#pragma unroll
        for (int j = 0; j < 9; ++j) { const bool tok = (nb > 0) || (kt0 + j >= 8);
#pragma unroll
            for (int jj = 0; jj < 4; ++jj) { bool valid = tok; if (j == 0) valid = valid && (e < jj); if (j == 8) valid = valid && (e >= jj);
                const float v = valid ? S[j][jj] : -1e30f; S[j][jj] = v; mx = fmaxf(mx, v); } }
        mx = fmaxf(mx, __shfl_xor(mx, 16)); mx = fmaxf(mx, __shfl_xor(mx, 32));
        float l = 0.f;
#pragma unroll
        for (int j = 0; j < 9; ++j)
#pragma unroll
            for (int jj = 0; jj < 4; ++jj) { const float p = __expf(S[j][jj] - mx); S[j][jj] = p; l += p; }
        l += __shfl_xor(l, 16); l += __shfl_xor(l, 32); l += __expf(sink - mx);
        const float inv = 1.0f / l;
        f32x4 O[4];
#pragma unroll
        for (int dt = 0; dt < 4; ++dt) O[dt] = (f32x4){0.f, 0.f, 0.f, 0.f};
#pragma unroll
        for (int jp = 0; jp < 5; ++jp) {
            u32x4 pw; pw.x = cvt_pk_bf16_v(S[2 * jp][0], S[2 * jp][1]); pw.y = cvt_pk_bf16_v(S[2 * jp][2], S[2 * jp][3]);
            if (jp < 4) { pw.z = cvt_pk_bf16_v(S[2 * jp + 1 < 9 ? 2 * jp + 1 : 8][0], S[2 * jp + 1 < 9 ? 2 * jp + 1 : 8][1]); pw.w = cvt_pk_bf16_v(S[2 * jp + 1 < 9 ? 2 * jp + 1 : 8][2], S[2 * jp + 1 < 9 ? 2 * jp + 1 : 8][3]); } else { pw.z = 0u; pw.w = 0u; }
            const bf16x8 pf = __builtin_bit_cast(bf16x8, pw);
#pragma unroll
            for (int dt = 0; dt < 4; ++dt) { const int d = dt * 16 + fr, sw = ((d >> 3) & 7) * 8, s0 = (kt0 + 2 * jp) * 16 + fq * 4; const LAS bf16_t* vr = Vt + d * 264;
                const s16x4 lo = *(const LAS s16x4*)(vr + (s0 ^ sw)); s16x4 hi = {0, 0, 0, 0}; if (jp < 4) hi = *(const LAS s16x4*)(vr + ((s0 + 16) ^ sw));
                const bf16x8 vf = {lo[0], lo[1], lo[2], lo[3], hi[0], hi[1], hi[2], hi[3]};
                O[dt] = mfma16(vf, pf, O[dt]); }
        }
        bf16_t* op = ob + (size_t)(R0 + q) * 1024 + h * 64 + fq * 4;
#pragma unroll
        for (int dt = 0; dt < 4; ++dt) { const f32x4 o = O[dt] * inv; u32x2 w; w.x = cvt_pk_bf16(o[0], o[1]); w.y = cvt_pk_bf16(o[2], o[3]); *(u32x2*)(op + dt * 16) = w; }
    }
}
__device__ __forceinline__ void attn_prompt_all(LAS unsigned char* lds, const bf16_t* qb, const bf16_t* kb, const bf16_t* vb, bf16_t* ob, const float* sinks, int tid, int wave, int lane) {
    const int G = gridDim.x; int unit = blockIdx.x; if (unit >= 512) return;
    KVRegs r; attn_kv_load(r, unit, kb, vb, tid);
    for (;;) {
        attn_kv_store(r, lds, tid);
        __syncthreads();
        const int nxt = unit + G;
        if (nxt < 512) attn_kv_load(r, nxt, kb, vb, tid);
        attn_prompt_math(lds, unit, qb, ob, sinks, wave, lane);
        __syncthreads();
        if (nxt >= 512) break;
        unit = nxt;
    }
}

__device__ __forceinline__ void attn_sample_unit(LAS unsigned char* lds, int unit, const bf16_t* qb, const bf16_t* kb, const bf16_t* vb, bf16_t* ob, const float* cache_k, const float* cache_v, const float* sinks, float* out, int tid, int wave, int lane) {
    const int kvh = unit & 3, b = unit >> 2; const size_t row = MPR + b;
    LAS float* sc = (LAS float*)lds;
    LAS float* lsum = sc + 4 * 132;
    LAS float* opart = sc + 4 * 132 + 16;
    const int jq = lane >> 4, dq = lane & 15;
    f32x4 qv[4];
#pragma unroll
    for (int g = 0; g < 4; ++g) qv[g] = ld4bf(qb + row * 1024 + (kvh * 4 + g) * 64 + dq * 4);
    f32x4 kv[4], vv[4];
#pragma unroll
    for (int i = 0; i < 4; ++i) { const int j = wave * 16 + i * 4 + jq; const size_t off = ((size_t)(b * 128 + j) * 4 + kvh) * 64 + dq * 4;
        kv[i] = __builtin_nontemporal_load((const f32x4*)(cache_k + off)); vv[i] = __builtin_nontemporal_load((const f32x4*)(cache_v + off)); }
    const f32x4 knew = ld4bf(kb + row * 256 + kvh * 64 + dq * 4);
#pragma unroll
    for (int i = 0; i < 4; ++i) { const int j = wave * 16 + i * 4 + jq;
        if (j >= 1) { const size_t off = ((size_t)(b * 128 + j - 1) * 4 + kvh) * 64 + dq * 4; __builtin_nontemporal_store(kv[i], (f32x4*)(out + O_NKS + off)); __builtin_nontemporal_store(vv[i], (f32x4*)(out + O_NVS + off)); } }
#pragma unroll
    for (int i = 0; i < 5; ++i) { const f32x4 kk = i < 4 ? kv[i < 4 ? i : 0] : knew; float mine = 0.f;
#pragma unroll
        for (int g = 0; g < 4; ++g) { float p = sum4(kk * qv[g]); p += __shfl_xor(p, 1); p += __shfl_xor(p, 2); p += __shfl_xor(p, 4); p += __shfl_xor(p, 8); if (dq == g) mine = p; }
        if (i < 4) { if (dq < 4) sc[dq * 132 + wave * 16 + i * 4 + jq] = mine; }
        else if (wave == 0 && jq == 0 && dq < 4) sc[dq * 132 + 128] = mine; }
    __syncthreads();
    if (wave < 4) { const int g = wave; float a = sc[g * 132 + lane]; const float b2 = sc[g * 132 + 64 + lane], n = sc[g * 132 + 128], sink = sinks[kvh * 4 + g];
        if (lane == 0) a = -1e30f;
        const float mx = fmaxf(fmaxf(wave_max(fmaxf(a, b2)), n), sink);
        const float pa = __expf(a - mx), pb = __expf(b2 - mx), pnw = __expf(n - mx); const float l = wave_sum(pa + pb) + pnw + __expf(sink - mx);
        sc[g * 132 + lane] = pa; sc[g * 132 + 64 + lane] = pb; if (lane == 0) { sc[g * 132 + 128] = pnw; lsum[g] = 1.0f / l; } }
    __syncthreads();
    f32x4 o[4];
#pragma unroll
    for (int g = 0; g < 4; ++g) o[g] = (f32x4){0.f, 0.f, 0.f, 0.f};
#pragma unroll
    for (int i = 0; i < 4; ++i) { const int j = wave * 16 + i * 4 + jq;
#pragma unroll
        for (int g = 0; g < 4; ++g) o[g] += vv[i] * sc[g * 132 + j]; }
#pragma unroll
    for (int g = 0; g < 4; ++g)
#pragma unroll
        for (int e = 0; e < 4; ++e) { float t = o[g][e]; t += __shfl_xor(t, 16); t += __shfl_xor(t, 32); o[g][e] = t; }
    if (jq == 0) {
#pragma unroll
        for (int g = 0; g < 4; ++g) *(LAS f32x4*)(opart + (wave * 4 + g) * 64 + dq * 4) = o[g]; }
    __syncthreads();
    if (tid < 256) { const int g = tid >> 6, d = tid & 63; float acc = 0.f;
#pragma unroll
        for (int w = 0; w < 8; ++w) acc += opart[(w * 4 + g) * 64 + d];
        acc += sc[g * 132 + 128] * bflo((unsigned)vb[row * 256 + kvh * 64 + d]);
        ob[row * 1024 + (kvh * 4 + g) * 64 + d] = (bf16_t)f2bf(acc * lsum[g]); }
    __syncthreads();
}

template <int W>
__device__ __forceinline__ void pool_item(const bf16_t* __restrict__ ub, bf16_t* __restrict__ mb, const float* __restrict__ state, int row, int ch) {
    f32x4 u0, u1; unpack8(*(const u32x4*)(ub + (size_t)row * 512 + ch), u0, u1);
    f32x4 s0 = u0, s1 = u1; float cnt;
    if (row < MPR) { const int t = row & (SEQ - 1); cnt = (float)((t + 1 < W) ? t + 1 : W);
        u32x4 w[W - 1];
#pragma unroll
        for (int i = 1; i < W; ++i) { w[i - 1] = (u32x4){0u, 0u, 0u, 0u}; if (i <= t) w[i - 1] = *(const u32x4*)(ub + (size_t)(row - i) * 512 + ch); }
#pragma unroll
        for (int i = 1; i < W; ++i) { f32x4 a0, a1; unpack8(w[i - 1], a0, a1); s0 += a0; s1 += a1; } }
    else { const int b = row - MPR; cnt = (float)W;
#pragma unroll
        for (int i = 1; i < W; ++i) { const float* sp = state + ((size_t)b * 15 + 15 - i) * 512 + ch; s0 += *(const f32x4*)sp; s1 += *(const f32x4*)(sp + 4); } }
    const float ic = 1.0f / cnt;
    *(u32x4*)(mb + (size_t)row * 512 + ch) = pack8(s0 * ic - u0, s1 * ic - u1);
}
template <int W>
__device__ __forceinline__ void pool_block4(const bf16_t* __restrict__ ub, bf16_t* __restrict__ mb, const float* __restrict__ state, int row0, int ch) {
    if (row0 >= MPR) {
#pragma unroll
        for (int r = 0; r < 4; ++r) pool_item<W>(ub, mb, state, row0 + r, ch);
        return;
    }
    const int t0 = row0 & (SEQ - 1);
    u32x4 w[W + 3];
#pragma unroll
    for (int j = 0; j < W + 3; ++j) { w[j] = (u32x4){0u, 0u, 0u, 0u}; if (t0 + j - (W - 1) >= 0) w[j] = *(const u32x4*)(ub + (size_t)(row0 + j - (W - 1)) * 512 + ch); }
    f32x4 s0 = {0.f, 0.f, 0.f, 0.f}, s1 = {0.f, 0.f, 0.f, 0.f};
#pragma unroll
    for (int j = 0; j < W - 1; ++j) { f32x4 a0, a1; unpack8(w[j], a0, a1); s0 += a0; s1 += a1; }
#pragma unroll
    for (int r = 0; r < 4; ++r) {
        f32x4 u0, u1; unpack8(w[W - 1 + r], u0, u1); s0 += u0; s1 += u1;
        const int n = (t0 + r + 1 < W) ? t0 + r + 1 : W; const float ic = 1.0f / (float)n;
        *(u32x4*)(mb + (size_t)(row0 + r) * 512 + ch) = pack8(s0 * ic - u0, s1 * ic - u1);
        f32x4 o0, o1; unpack8(w[r], o0, o1); s0 -= o0; s1 -= o1;
    }
}
__device__ __forceinline__ void pool_items(unsigned char* ws, const float* __restrict__ state, int tid) {
    const bf16_t* __restrict__ ub = (const bf16_t*)(ws + WS_UB); bf16_t* __restrict__ mb = (bf16_t*)(ws + WS_MB);
    for (int idx = blockIdx.x * 512 + tid; idx < (MREAL / 4) * 64; idx += gridDim.x * 512) {
        const int cgk = idx & 15, g = (idx >> 6) & 3, rb = (idx >> 8) * 4 + ((idx >> 4) & 3), row0 = rb * 4, ch = g * 128 + cgk * 8;
        if (g == 0) pool_block4<2>(ub, mb, state, row0, ch); else if (g == 1) pool_block4<4>(ub, mb, state, row0, ch); else if (g == 2) pool_block4<8>(ub, mb, state, row0, ch); else pool_block4<16>(ub, mb, state, row0, ch);
    }
}

template <int K, class F>
__device__ __forceinline__ void skinny_gemm(LAS unsigned char* lds, const bf16_t* A, const bf16_t* Bt, int wave, int lane, const F& f) {
    constexpr int KQ = K / 4;
    const int fr = lane & 15, fq = lane >> 4, ks = wave & 3;
    for (int tp = blockIdx.x; tp < 256; tp += gridDim.x) {
        const int t = tp * 2 + (wave >> 2), cb = t & 63, rb = t >> 6;
        const bf16_t* ap = A + (size_t)(rb * 16 + fr) * K + ks * KQ + fq * 8;
        const bf16_t* bp = Bt + (size_t)(cb * 16 + fr) * K + ks * KQ + fq * 8;
        f32x4 acc = {0.f, 0.f, 0.f, 0.f};
#pragma unroll 8
        for (int k = 0; k < KQ; k += 32) acc = mfma16(*(const bf16x8*)(bp + k), *(const bf16x8*)(ap + k), acc);
        LAS f32x4* red = (LAS f32x4*)lds;
        red[wave * 64 + lane] = acc;
        __syncthreads();
        if (ks == 0) { acc = (red[wave * 64 + lane] + red[(wave + 1) * 64 + lane]) + (red[(wave + 2) * 64 + lane] + red[(wave + 3) * 64 + lane]);
            f(MPR + rb * 16 + fr, cb * 16 + fq * 4, acc, fq, cb); }
        __syncthreads();
    }
}
__device__ __forceinline__ void st4bf(bf16_t* p, const f32x4 v) { u32x2 w; w.x = cvt_pk_bf16(v[0], v[1]); w.y = cvt_pk_bf16(v[2], v[3]); *(u32x2*)p = w; }
__device__ __forceinline__ void ss_part(float* ss, int row, int cb, int fq, float q) { q += __shfl_xor(q, 16); q += __shfl_xor(q, 32); if (fq == 0) ss[(size_t)MPR * 16 + (size_t)(row - MPR) * 64 + cb] = q; }
struct SMergeA { bf16_t* mg; const bf16_t* gb;
    __device__ __forceinline__ void operator()(int row, int col, f32x4 v, int, int) const { st4bf(mg + (size_t)row * DM + col, ld4bf(gb + (size_t)row * 2048 + col) * v); } };
struct SMergeB { bf16_t* mg; const bf16_t* gb;
    __device__ __forceinline__ void operator()(int row, int col, f32x4 v, int, int) const { bf16_t* p = mg + (size_t)row * DM + col; st4bf(p, ld4bf(p) + ld4bf(gb + (size_t)row * 2048 + 1024 + col) * v); } };
struct SRes1 { const float *xs; bf16_t* hb; float* ss;
    __device__ __forceinline__ void operator()(int row, int col, f32x4 v, int fq, int cb) const {
        v += *(const f32x4*)(xs + (size_t)(row - MPR) * DM + col); st4bf(hb + (size_t)row * DM + col, v); ss_part(ss, row, cb, fq, sum4(v * v)); } };
struct SRes2 { bf16_t* hb;
    __device__ __forceinline__ void operator()(int row, int col, f32x4 v, int, int) const { bf16_t* hp = hb + (size_t)row * DM + col; st4bf(hp, ld4bf(hp) + v); } };
struct SEraw { bf16_t* er; float* ss;
    __device__ __forceinline__ void operator()(int row, int col, f32x4 v, int fq, int cb) const { st4bf(er + (size_t)row * DM + col, v); ss_part(ss, row, cb, fq, sum4(v * v)); } };
struct SPle { bf16_t* ob; const bf16_t* hb; const bf16_t* er; const float *sse, *pn; float* sso;
    __device__ __forceinline__ void operator()(int row, int col, f32x4 v, int fq, int cb) const {
        const float rs = row_rs(sse, row);
        v = ld4bf(hb + (size_t)row * DM + col) + sigm4(v) * (ld4bf(er + (size_t)row * DM + col) * rs * *(const f32x4*)(pn + col)); st4bf(ob + (size_t)row * DM + col, v); ss_part(sso, row, cb, fq, sum4(v * v)); } };

#define XB_TMO      128
#define XB_XCNT(j)  (256  + 64 * (j))
#define XB_XSUB(j)  (1280 + 64 * (j))
#define XB_XGEN(j)  (2304 + 64 * (j))
#define XB_TOP      3328
#define XB_TOPGEN   3392
#define XCD_BAR_WORDS 3456
#define XB_SPIN_CAP (1u << 18)

__device__ __forceinline__ unsigned xb_ld(unsigned* p)              { return __hip_atomic_load(p, __ATOMIC_RELAXED, __HIP_MEMORY_SCOPE_AGENT); }
__device__ __forceinline__ unsigned xb_add(unsigned* p, unsigned v) { return __hip_atomic_fetch_add(p, v, __ATOMIC_RELAXED, __HIP_MEMORY_SCOPE_AGENT); }
__device__ __forceinline__ unsigned xb_xcc_id() { return (unsigned)__builtin_amdgcn_s_getreg((3 << 11) | 20) & 0xFu; }
#define XB_SPIN(cond, bar) do { unsigned _sp = 0; while (cond) { __builtin_amdgcn_s_sleep(1); \
    if ((++_sp & 255u) == 0u) { if (xb_ld(&(bar)[XB_TMO])) break; if (_sp > XB_SPIN_CAP) { atomicAdd(&(bar)[XB_TMO], 1u); break; } } } } while (0)

__device__ __forceinline__ bool is_thread0(int wave_s) { int l = (int)__builtin_amdgcn_mbcnt_hi(~0u, __builtin_amdgcn_mbcnt_lo(~0u, 0u)); asm volatile("" : "+v"(l)); return wave_s == 0 && l == 0; }
struct XcdBarrier {
    unsigned* bar; unsigned x;
    volatile LAS unsigned* st;
};

__device__ __forceinline__ XcdBarrier xcd_barrier_post(unsigned* bar, volatile LAS unsigned* st) {
    XcdBarrier b; b.bar = bar; b.x = xb_xcc_id(); b.st = st;
    if (threadIdx.x == 0) (void)xb_add(&bar[XB_XCNT(b.x)], 1u);
    return b;
}
__device__ __forceinline__ void xcd_barrier_complete(unsigned* bar, unsigned x, unsigned& nloc, unsigned& nx) {
    const unsigned G = gridDim.x * gridDim.y * gridDim.z;
    unsigned sum, cnt, mine, sp = 0u;
    for (;;) {
        sum = 0u; cnt = 0u; mine = 0u;
#pragma unroll
        for (unsigned j = 0; j < 16; ++j) { const unsigned c = xb_ld(&bar[XB_XCNT(j)]); sum += c; cnt += (c > 0u) ? 1u : 0u; mine = (j == x) ? c : mine; }
        if (sum == G) break;
        __builtin_amdgcn_s_sleep(1);
        if ((++sp & 255u) == 0u) { if (xb_ld(&bar[XB_TMO])) break; if (sp > XB_SPIN_CAP) { atomicAdd(&bar[XB_TMO], 1u); break; } }
    }
    nloc = mine > 0u ? mine : 1u; nx = cnt > 0u ? cnt : 1u;
}

__device__ __forceinline__ void xcd_barrier(const XcdBarrier& b, const int wave_s) {
    asm volatile("s_waitcnt vmcnt(0)" ::: "memory");
    __syncthreads();
    if (is_thread0(wave_s)) {
        unsigned* bar = b.bar;
        __builtin_amdgcn_s_waitcnt(0);
        unsigned nloc = b.st[0], nx = b.st[1];
        if (nloc == 0u) { xcd_barrier_complete(bar, b.x, nloc, nx); b.st[0] = nloc; b.st[1] = nx; }
        const unsigned old = xb_add(&bar[XB_XSUB(b.x)], 1u);
        const unsigned gen = old / nloc;
        if (old + 1u == (gen + 1u) * nloc) {
            __builtin_amdgcn_fence(__ATOMIC_RELEASE, "agent");
            asm volatile("s_waitcnt vmcnt(0)" ::: "memory");
            const unsigned og = xb_add(&bar[XB_TOP], 1u);
            const unsigned tg = og / nx;
            if (og + 1u == (tg + 1u) * nx) xb_add(&bar[XB_TOPGEN], 1u);
            else XB_SPIN(xb_ld(&bar[XB_TOPGEN]) == tg, bar);
            __builtin_amdgcn_fence(__ATOMIC_ACQUIRE, "agent");
            xb_add(&bar[XB_XGEN(b.x)], 1u);
            asm volatile("s_waitcnt vmcnt(0)" ::: "memory");
        } else {
            XB_SPIN(xb_ld(&bar[XB_XGEN(b.x)]) == gen, bar);
            __builtin_amdgcn_fence(__ATOMIC_ACQUIRE, "agent");
            asm volatile("s_waitcnt vmcnt(0)" ::: "memory");
        }
    }
    __syncthreads();
}

constexpr size_t WS_BAR = 5 * MiB; constexpr int BAR_BYTES = 16384;
__global__ void __launch_bounds__(512, 2) fwd_kernel(Args a) {
    extern __shared__ __attribute__((aligned(16))) unsigned char lds_raw[];
    LAS unsigned char* lds = (LAS unsigned char*)lds_raw;
    const int wave = __builtin_amdgcn_readfirstlane((int)threadIdx.x >> 6);
    if (threadIdx.x < 64) ((volatile LAS unsigned*)(lds + 131072))[threadIdx.x] = 0u;
    __syncthreads();
    XcdBarrier xbar; xbar.bar = (unsigned*)(karg_ws() + WS_BAR); xbar.x = 0; xbar.st = nullptr;
    if (a.ph_hi - a.ph_lo > 1) xbar = xcd_barrier_post((unsigned*)(karg_ws() + WS_BAR), (volatile LAS unsigned*)(lds + 131072) + 8);
#define TID_LANE() int lane = (int)__builtin_amdgcn_mbcnt_hi(~0u, __builtin_amdgcn_mbcnt_lo(~0u, 0u)); asm volatile("" : "+v"(lane)); const int tid = wave * 64 + lane; (void)tid
    const int lo = a.ph_lo, hi = a.ph_hi;
#define IN(k) (lo <= (k) && (k) < hi)
#define SEAM(k) do { if (IN(k) && IN((k) + 1)) { xcd_barrier(xbar, wave); } } while (0)
    const int G = gridDim.x, c = blockIdx.x;

    if (a.ph_hi > NPHASE) cg::this_grid().sync();
    if (IN(0)) { TID_LANE(); p0_prologue<0>(lds, tid, wave, lane, (int)blockIdx.x, (int)gridDim.x); }
    SEAM(0);
    if (IN(1)) {
        unsigned char* ws = karg_ws();
        bf16_t* RA = (bf16_t*)(ws + WS_RA); bf16_t* GB = (bf16_t*)(ws + WS_RG); bf16_t* ER = (bf16_t*)(ws + WS_RG);
        bf16_t* UB = (bf16_t*)(ws + WS_UB); bf16_t* QB = (bf16_t*)(ws + WS_QB); bf16_t* KB = (bf16_t*)(ws + WS_KB); bf16_t* VB = (bf16_t*)(ws + WS_VB);
        bf16_t* MB = (bf16_t*)(ws + WS_MB); bf16_t* MG = (bf16_t*)(ws + WS_MG); bf16_t* ACT = (bf16_t*)(ws + WS_ACT);
        float* SS2 = (float*)(ws + WS_SS2); float* SSE = (float*)(ws + WS_SSE); float* SSO = (float*)(ws + WS_SSO);
        (void)RA; (void)GB; (void)ER; (void)UB; (void)QB; (void)KB; (void)VB; (void)MB; (void)MG; (void)ACT; (void)SS2; (void)SSE; (void)SSO;
        Gemm g{RA, (const bf16_t*)(ws + WS_WIN), MPAD, INC, 1024}; StaticOrder S; S.init(MPAD, INC, G, c);
        EpiIn E{UB, QB, KB, VB, GB, karg_out(), (const float*)(ws + WS_ROPE)};
        gemm_phase<EpiIn, StaticOrder, true, true, 1024>(lds, g, S, E, wave);
        { const int nwg = (MPAD / 256) * (INC / 256), extra = nwg % G;
          TID_LANE(); if (extra == 0) p0_prologue<1>(lds, tid, wave, lane, c, G); else if (c >= extra) p0_prologue<1>(lds, tid, wave, lane, c - extra, G - extra); }
    }
    SEAM(1);
    if (IN(2)) {
        TID_LANE();
        unsigned char* ws = karg_ws();
        bf16_t* RA = (bf16_t*)(ws + WS_RA); bf16_t* GB = (bf16_t*)(ws + WS_RG); bf16_t* ER = (bf16_t*)(ws + WS_RG);
        bf16_t* UB = (bf16_t*)(ws + WS_UB); bf16_t* QB = (bf16_t*)(ws + WS_QB); bf16_t* KB = (bf16_t*)(ws + WS_KB); bf16_t* VB = (bf16_t*)(ws + WS_VB);
        bf16_t* MB = (bf16_t*)(ws + WS_MB); bf16_t* MG = (bf16_t*)(ws + WS_MG); bf16_t* ACT = (bf16_t*)(ws + WS_ACT);
        float* SS2 = (float*)(ws + WS_SS2); float* SSE = (float*)(ws + WS_SSE); float* SSO = (float*)(ws + WS_SSO);
        (void)RA; (void)GB; (void)ER; (void)UB; (void)QB; (void)KB; (void)VB; (void)MB; (void)MG; (void)ACT; (void)SS2; (void)SSE; (void)SSO;
        { const float* const sinks_ = karg_in(11); const float* const ck_ = karg_in(4); const float* const cv_ = karg_in(5); float* const out_ = karg_out();
        attn_prompt_all(lds, QB, KB, VB, RA, sinks_, tid, wave, lane);
        for (int unit = c; unit < 512; unit += G) attn_sample_unit(lds, unit, QB, KB, VB, RA, ck_, cv_, sinks_, out_, tid, wave, lane); }
        pool_items(ws, karg_in(6), tid);
        __syncthreads();
    }
    SEAM(2);
    if (IN(3)) {
        unsigned char* ws = karg_ws();
        bf16_t* RA = (bf16_t*)(ws + WS_RA); bf16_t* GB = (bf16_t*)(ws + WS_RG); bf16_t* ER = (bf16_t*)(ws + WS_RG);
        bf16_t* UB = (bf16_t*)(ws + WS_UB); bf16_t* QB = (bf16_t*)(ws + WS_QB); bf16_t* KB = (bf16_t*)(ws + WS_KB); bf16_t* VB = (bf16_t*)(ws + WS_VB);
        bf16_t* MB = (bf16_t*)(ws + WS_MB); bf16_t* MG = (bf16_t*)(ws + WS_MG); bf16_t* ACT = (bf16_t*)(ws + WS_ACT);
        float* SS2 = (float*)(ws + WS_SS2); float* SSE = (float*)(ws + WS_SSE); float* SSO = (float*)(ws + WS_SSO);
        (void)RA; (void)GB; (void)ER; (void)UB; (void)QB; (void)KB; (void)VB; (void)MB; (void)MG; (void)ACT; (void)SS2; (void)SSE; (void)SSO;
        TID_LANE();
        { const bf16_t* mbs = MB + (size_t)MPR * 512; const bf16_t* ras = RA + (size_t)MPR * DM;
          SMergeA Ea{MG, GB}; skinny_gemm<512>(lds, mbs, (const bf16_t*)(ws + WS_WEFF), wave, lane, Ea);
          SMergeB Eb{MG, GB}; skinny_gemm<1024>(lds, ras, (const bf16_t*)(ws + WS_WAB), wave, lane, Eb); }
        StaticOrder S; S.init(MPR, 1024, G, c);
        { Gemm g{MB, (const bf16_t*)(ws + WS_WEFF), MPR, 1024, 512}; EpiMergeA E{MG, GB}; gemm_phase<EpiMergeA, StaticOrder, true, true, 512>(lds, g, S, E, wave); }
        { Gemm g{RA, (const bf16_t*)(ws + WS_WAB), MPR, 1024, 1024}; EpiMergeB E{MG, GB}; gemm_phase<EpiMergeB, StaticOrder, true, true, 1024>(lds, g, S, E, wave); }
    }
    SEAM(3);
    if (IN(4)) {
        unsigned char* ws = karg_ws();
        bf16_t* RA = (bf16_t*)(ws + WS_RA); bf16_t* GB = (bf16_t*)(ws + WS_RG); bf16_t* ER = (bf16_t*)(ws + WS_RG);
        bf16_t* UB = (bf16_t*)(ws + WS_UB); bf16_t* QB = (bf16_t*)(ws + WS_QB); bf16_t* KB = (bf16_t*)(ws + WS_KB); bf16_t* VB = (bf16_t*)(ws + WS_VB);
        bf16_t* MB = (bf16_t*)(ws + WS_MB); bf16_t* MG = (bf16_t*)(ws + WS_MG); bf16_t* ACT = (bf16_t*)(ws + WS_ACT);
        float* SS2 = (float*)(ws + WS_SS2); float* SSE = (float*)(ws + WS_SSE); float* SSO = (float*)(ws + WS_SSO);
        (void)RA; (void)GB; (void)ER; (void)UB; (void)QB; (void)KB; (void)VB; (void)MB; (void)MG; (void)ACT; (void)SS2; (void)SSE; (void)SSO;
        TID_LANE();
        { SRes1 Es{karg_in(1), RA, SS2}; skinny_gemm<1024>(lds, MG + (size_t)MPR * DM, (const bf16_t*)(ws + WS_WOUT), wave, lane, Es); }
        Gemm g{MG, (const bf16_t*)(ws + WS_WOUT), MPR, 1024, 1024}; StaticOrder S; S.init(MPR, 1024, G, c);
        EpiRes1 E{karg_in(0), RA, SS2};
        gemm_phase<EpiRes1, StaticOrder, true, true, 1024>(lds, g, S, E, wave);
    }
    SEAM(4);
    if (IN(5)) {
        unsigned char* ws = karg_ws();
        bf16_t* RA = (bf16_t*)(ws + WS_RA); bf16_t* GB = (bf16_t*)(ws + WS_RG); bf16_t* ER = (bf16_t*)(ws + WS_RG);
        bf16_t* UB = (bf16_t*)(ws + WS_UB); bf16_t* QB = (bf16_t*)(ws + WS_QB); bf16_t* KB = (bf16_t*)(ws + WS_KB); bf16_t* VB = (bf16_t*)(ws + WS_VB);
        bf16_t* MB = (bf16_t*)(ws + WS_MB); bf16_t* MG = (bf16_t*)(ws + WS_MG); bf16_t* ACT = (bf16_t*)(ws + WS_ACT);
        float* SS2 = (float*)(ws + WS_SS2); float* SSE = (float*)(ws + WS_SSE); float* SSO = (float*)(ws + WS_SSO);
        (void)RA; (void)GB; (void)ER; (void)UB; (void)QB; (void)KB; (void)VB; (void)MB; (void)MG; (void)ACT; (void)SS2; (void)SSE; (void)SSO;
        Gemm g{RA, (const bf16_t*)(ws + WS_WFI), MPAD, 2 * FFH, 1024}; StaticOrder S; S.init(MPAD, 2 * FFH, G, c);
        EpiSwiglu E{ACT, SS2};
        gemm_phase<EpiSwiglu, StaticOrder, true, true, 1024>(lds, g, S, E, wave);
        { const int nwg5 = (MPAD / 256) * (2 * FFH / 256), extra5 = nwg5 % G;
          TailOrder T; T.init(MPR, 1024, G, c, extra5); Gemm gp{(const bf16_t*)(ws + WS_PB), (const bf16_t*)(ws + WS_WPP), MPR, 1024, PLE}; EpiEraw Ee{ER, SSE};
          gemm_phase<EpiEraw, TailOrder, true, true, PLE>(lds, gp, T, Ee, wave); }
    }
    SEAM(5);
    if (IN(6)) {
        unsigned char* ws = karg_ws();
        bf16_t* RA = (bf16_t*)(ws + WS_RA); bf16_t* GB = (bf16_t*)(ws + WS_RG); bf16_t* ER = (bf16_t*)(ws + WS_RG);
        bf16_t* UB = (bf16_t*)(ws + WS_UB); bf16_t* QB = (bf16_t*)(ws + WS_QB); bf16_t* KB = (bf16_t*)(ws + WS_KB); bf16_t* VB = (bf16_t*)(ws + WS_VB);
        bf16_t* MB = (bf16_t*)(ws + WS_MB); bf16_t* MG = (bf16_t*)(ws + WS_MG); bf16_t* ACT = (bf16_t*)(ws + WS_ACT);
        float* SS2 = (float*)(ws + WS_SS2); float* SSE = (float*)(ws + WS_SSE); float* SSO = (float*)(ws + WS_SSO);
        (void)RA; (void)GB; (void)ER; (void)UB; (void)QB; (void)KB; (void)VB; (void)MB; (void)MG; (void)ACT; (void)SS2; (void)SSE; (void)SSO;
        TID_LANE();
        { SRes2 Es{RA}; skinny_gemm<FFH>(lds, ACT + (size_t)MPR * FFH, (const bf16_t*)(ws + WS_WFO), wave, lane, Es);
          SEraw Ee{ER, SSE}; skinny_gemm<PLE>(lds, (const bf16_t*)(ws + WS_PB) + (size_t)MPR * PLE, (const bf16_t*)(ws + WS_WPP), wave, lane, Ee); }
        StaticOrder S; S.init(MPR, 1024, G, c);
        { Gemm g{ACT, (const bf16_t*)(ws + WS_WFO), MPR, 1024, FFH}; EpiRes2 E{RA}; gemm_phase<EpiRes2, StaticOrder, true, true, FFH>(lds, g, S, E, wave); }
    }
    SEAM(6);
    if (IN(7)) {
        unsigned char* ws = karg_ws();
        bf16_t* RA = (bf16_t*)(ws + WS_RA); bf16_t* GB = (bf16_t*)(ws + WS_RG); bf16_t* ER = (bf16_t*)(ws + WS_RG);
        bf16_t* UB = (bf16_t*)(ws + WS_UB); bf16_t* QB = (bf16_t*)(ws + WS_QB); bf16_t* KB = (bf16_t*)(ws + WS_KB); bf16_t* VB = (bf16_t*)(ws + WS_VB);
        bf16_t* MB = (bf16_t*)(ws + WS_MB); bf16_t* MG = (bf16_t*)(ws + WS_MG); bf16_t* ACT = (bf16_t*)(ws + WS_ACT);
        float* SS2 = (float*)(ws + WS_SS2); float* SSE = (float*)(ws + WS_SSE); float* SSO = (float*)(ws + WS_SSO);
        (void)RA; (void)GB; (void)ER; (void)UB; (void)QB; (void)KB; (void)VB; (void)MB; (void)MG; (void)ACT; (void)SS2; (void)SSE; (void)SSO;
        TID_LANE();
        { SPle Es{ACT, RA, ER, SSE, karg_in(19), SSO}; skinny_gemm<1024>(lds, RA + (size_t)MPR * DM, (const bf16_t*)(ws + WS_WPG), wave, lane, Es); }
        Gemm g{RA, (const bf16_t*)(ws + WS_WPG), MPR, 1024, 1024}; StaticOrder S; S.init(MPR, 1024, G, c);
        EpiPle E{ACT, RA, ER, SSE, karg_in(19), SSO};
        gemm_phase<EpiPle, StaticOrder, true, true, 1024>(lds, g, S, E, wave);
    }
    SEAM(7);
    if (IN(8)) {
        TID_LANE();
        unsigned char* ws = karg_ws();
        bf16_t* RA = (bf16_t*)(ws + WS_RA); bf16_t* GB = (bf16_t*)(ws + WS_RG); bf16_t* ER = (bf16_t*)(ws + WS_RG);
        bf16_t* UB = (bf16_t*)(ws + WS_UB); bf16_t* QB = (bf16_t*)(ws + WS_QB); bf16_t* KB = (bf16_t*)(ws + WS_KB); bf16_t* VB = (bf16_t*)(ws + WS_VB);
        bf16_t* MB = (bf16_t*)(ws + WS_MB); bf16_t* MG = (bf16_t*)(ws + WS_MG); bf16_t* ACT = (bf16_t*)(ws + WS_ACT);
        float* SS2 = (float*)(ws + WS_SS2); float* SSE = (float*)(ws + WS_SSE); float* SSO = (float*)(ws + WS_SSO);
        (void)RA; (void)GB; (void)ER; (void)UB; (void)QB; (void)KB; (void)VB; (void)MB; (void)MG; (void)ACT; (void)SS2; (void)SSE; (void)SSO;
        const float* fn = karg_in(21); float* const out_ = karg_out();
        f32x4 f0[2], f1[2];
#pragma unroll
        for (int hh = 0; hh < 2; ++hh) { f0[hh] = *(const f32x4*)(fn + hh * 512 + lane * 8); f1[hh] = *(const f32x4*)(fn + hh * 512 + lane * 8 + 4); }
        for (int m = (c * 8 + wave) * 2; m < MREAL; m += G * 16) {
            u32x4 w[2][2];
#pragma unroll
            for (int r = 0; r < 2; ++r)
#pragma unroll
                for (int hh = 0; hh < 2; ++hh) w[r][hh] = *(const u32x4*)(ACT + (size_t)(m + r) * DM + hh * 512 + lane * 8);
#pragma unroll
            for (int r = 0; r < 2; ++r) { const float rs = row_rs(SSO, m + r);
#pragma unroll
                for (int hh = 0; hh < 2; ++hh) { f32x4 v0, v1; unpack8(w[r][hh], v0, v1); float* yp = out_ + (size_t)(m + r) * DM + hh * 512 + lane * 8;
                    __builtin_nontemporal_store(v0 * rs * f0[hh], (f32x4*)yp); __builtin_nontemporal_store(v1 * rs * f1[hh], (f32x4*)(yp + 4)); } }
        }
    }
#undef IN
#undef SEAM
}

extern "C" void kernel_launch(void* const* d_in, const int* in_sizes, int n_in, void* d_out, int out_size, void* d_ws, size_t ws_size, hipStream_t stream) {
    static int grid = 0;
    if (grid == 0) {
        if (n_in != 22 || out_size != (int)O_END || ws_size < WS_END) { fprintf(stderr, "kernel_launch: unexpected sizes: n_in %d out %d ws %zu (need %zu)\n", n_in, out_size, ws_size, (size_t)WS_END); grid = -1; return; }
        int dev = 0, cus = 0, per_cu = 0;
        hipGetDevice(&dev); hipDeviceGetAttribute(&cus, hipDeviceAttributeMultiprocessorCount, dev);
        if (hipFuncSetAttribute((const void*)fwd_kernel, hipFuncAttributeMaxDynamicSharedMemorySize, LDS_BYTES) != hipSuccess) { fprintf(stderr, "kernel_launch: hipFuncSetAttribute failed\n"); grid = -1; return; }
        if (hipOccupancyMaxActiveBlocksPerMultiprocessor(&per_cu, (const void*)fwd_kernel, 512, LDS_BYTES) != hipSuccess || per_cu < 1) { fprintf(stderr, "kernel_launch: occupancy query failed (%d)\n", per_cu); grid = -1; return; }
        grid = cus * per_cu;
        fprintf(stderr, "kernel_launch: cus %d per_cu %d grid %d\n", cus, per_cu, grid);
    }
    if (grid < 0) return;
    Args a{};
    for (int i = 0; i < 22; ++i) a.in[i] = (const float*)d_in[i];
    a.out = (float*)d_out; a.ws = (unsigned char*)d_ws;
#if N_LAUNCH == 1
    if (hipMemsetAsync((char*)d_ws + WS_BAR, 0, BAR_BYTES, stream) != hipSuccess) { fprintf(stderr, "kernel_launch: memset failed\n"); return; }
    a.ph_lo = 0; a.ph_hi = NPHASE;
    void* args[] = {&a};
    hipError_t e = hipLaunchCooperativeKernel((const void*)fwd_kernel, dim3(grid), dim3(512), args, LDS_BYTES, stream);
    if (e != hipSuccess) fprintf(stderr, "cooperative launch failed: %s (grid %d)\n", hipGetErrorString(e), grid);
#else
    for (int p = 0; p < NPHASE; ++p) { a.ph_lo = p; a.ph_hi = p + 1; hipLaunchKernelGGL(fwd_kernel, dim3(grid), dim3(512), LDS_BYTES, stream, a); }
#endif
}
```

```cpp
#include <hip/hip_runtime.h>
#include <hip/hip_cooperative_groups.h>
#include <cstdio>
#include <cstdint>
namespace cg = cooperative_groups;
namespace pg8 {
#define PG8_LAS __attribute__((address_space(3)))
typedef unsigned short bf16_t;
typedef short bf16x8 __attribute__((ext_vector_type(8)));
typedef float f32x4 __attribute__((ext_vector_type(4)));
typedef unsigned u32x4 __attribute__((ext_vector_type(4)));
constexpr int BM = 256, BK = 64, HALF = 128, HTB = HALF * BK * 2  , STAGE_BYTES = 8 * HTB, NXCD = 8, WGM = 8;

__host__ __device__ __forceinline__ int lds_byte(int r, int c) { const int st = (r >> 4) * 2 + (c >> 5), rr = r & 15, cc = c & 31, ob = rr * 64 + cc * 2; return st * 1024 + (ob ^ (((ob >> 9) & 1) << 5)); }
__host__ __device__ __forceinline__ void stage_rc(int b, int& R, int& C) { const int st = b / 1024, sb = b % 1024, swz = sb ^ (((sb >> 9) & 1) << 5); R = (st >> 1) * 16 + swz / 64; C = (st & 1) * 32 + (swz % 64) / 2; }
__host__ __device__ __forceinline__ int perm32(int rho) { const int n = rho >> 4, i = rho & 15; return 8 * (i >> 2) + 4 * n + (i & 3); }

struct Unit { int pm, pn; };
struct Gemm { const bf16_t* A; const bf16_t* Bt; int M, N, K; };

struct StaticOrder {
    int nM, nN, nwg, G, c;
    __host__ __device__ void init(int M, int N, int G_, int c_) { nM = M / BM; nN = N / BM; nwg = nM * nN; G = G_; c = c_; }
    __host__ __device__ bool next(int i, Unit& u) const {
        const long L = (long)i * G + c; if (L >= nwg) return false;
        int wgid = (int)L; { const int q = nwg / NXCD, r = nwg % NXCD, xcd = wgid % NXCD, off = wgid / NXCD; wgid = (xcd < r ? xcd * (q + 1) : r * (q + 1) + (xcd - r) * q) + off; }
        const int nig = WGM * nN, gid = wgid / nig, fm = gid * WGM, gsz = (nM - fm) < WGM ? (nM - fm) : WGM;
        u.pm = fm + ((wgid % nig) % gsz); u.pn = (wgid % nig) / gsz; return true;
    }
    __device__ __forceinline__ void a_ready(const Unit&) const {}
    __device__ __forceinline__ void done(const Unit&) const {}
};

struct TailOrder {
    int nwg, first, cnt, c;
    __host__ __device__ void init(int M, int N, int G_, int c_, int first_) { nwg = (M / BM) * (N / BM); first = first_ < G_ ? first_ : 0; cnt = G_ - first; c = c_; }
    __host__ __device__ bool next(int i, Unit& u) const {
        if (c < first) return false; const int t = (c - first) + i * cnt; if (t >= nwg) return false;
        u.pm = t >> 2; u.pn = t & 3; return true;
    }
    __device__ __forceinline__ void a_ready(const Unit&) const {}
    __device__ __forceinline__ void done(const Unit&) const {}
};

__device__ __forceinline__ unsigned cvt_pk_bf16(float lo, float hi) { unsigned r; asm volatile("s_nop 0\n\tv_cvt_pk_bf16_f32 %0, %1, %2" : "=v"(r) : "v"(lo), "v"(hi)); return r; }
typedef float f32x2_cv __attribute__((ext_vector_type(2))); typedef __bf16 bf16x2_cv __attribute__((ext_vector_type(2)));
__device__ __forceinline__ unsigned cvt_pk_bf16_v(float lo, float hi) { const f32x2_cv v = {lo, hi}; const bf16x2_cv b = __builtin_convertvector(v, bf16x2_cv); return __builtin_bit_cast(unsigned, b); }
typedef float f32x2 __attribute__((ext_vector_type(2)));

constexpr int DM = 1024, SEQ = 8192, MPR = 16384, MSM = 128, MREAL = MPR + MSM, MPAD = 16640;
constexpr int INC = 4096, FFH = 2816, PLE = 256;
constexpr float EPS = 1e-6f;
constexpr size_t O_Y = 0, O_NKP = (size_t)MREAL * DM, O_NVP = O_NKP + 65536, O_NPP = O_NVP + 65536, O_NKS = O_NPP + 15360, O_NVS = O_NKS + 4194304, O_NPS = O_NVS + 4194304, O_END = O_NPS + 983040;

typedef unsigned u32x2 __attribute__((ext_vector_type(2)));
__device__ __forceinline__ float bflo(unsigned w) { return __builtin_bit_cast(float, w << 16); }
__device__ __forceinline__ float bfhi(unsigned w) { return __builtin_bit_cast(float, w & 0xffff0000u); }
__device__ __forceinline__ u32x4 pack8(const f32x4 a, const f32x4 b) { u32x4 w; w.x = cvt_pk_bf16(a[0], a[1]); w.y = cvt_pk_bf16(a[2], a[3]); w.z = cvt_pk_bf16(b[0], b[1]); w.w = cvt_pk_bf16(b[2], b[3]); return w; }
__device__ __forceinline__ u32x4 pack8v(const f32x4 a, const f32x4 b) { u32x4 w; w.x = cvt_pk_bf16_v(a[0], a[1]); w.y = cvt_pk_bf16_v(a[2], a[3]); w.z = cvt_pk_bf16_v(b[0], b[1]); w.w = cvt_pk_bf16_v(b[2], b[3]); return w; }
__device__ __forceinline__ void unpack8(const u32x4 w, f32x4& a, f32x4& b) { a = (f32x4){bflo(w.x), bfhi(w.x), bflo(w.y), bfhi(w.y)}; b = (f32x4){bflo(w.z), bfhi(w.z), bflo(w.w), bfhi(w.w)}; }
__device__ __forceinline__ float sigm(float x) { return __builtin_amdgcn_rcpf(1.0f + __expf(-x)); }
__device__ __forceinline__ f32x4 sigm4(const f32x4 x) { return (f32x4){sigm(x[0]), sigm(x[1]), sigm(x[2]), sigm(x[3])}; }
__device__ __forceinline__ float sum4(const f32x4 x) { return (x[0] + x[1]) + (x[2] + x[3]); }
__device__ __forceinline__ float row_rs(const float* ss, int row) {
    if (row < MPR) { const f32x4* p = (const f32x4*)(ss + (size_t)row * 16); const f32x4 a = p[0], b = p[1], c = p[2], d = p[3];
        return rsqrtf(((sum4(a) + sum4(b)) + (sum4(c) + sum4(d))) * (1.0f / DM) + EPS); }
    const f32x4* p = (const f32x4*)(ss + (size_t)MPR * 16 + (size_t)(row - MPR) * 64); f32x4 t = p[0];
#pragma unroll
    for (int i = 1; i < 16; ++i) t += p[i];
    return rsqrtf(sum4(t) * (1.0f / DM) + EPS);
}
#define EPI_ROW(ai, m) (u.pm * BM + (ai) * HALF + wr * 64 + (m) * 16 + fr)
#define EPI_LOOP_AM _Pragma("unroll") for (int ai = 0; ai < 2; ++ai) _Pragma("unroll") for (int m = 0; m < 4; ++m)
#define EPI_LOOP_BJ _Pragma("unroll") for (int bj = 0; bj < 2; ++bj)

struct EpiIn {
    static constexpr bool PERM = true, AFTER_DRAIN = false;
    bf16_t *ub, *qb, *kb, *vb, *gb; float* out; const float* rope;
    __device__ __forceinline__ void operator()(const f32x4 (&acc)[2][2][4][2], const Unit& u, int wr, int wc, int fr, int fq) const {
        const int colt = u.pn * BM, cw = wc * 32 + 8 * fq;
        const bool tail = (u.pm == 31) || (u.pm == 63) || (u.pm == 64);
        EPI_LOOP_AM {
            const int row = EPI_ROW(ai, m);
            if (colt >= 2048) {
                EPI_LOOP_BJ { const int col = colt - 2048 + bj * HALF + cw; *(u32x4*)(gb + (size_t)row * 2048 + col) = pack8v(sigm4(acc[ai][bj][m][0]), sigm4(acc[ai][bj][m][1])); }
            } else if (colt < 512) {
                EPI_LOOP_BJ { const int col = colt + bj * HALF + cw; const f32x4 v0 = acc[ai][bj][m][0], v1 = acc[ai][bj][m][1];
                    *(u32x4*)(ub + (size_t)row * 512 + col) = pack8(v0, v1);
                    if (tail) { float* dst = nullptr;
                        if (row >= MPR) { if (row < MREAL) dst = out + O_NPS + ((size_t)(row - MPR) * 15 + 14) * 512 + col; }
                        else { const int t = row & (SEQ - 1); if (t >= SEQ - 15) dst = out + O_NPP + ((size_t)(row >> 13) * 15 + (t - (SEQ - 15))) * 512 + col; }
                        if (dst) { *(f32x4*)dst = v0; *(f32x4*)(dst + 4) = v1; } } }
            } else if (colt < 1792) {
                const bool isq = colt < 1536;
                const int pidx = row < MPR ? (row & (SEQ - 1)) : SEQ;
                EPI_LOOP_BJ { f32x4 v0 = acc[ai][bj][m][0], v1 = acc[ai][bj][m][1];
                    if ((wc & 1) == 0) {
                        f32x4 p0, p1;
#pragma unroll
                        for (int j = 0; j < 4; ++j) { p0[j] = __shfl_xor(v0[j], 16); p1[j] = __shfl_xor(v1[j], 16); }
                        if (fq < 2) { const f32x4* rp = (const f32x4*)(rope + (size_t)pidx * 16); const f32x4 c0 = rp[0], c1 = rp[1]; f32x4 s0 = rp[2], s1 = rp[3];
                            if (fq == 0) { s0 = -s0; s1 = -s1; }
                            v0 = v0 * c0 + p0 * s0; v1 = v1 * c1 + p1 * s1; }
                    }
                    if (isq) { v0 = v0 * 0.125f; v1 = v1 * 0.125f; *(u32x4*)(qb + (size_t)row * 1024 + (colt - 512) + bj * HALF + cw) = pack8(v0, v1); }
                    else { const int col = bj * HALF + cw; *(u32x4*)(kb + (size_t)row * 256 + col) = pack8(v0, v1);
                        if (tail) { float* dst = nullptr;
                            if (row >= MPR) { if (row < MREAL) dst = out + O_NKS + ((size_t)(row - MPR) * 128 + 127) * 256 + col; }
                            else { const int t = row & (SEQ - 1); if (t >= SEQ - 128) dst = out + O_NKP + ((size_t)(row >> 13) * 128 + (t - (SEQ - 128))) * 256 + col; }
                            if (dst) { *(f32x4*)dst = v0; *(f32x4*)(dst + 4) = v1; } } } }
            } else {
                EPI_LOOP_BJ { const int col = bj * HALF + cw; const f32x4 v0 = acc[ai][bj][m][0], v1 = acc[ai][bj][m][1];
                    *(u32x4*)(vb + (size_t)row * 256 + col) = pack8(v0, v1);
                    if (tail) { float* dst = nullptr;
                        if (row >= MPR) { if (row < MREAL) dst = out + O_NVS + ((size_t)(row - MPR) * 128 + 127) * 256 + col; }
                        else { const int t = row & (SEQ - 1); if (t >= SEQ - 128) dst = out + O_NVP + ((size_t)(row >> 13) * 128 + (t - (SEQ - 128))) * 256 + col; }
                        if (dst) { *(f32x4*)dst = v0; *(f32x4*)(dst + 4) = v1; } } }
            }
        }
    }
};
struct EpiMergeA {
    static constexpr bool PERM = true, AFTER_DRAIN = false;
    bf16_t* mg; const bf16_t* gb;
    __device__ __forceinline__ void operator()(const f32x4 (&acc)[2][2][4][2], const Unit& u, int wr, int wc, int fr, int fq) const {
        const int cw = u.pn * BM + wc * 32 + 8 * fq;
        EPI_LOOP_AM { const int row = EPI_ROW(ai, m);
            EPI_LOOP_BJ { const int col = cw + bj * HALF; f32x4 g0, g1; unpack8(*(const u32x4*)(gb + (size_t)row * 2048 + col), g0, g1);
                *(u32x4*)(mg + (size_t)row * DM + col) = pack8(g0 * acc[ai][bj][m][0], g1 * acc[ai][bj][m][1]); } }
    }
};
struct EpiMergeB {
    static constexpr bool PERM = true, AFTER_DRAIN = false;
    bf16_t* mg; const bf16_t* gb;
    __device__ __forceinline__ void operator()(const f32x4 (&acc)[2][2][4][2], const Unit& u, int wr, int wc, int fr, int fq) const {
        const int cw = u.pn * BM + wc * 32 + 8 * fq;
        EPI_LOOP_AM { const int row = EPI_ROW(ai, m);
            EPI_LOOP_BJ { const int col = cw + bj * HALF; f32x4 g0, g1, t0, t1; unpack8(*(const u32x4*)(gb + (size_t)row * 2048 + 1024 + col), g0, g1);
                unpack8(*(const u32x4*)(mg + (size_t)row * DM + col), t0, t1);
                *(u32x4*)(mg + (size_t)row * DM + col) = pack8(t0 + g0 * acc[ai][bj][m][0], t1 + g1 * acc[ai][bj][m][1]); } }
    }
};
struct EpiRes1 {
    static constexpr bool PERM = true, AFTER_DRAIN = false;
    const float *xp; bf16_t* hb; float* ss;
    __device__ __forceinline__ void operator()(const f32x4 (&acc)[2][2][4][2], const Unit& u, int wr, int wc, int fr, int fq) const {
        const int cw = u.pn * BM + wc * 32 + 8 * fq;
        EPI_LOOP_AM { const int row = EPI_ROW(ai, m); const float* xr = xp + (size_t)row * DM; float q = 0.f;
            EPI_LOOP_BJ { const int col = cw + bj * HALF; const f32x4 v0 = acc[ai][bj][m][0] + __builtin_nontemporal_load((const f32x4*)(xr + col)), v1 = acc[ai][bj][m][1] + __builtin_nontemporal_load((const f32x4*)(xr + col + 4));
                q += sum4(v0 * v0) + sum4(v1 * v1);
                *(u32x4*)(hb + (size_t)row * DM + col) = pack8(v0, v1); }
            q += __shfl_xor(q, 16); q += __shfl_xor(q, 32);
            if (fq == 0) ss[(size_t)row * 16 + u.pn * 4 + wc] = q; }
    }
};
struct EpiSwiglu {
    static constexpr bool PERM = true, AFTER_DRAIN = false;
    bf16_t* act; const float* ss;
    __device__ __forceinline__ void operator()(const f32x4 (&acc)[2][2][4][2], const Unit& u, int wr, int wc, int fr, int fq) const {
        const int cw = u.pn * 128 + wc * 16 + 4 * fq;
        EPI_LOOP_AM { const int row = EPI_ROW(ai, m); const float rs = row_rs(ss, row);
            EPI_LOOP_BJ { const f32x4 g = acc[ai][bj][m][0] * rs, up = acc[ai][bj][m][1] * rs; const f32x4 a = g * sigm4(g) * up;
                u32x2 w; w.x = cvt_pk_bf16(a[0], a[1]); w.y = cvt_pk_bf16(a[2], a[3]);
                *(u32x2*)(act + (size_t)row * FFH + cw + bj * 64) = w; } }
    }
};
struct EpiRes2 {
    static constexpr bool PERM = true, AFTER_DRAIN = false;
    bf16_t* hb;
    __device__ __forceinline__ void operator()(const f32x4 (&acc)[2][2][4][2], const Unit& u, int wr, int wc, int fr, int fq) const {
        const int cw = u.pn * BM + wc * 32 + 8 * fq;
        EPI_LOOP_AM { const int row = EPI_ROW(ai, m);
            EPI_LOOP_BJ { bf16_t* hp = hb + (size_t)row * DM + cw + bj * HALF; f32x4 h0, h1; unpack8(*(const u32x4*)hp, h0, h1);
                *(u32x4*)hp = pack8(h0 + acc[ai][bj][m][0], h1 + acc[ai][bj][m][1]); } }
    }
};
struct EpiEraw {
    static constexpr bool PERM = true, AFTER_DRAIN = false;
    bf16_t* er; float* ss;
    __device__ __forceinline__ void operator()(const f32x4 (&acc)[2][2][4][2], const Unit& u, int wr, int wc, int fr, int fq) const {
        const int cw = u.pn * BM + wc * 32 + 8 * fq;
        EPI_LOOP_AM { const int row = EPI_ROW(ai, m); float q = 0.f;
            EPI_LOOP_BJ { const int col = cw + bj * HALF; const f32x4 v0 = acc[ai][bj][m][0], v1 = acc[ai][bj][m][1];
                q += sum4(v0 * v0) + sum4(v1 * v1); *(u32x4*)(er + (size_t)row * DM + col) = pack8(v0, v1); }
            q += __shfl_xor(q, 16); q += __shfl_xor(q, 32);
            if (fq == 0) ss[(size_t)row * 16 + u.pn * 4 + wc] = q; }
    }
};
struct EpiPle {
    static constexpr bool PERM = true, AFTER_DRAIN = false;
    bf16_t* ob; const bf16_t* hb; const bf16_t* er; const float *sse, *pn; float* sso;
    __device__ __forceinline__ void operator()(const f32x4 (&acc)[2][2][4][2], const Unit& u, int wr, int wc, int fr, int fq) const {
        const int cw = u.pn * BM + wc * 32 + 8 * fq;
        EPI_LOOP_AM { const int row = EPI_ROW(ai, m); const float rs = row_rs(sse, row); float q = 0.f;
            EPI_LOOP_BJ { const int col = cw + bj * HALF; f32x4 e0, e1, h0, h1; unpack8(*(const u32x4*)(er + (size_t)row * DM + col), e0, e1); unpack8(*(const u32x4*)(hb + (size_t)row * DM + col), h0, h1);
                const f32x4 n0 = *(const f32x4*)(pn + col), n1 = *(const f32x4*)(pn + col + 4);
                const f32x4 v0 = h0 + sigm4(acc[ai][bj][m][0]) * (e0 * rs * n0), v1 = h1 + sigm4(acc[ai][bj][m][1]) * (e1 * rs * n1);
                *(u32x4*)(ob + (size_t)row * DM + col) = pack8(v0, v1);
                q += sum4(v0 * v0) + sum4(v1 * v1); }
            q += __shfl_xor(q, 16); q += __shfl_xor(q, 32);
            if (fq == 0) sso[(size_t)row * 16 + u.pn * 4 + wc] = q; }
    }
};
template <class Epi, class Sched, bool ALIGN_EPI = false, bool SP2 = false, int KC = 0>
__device__ __forceinline__ void gemm_phase(PG8_LAS unsigned char* lds, const Gemm g, const Sched& S, const Epi& E, const int wave_s) {
    int lane_ = (int)__builtin_amdgcn_mbcnt_hi(~0u, __builtin_amdgcn_mbcnt_lo(~0u, 0u)); asm volatile("" : "+v"(lane_));
    const int wid = wave_s, lane = lane_, tid = wid * 64 + lane, wr = wid >> 2, wc = wid & 3, fr = lane & 15, fq = lane >> 4;
    const int K = KC > 0 ? KC : g.K, nt = K / BK;
    unsigned voffA[2], voffB[2];
#pragma unroll
    for (int i = 0; i < 2; ++i) { int R, C; stage_rc(tid * 16 + i * 8192, R, C); const int Rb = Epi::PERM ? ((R & ~31) + perm32(R & 31)) : R;
        voffA[i] = (unsigned)(R * K + C) * 2u; voffB[i] = (unsigned)(Rb * K + C) * 2u; }
    const size_t kstep = (size_t)(BK * 2);
    const size_t hstep = (size_t)HALF * K * 2;
    const size_t tstep = 2 * hstep;
    const unsigned ldsw = (unsigned)wid * 1024u;
    const int aoff = lds_byte(wr * 64 + fr, fq * 8), boff = lds_byte(wc * 32 + fr, fq * 8);
#define PG8_SA(b, h) (((b) * 2 + (h)) * HTB)
#define PG8_SB(b, h) ((4 + (b) * 2 + (h)) * HTB)
#define PG8_STAGE(bufoff, gbase, voff) do { _Pragma("unroll") for (int _i = 0; _i < 2; ++_i) \
        __builtin_amdgcn_global_load_lds((const unsigned*)((const char*)(gbase) + (voff)[_i]), (PG8_LAS unsigned*)(lds + (bufoff) + ldsw + _i * 8192), 16, 0, 0); } while (0)
#define PG8_LDA(dst, b, h) do { _Pragma("unroll") for (int m = 0; m < 4; ++m) _Pragma("unroll") for (int k = 0; k < 2; ++k) dst[m][k] = *(const PG8_LAS bf16x8*)(lds + PG8_SA(b, h) + aoff + m * 2048 + k * 1024); } while (0)
#define PG8_LDB(dst, b, h) do { _Pragma("unroll") for (int n = 0; n < 2; ++n) _Pragma("unroll") for (int k = 0; k < 2; ++k) dst[n][k] = *(const PG8_LAS bf16x8*)(lds + PG8_SB(b, h) + boff + n * 2048 + k * 1024); } while (0)
#define PG8_MMA(ai, bj, At, Bt) do { __builtin_amdgcn_s_setprio(1); _Pragma("unroll") for (int m = 0; m < 4; ++m) _Pragma("unroll") for (int n = 0; n < 2; ++n) _Pragma("unroll") for (int k = 0; k < 2; ++k) \
        acc[ai][bj][m][n] = __builtin_amdgcn_mfma_f32_16x16x32_bf16(Bt[n][k], At[m][k], acc[ai][bj][m][n], 0, 0, 0); __builtin_amdgcn_s_setprio(0); } while (0)
#define PG8_WAIT_V(n) asm volatile("s_waitcnt vmcnt(" #n ")" ::: "memory")
#define PG8_WAIT_L(n) asm volatile("s_waitcnt lgkmcnt(" #n ")" ::: "memory")
#define PG8_BAR __builtin_amdgcn_s_barrier()
#define PG8_SCHED __builtin_amdgcn_sched_barrier(0)
    Unit cur, nxt; int ui = 0;
    if (!S.next(0, cur)) return;
    f32x4 acc[2][2][4][2];
#pragma unroll
    for (int a = 0; a < 2; ++a)
#pragma unroll
        for (int b = 0; b < 2; ++b)
#pragma unroll
            for (int m = 0; m < 4; ++m)
#pragma unroll
                for (int n = 0; n < 2; ++n) acc[a][b][m][n] = (f32x4){0.f, 0.f, 0.f, 0.f};
    bf16x8 At[4][2], B0[2][2], B1[2][2];
    const char* cA = (const char*)g.A + (size_t)cur.pm * tstep; const char* cB = (const char*)g.Bt + (size_t)cur.pn * tstep;
    S.a_ready(cur);
    if constexpr (SP2) {
        PG8_STAGE(PG8_SB(0, 0), cB, voffB); PG8_STAGE(PG8_SB(0, 1), cB + hstep, voffB); PG8_STAGE(PG8_SA(0, 0), cA, voffA); PG8_STAGE(PG8_SA(0, 1), cA + hstep, voffA);
        if (wr == 1) PG8_BAR;
        PG8_WAIT_V(2); PG8_BAR;
        PG8_STAGE(PG8_SB(1, 0), cB + kstep, voffB); PG8_STAGE(PG8_SA(1, 0), cA + kstep, voffA); PG8_STAGE(PG8_SB(1, 1), cB + hstep + kstep, voffB);
        PG8_WAIT_V(6); PG8_BAR;
    } else {
        PG8_STAGE(PG8_SB(0, 0), cB, voffB); PG8_STAGE(PG8_SA(0, 0), cA, voffA); PG8_STAGE(PG8_SB(0, 1), cB + hstep, voffB); PG8_STAGE(PG8_SA(0, 1), cA + hstep, voffA);
        if (wr == 1) PG8_BAR;
        PG8_WAIT_V(4); PG8_BAR;
        PG8_STAGE(PG8_SB(1, 0), cB + kstep, voffB); PG8_STAGE(PG8_SA(1, 0), cA + kstep, voffA); PG8_STAGE(PG8_SB(1, 1), cB + hstep + kstep, voffB);
        PG8_WAIT_V(6); PG8_BAR;
    }
    for (;;) {
        const bool has_next = S.next(ui + 1, nxt);
        const char* nA = has_next ? (const char*)g.A + (size_t)nxt.pm * tstep : cA; const char* nB = has_next ? (const char*)g.Bt + (size_t)nxt.pn * tstep : cB;
        for (int t = 0; t < nt; t += 2) {
            const bool last = (t == nt - 2);
            const char* a1 = cA + (size_t)(t + 1) * kstep;
            const char* a2 = last ? nA : cA + (size_t)(t + 2) * kstep; const char* b2 = last ? nB : cB + (size_t)(t + 2) * kstep;
            const char* a3 = a2 + kstep; const char* b3 = b2 + kstep;
            if (last && has_next) S.a_ready(nxt);
            if constexpr (SP2) {
            PG8_LDB(B0, 0, 0); PG8_LDB(B1, 0, 1); PG8_SCHED; PG8_LDA(At, 0, 0); PG8_STAGE(PG8_SA(1, 1), a1 + hstep, voffA);
            PG8_WAIT_V(8); PG8_WAIT_L(0); PG8_BAR; PG8_MMA(0, 0, At, B0); PG8_MMA(0, 1, At, B1); PG8_BAR; PG8_SCHED;
            PG8_LDA(At, 0, 1); PG8_STAGE(PG8_SB(0, 0), b2, voffB); PG8_STAGE(PG8_SB(0, 1), b2 + hstep, voffB); PG8_STAGE(PG8_SA(0, 0), a2, voffA);
            PG8_WAIT_V(8); PG8_WAIT_L(0); PG8_BAR; PG8_MMA(1, 0, At, B0); PG8_MMA(1, 1, At, B1); PG8_BAR; PG8_SCHED;
            PG8_LDB(B0, 1, 0); PG8_LDB(B1, 1, 1); PG8_SCHED; PG8_LDA(At, 1, 0); PG8_STAGE(PG8_SA(0, 1), a2 + hstep, voffA);
            PG8_WAIT_V(8); PG8_WAIT_L(0); PG8_BAR; PG8_MMA(0, 0, At, B0); PG8_MMA(0, 1, At, B1); PG8_BAR; PG8_SCHED;
            PG8_LDA(At, 1, 1); PG8_STAGE(PG8_SB(1, 0), b3, voffB); PG8_STAGE(PG8_SB(1, 1), b3 + hstep, voffB); PG8_STAGE(PG8_SA(1, 0), a3, voffA);
            PG8_WAIT_V(8); PG8_WAIT_L(0); PG8_BAR; PG8_MMA(1, 0, At, B0); PG8_MMA(1, 1, At, B1); PG8_BAR; PG8_SCHED;
            } else {
            PG8_LDB(B0, 0, 0); PG8_SCHED; PG8_LDA(At, 0, 0); PG8_STAGE(PG8_SA(1, 1), a1 + hstep, voffA);
            PG8_WAIT_L(8); PG8_BAR; PG8_WAIT_L(0); PG8_MMA(0, 0, At, B0); PG8_BAR; PG8_SCHED;
            PG8_LDB(B1, 0, 1); PG8_STAGE(PG8_SB(0, 0), b2, voffB);
            PG8_BAR; PG8_WAIT_L(0); PG8_MMA(0, 1, At, B1); PG8_BAR;
            PG8_LDA(At, 0, 1); PG8_STAGE(PG8_SA(0, 0), a2, voffA);
            PG8_BAR; PG8_WAIT_L(0); PG8_MMA(1, 0, At, B0); PG8_BAR; PG8_SCHED;
            PG8_STAGE(PG8_SB(0, 1), b2 + hstep, voffB);
            PG8_WAIT_V(6); PG8_BAR; PG8_MMA(1, 1, At, B1); PG8_BAR;
            PG8_LDB(B0, 1, 0); PG8_SCHED; PG8_LDA(At, 1, 0); PG8_STAGE(PG8_SA(0, 1), a2 + hstep, voffA);
            PG8_WAIT_L(8); PG8_BAR; PG8_WAIT_L(0); PG8_MMA(0, 0, At, B0); PG8_BAR; PG8_SCHED;
            PG8_LDB(B1, 1, 1); PG8_STAGE(PG8_SB(1, 0), b3, voffB);
            PG8_BAR; PG8_WAIT_L(0); PG8_MMA(0, 1, At, B1); PG8_BAR;
            PG8_LDA(At, 1, 1); PG8_STAGE(PG8_SA(1, 0), a3, voffA);
            PG8_BAR; PG8_WAIT_L(0); PG8_MMA(1, 0, At, B0); PG8_BAR; PG8_SCHED;
            PG8_STAGE(PG8_SB(1, 1), b3 + hstep, voffB);
            PG8_WAIT_V(6); PG8_BAR; PG8_MMA(1, 1, At, B1); PG8_BAR;
            }
        }
        if constexpr (ALIGN_EPI) { if (wr == 0) PG8_BAR; }
        if constexpr (!Epi::AFTER_DRAIN) { E(acc, cur, wr, wc, fr, fq); S.done(cur); }
        if (!has_next) break;
#pragma unroll
        for (int a = 0; a < 2; ++a)
#pragma unroll
            for (int b = 0; b < 2; ++b)
#pragma unroll
                for (int m = 0; m < 4; ++m)
#pragma unroll
                    for (int n = 0; n < 2; ++n) acc[a][b][m][n] = (f32x4){0.f, 0.f, 0.f, 0.f};
        cur = nxt; cA = nA; cB = nB; ++ui;
        if constexpr (ALIGN_EPI) { if (wr == 1) PG8_BAR; }
    }
    PG8_WAIT_V(0);
    if constexpr (!ALIGN_EPI) { if (wr == 0) PG8_BAR; }
    PG8_BAR;
    if constexpr (Epi::AFTER_DRAIN) { E.fused(acc, cur, wr, wc, fr, fq, lds, wid, lane); S.done(cur); }
#undef PG8_SA
#undef PG8_SB
#undef PG8_STAGE
#undef PG8_LDA
#undef PG8_LDB
#undef PG8_MMA
#undef PG8_WAIT_V
#undef PG8_WAIT_L
#undef PG8_BAR
#undef PG8_SCHED
}
}

using namespace pg8;
#define LAS __attribute__((address_space(3)))
typedef short s16x4 __attribute__((ext_vector_type(4)));
#ifndef N_LAUNCH
#define N_LAUNCH 1
#endif
constexpr int NPHASE = 9;
constexpr int LDS_BYTES = 135168;
constexpr size_t MiB = 1u << 20;
constexpr size_t WS_SS2 = 0, WS_SSE = 1310720, WS_SSO = 2621440, WS_ROPE = 3932160;
constexpr size_t WS_WIN = 6 * MiB, WS_WEFF = 14 * MiB, WS_WAB = 15 * MiB, WS_WOUT = 17 * MiB, WS_WFI = 19 * MiB, WS_WFO = 30 * MiB, WS_WPP = 35 * MiB + 524288, WS_WPG = 36 * MiB;
constexpr size_t WS_PB = 38 * MiB;
constexpr size_t WS_RA = 47 * MiB;
constexpr size_t WS_RG = 80 * MiB;
constexpr size_t WS_UB = 145 * MiB, WS_QB = 161 * MiB + 262144, WS_KB = 193 * MiB + 786432, WS_VB = 201 * MiB + 917504, WS_MB = 210 * MiB;
constexpr size_t WS_MG = WS_QB;
constexpr size_t WS_ACT = 145 * MiB;
constexpr size_t WS_END = 256 * MiB;
static_assert(WS_UB + (size_t)MPAD * 512 * 2 == WS_QB && WS_QB + (size_t)MPAD * 1024 * 2 == WS_KB && WS_KB + (size_t)MPAD * 256 * 2 == WS_VB && WS_VB + (size_t)MPAD * 256 * 2 == WS_MB, "ws map");
static_assert(WS_MB + (size_t)MPAD * 512 * 2 <= WS_END && WS_ACT + (size_t)MPAD * FFH * 2 <= WS_END && WS_RA + (size_t)MPAD * 2048 <= WS_RG && WS_RG + (size_t)MPAD * 4096 <= WS_UB && WS_PB + (size_t)MPAD * 512 <= WS_RA, "ws map 2");
static_assert(WS_ROPE + 8193 * 64 <= WS_WIN && (size_t)MPAD * 64 <= WS_SSE, "ws map 3");

__device__ const float ROPE_INV[8] = {1.0f, 0.19392274474868576f, 0.03760603093086393f, 0.007292664737217109f, 0.001414213562373095f, 0.0002742481756762073f, 5.318295896944988e-05f, 1.031338537721246e-05f};

__device__ __forceinline__ unsigned f2bf(float f) { unsigned u = __builtin_bit_cast(unsigned, f); return (u + 0x7fffu + ((u >> 16) & 1u)) >> 16; }
__device__ __forceinline__ unsigned pk2(float lo, float hi) { return f2bf(lo) | (f2bf(hi) << 16); }
__device__ __forceinline__ float wave_sum(float v) {
#pragma unroll
    for (int o = 1; o < 64; o <<= 1) v += __shfl_xor(v, o);
    return v;
}
__device__ __forceinline__ float wave_max(float v) {
#pragma unroll
    for (int o = 1; o < 64; o <<= 1) v = fmaxf(v, __shfl_xor(v, o));
    return v;
}
#define LDS_WAIT() asm volatile("s_waitcnt lgkmcnt(0)" ::: "memory")

struct Args { const float* in[22]; float* out; unsigned char* ws; int ph_lo, ph_hi; };
typedef const float* cfp_t;
__device__ __forceinline__ cfp_t karg_in(int k) { const __attribute__((address_space(4))) char* kp = (const __attribute__((address_space(4))) char*)__builtin_amdgcn_kernarg_segment_ptr(); return *(const volatile __attribute__((address_space(4))) cfp_t*)(kp + 8 * k); }
__device__ __forceinline__ float* karg_out() { return (float*)karg_in(22); }
__device__ __forceinline__ unsigned char* karg_ws() { return (unsigned char*)karg_in(23); }
struct TItem { const float* W; bf16_t* WT; int K, N, mode, r; };
__device__ __forceinline__ TItem p0_item(unsigned char* ws, int it) {
    constexpr int I_IN = 16 * 128, I_AB = 16 * 32, I_OUT = 16 * 32, I_FI = 16 * 176, I_FO = 44 * 32, I_PP = 4 * 32;
    int r = it;
    if (r < I_IN) return TItem{karg_in(8), (bf16_t*)(ws + WS_WIN), 1024, INC, 0, r}; r -= I_IN;
    if (r < I_AB) return TItem{karg_in(13), (bf16_t*)(ws + WS_WAB), 1024, 1024, 0, r}; r -= I_AB;
    if (r < I_OUT) return TItem{karg_in(14), (bf16_t*)(ws + WS_WOUT), 1024, 1024, 0, r}; r -= I_OUT;
    if (r < I_FI) return TItem{karg_in(16), (bf16_t*)(ws + WS_WFI), 1024, 2 * FFH, 1, r}; r -= I_FI;
    if (r < I_FO) return TItem{karg_in(17), (bf16_t*)(ws + WS_WFO), FFH, 1024, 0, r}; r -= I_FO;
    if (r < I_PP) return TItem{karg_in(18), (bf16_t*)(ws + WS_WPP), PLE, 1024, 0, r}; r -= I_PP;
    return TItem{karg_in(20), (bf16_t*)(ws + WS_WPG), 1024, 1024, 0, r};
}
__device__ __forceinline__ void p0_item_load(const TItem& t, float (&wv)[32], int lane) {
    const int nblk = t.N / 32, kb = t.r / nblk, nb = t.r % nblk, k0 = 64 * kb, n0 = 32 * nb;
#pragma unroll
    for (int i = 0; i < 32; ++i) wv[i] = __builtin_nontemporal_load(t.W + (size_t)(k0 + 2 * i + (lane >> 5)) * t.N + n0 + (lane & 31));
}
__device__ __forceinline__ void p0_item_finish(const TItem& t, const float (&wv)[32], LAS float* scr, int lane, const float* kscale) {
    const int nblk = t.N / 32, kb = t.r / nblk, nb = t.r % nblk, k0 = 64 * kb, n0 = 32 * nb;
    if (t.mode == 1) {
#pragma unroll
        for (int i = 0; i < 32; ++i) scr[(2 * i + (lane >> 5)) * 33 + (lane & 31)] = wv[i] * kscale[k0 + 2 * i + (lane >> 5)];
    } else {
#pragma unroll
        for (int i = 0; i < 32; ++i) scr[(2 * i + (lane >> 5)) * 33 + (lane & 31)] = wv[i];
    }
    LDS_WAIT();
    const int c = lane & 7;
#pragma unroll
    for (int j = 0; j < 4; ++j) { const int n = (lane >> 3) + 8 * j; const LAS float* s = scr + (8 * c) * 33 + n;
        u32x4 o; o.x = pk2(s[0 * 33], s[1 * 33]); o.y = pk2(s[2 * 33], s[3 * 33]); o.z = pk2(s[4 * 33], s[5 * 33]); o.w = pk2(s[6 * 33], s[7 * 33]);
        int nn = n0 + n;
        if (t.mode == 1) { const int up = nn >= FFH ? 1 : 0; const int jj = nn - up * FFH; nn = 8 * (jj >> 2) + 4 * up + (jj & 3); }
        *(u32x4*)(t.WT + (size_t)nn * t.K + k0 + 8 * c) = o; }
    LDS_WAIT();
}
__device__ __forceinline__ void rms_row_to_bf16(const float* xrow, const float* gamma, bf16_t* orow, int lane) {
    const f32x4* xr = (const f32x4*)xrow + lane; f32x4 v[4]; float s = 0.f;
#pragma unroll
    for (int j = 0; j < 4; ++j) { v[j] = xr[64 * j]; s += sum4(v[j] * v[j]); }
    const float rs = rsqrtf(wave_sum(s) * (1.0f / DM) + EPS);
    u32x2* o8 = (u32x2*)orow + lane;
#pragma unroll
    for (int j = 0; j < 4; ++j) { const f32x4 g = ((const f32x4*)gamma)[lane + 64 * j]; const f32x4 y = v[j] * rs * g; u32x2 w; w.x = pk2(y[0], y[1]); w.y = pk2(y[2], y[3]); o8[64 * j] = w; }
}


template <int PART>
__device__ __forceinline__ void p0_prologue(LAS unsigned char* lds, int tid, int wave, int lane, int cidx, int cnum) {
    unsigned char* ws = karg_ws(); float* const aout = karg_out(); (void)aout;
    LAS float* scr = (LAS float*)(lds + wave * 16384);
    const int gw = cidx * 8 + wave, NGW = cnum * 8;
    const int gt = cidx * 512 + tid, NGT = cnum * 512;
    constexpr int I_IN = 16 * 128, I_AB = 16 * 32, I_OUT = 16 * 32, I_FI = 16 * 176, I_FO = 44 * 32, I_PP = 4 * 32, I_PG = 16 * 32;
    constexpr int NITEMS = I_IN + I_AB + I_OUT + I_FI + I_FO + I_PP + I_PG;
    {
        const int it_end = (PART == 0 ? I_IN : NITEMS); int it = (PART == 0 ? gw : I_IN + gw); const float* const ln2_ = karg_in(15);
        if (it < it_end) {
            TItem cur = p0_item(ws, it); float wv[32]; p0_item_load(cur, wv, lane);
            for (;;) {
                const int nx = it + NGW; const bool more = nx < it_end; TItem nxt = cur; float wn[32];
                if (more) { nxt = p0_item(ws, nx); p0_item_load(nxt, wn, lane); }
                p0_item_finish(cur, wv, scr, lane, ln2_);
                if (!more) break;
                cur = nxt; it = nx;
#pragma unroll
                for (int i = 0; i < 32; ++i) wv[i] = wn[i];
            }
        }
    }
    if (PART == 1) {
        const float* gwt = karg_in(9); const float* sc = karg_in(10); const float* wpb = karg_in(12); bf16_t* weff = (bf16_t*)(ws + WS_WEFF);
        const int fr = lane & 15, fq = lane >> 4;
        for (int t = gw; t < 4 * 8 * 64; t += NGW) {
            const int nt = t & 63, kt = (t >> 6) & 7, g = t >> 9;
            const float* ga = gwt + (size_t)(g * 128 + kt * 16 + fr) * 128 + fq * 8;
            const float* wb = wpb + (size_t)(g * 128 + fq * 8) * 1024 + nt * 16 + fr;
            const float* sg = sc + g * 128 + fq * 8;
            f32x4 a0[4], a1[4]; float bv[4][8], sv[4][8];
#pragma unroll
            for (int cs = 0; cs < 4; ++cs) { a0[cs] = *(const f32x4*)(ga + cs * 32); a1[cs] = *(const f32x4*)(ga + cs * 32 + 4);
#pragma unroll
                for (int e = 0; e < 8; ++e) { bv[cs][e] = wb[(size_t)(cs * 32 + e) * 1024]; sv[cs][e] = sg[cs * 32 + e]; } }
            f32x4 acc = {0.f, 0.f, 0.f, 0.f};
#pragma unroll
            for (int cs = 0; cs < 4; ++cs) {
                u32x4 aw; aw.x = pk2(a0[cs][0], a0[cs][1]); aw.y = pk2(a0[cs][2], a0[cs][3]); aw.z = pk2(a1[cs][0], a1[cs][1]); aw.w = pk2(a1[cs][2], a1[cs][3]);
                u32x4 bw; bw.x = pk2(bv[cs][0] * sv[cs][0], bv[cs][1] * sv[cs][1]); bw.y = pk2(bv[cs][2] * sv[cs][2], bv[cs][3] * sv[cs][3]); bw.z = pk2(bv[cs][4] * sv[cs][4], bv[cs][5] * sv[cs][5]); bw.w = pk2(bv[cs][6] * sv[cs][6], bv[cs][7] * sv[cs][7]);
                acc = __builtin_amdgcn_mfma_f32_16x16x32_bf16(__builtin_bit_cast(bf16x8, aw), __builtin_bit_cast(bf16x8, bw), acc, 0, 0, 0); }
            u32x2 o; o.x = pk2(acc[0], acc[1]); o.y = pk2(acc[2], acc[3]);
            *(u32x2*)(weff + (size_t)(nt * 16 + fr) * 512 + g * 128 + kt * 16 + 4 * fq) = o;
        }
    }
    if (PART == 0) { const float* const xp_ = karg_in(0); const float* const xs_ = karg_in(1); const float* const ln1_ = karg_in(7);
    for (int m = gw * 2; m < MREAL; m += NGW * 2) {
        const int m1 = m + 1;
        const f32x4* x0 = (const f32x4*)(m < MPR ? xp_ + (size_t)m * DM : xs_ + (size_t)(m - MPR) * DM) + lane;
        const f32x4* x1 = (const f32x4*)(m1 < MPR ? xp_ + (size_t)m1 * DM : xs_ + (size_t)(m1 - MPR) * DM) + lane;
        f32x4 v0[4], v1[4]; float s0 = 0.f, s1 = 0.f;
#pragma unroll
        for (int j = 0; j < 4; ++j) { v0[j] = __builtin_nontemporal_load(x0 + 64 * j); v1[j] = __builtin_nontemporal_load(x1 + 64 * j); }
#pragma unroll
        for (int j = 0; j < 4; ++j) { s0 += sum4(v0[j] * v0[j]); s1 += sum4(v1[j] * v1[j]); }
        const float r0 = rsqrtf(wave_sum(s0) * (1.0f / DM) + EPS), r1 = rsqrtf(wave_sum(s1) * (1.0f / DM) + EPS);
        u32x2* o0 = (u32x2*)((bf16_t*)(ws + WS_RA) + (size_t)m * DM) + lane; u32x2* o1 = (u32x2*)((bf16_t*)(ws + WS_RA) + (size_t)m1 * DM) + lane;
#pragma unroll
        for (int j = 0; j < 4; ++j) { const f32x4 g = ((const f32x4*)ln1_)[lane + 64 * j]; const f32x4 y0 = v0[j] * r0 * g, y1 = v1[j] * r1 * g;
            u32x2 w0, w1; w0.x = pk2(y0[0], y0[1]); w0.y = pk2(y0[2], y0[3]); w1.x = pk2(y1[0], y1[1]); w1.y = pk2(y1[2], y1[3]); o0[64 * j] = w0; o1[64 * j] = w1; }
    } }
    if (PART == 1) { const float* const pp_ = karg_in(2); const float* const ps_ = karg_in(3);
    for (int idx0 = gt; idx0 < MREAL * 32; idx0 += NGT * 4) {
        f32x4 v0[4], v1[4];
#pragma unroll
        for (int q = 0; q < 4; ++q) { const int idx = idx0 + q * NGT; if (idx < MREAL * 32) { const int m = idx >> 5, c = (idx & 31) * 8; const float* pr = (m < MPR ? pp_ + (size_t)m * PLE : ps_ + (size_t)(m - MPR) * PLE) + c; v0[q] = __builtin_nontemporal_load((const f32x4*)pr); v1[q] = __builtin_nontemporal_load((const f32x4*)(pr + 4)); } }
#pragma unroll
        for (int q = 0; q < 4; ++q) { const int idx = idx0 + q * NGT; if (idx < MREAL * 32) { const int m = idx >> 5, c = (idx & 31) * 8;
            u32x4 w; w.x = pk2(v0[q][0], v0[q][1]); w.y = pk2(v0[q][2], v0[q][3]); w.z = pk2(v1[q][0], v1[q][1]); w.w = pk2(v1[q][2], v1[q][3]);
            *(u32x4*)((bf16_t*)(ws + WS_PB) + (size_t)m * PLE + c) = w; } }
    } }
    if (PART == 0) for (int idx = gt; idx < 8193 * 8; idx += NGT) {
        const int pi = idx >> 3, i = idx & 7; const float pos = pi < SEQ ? (float)pi : 16384.0f; const float ang = pos * ROPE_INV[i];
        const double tw = 6.283185307179586476925; const double kq = __builtin_rint((double)ang * (1.0 / tw)); const float r = (float)((double)ang - kq * tw);
        float* rp = (float*)(ws + WS_ROPE) + (size_t)pi * 16; rp[i] = __cosf(r); rp[8 + i] = __sinf(r);
    }
    if (PART == 1) { const float* const st_ = karg_in(6);
    for (int idx = gt; idx < MSM * 14 * 128; idx += NGT) {
        const int b = idx / (14 * 128), rem = idx % (14 * 128), r = rem >> 7, c = (rem & 127) * 4;
        *(f32x4*)(aout + O_NPS + ((size_t)b * 15 + r) * 512 + c) = *(const f32x4*)(st_ + ((size_t)b * 15 + r + 1) * 512 + c);
    } }
}

__device__ __forceinline__ f32x4 ld4bf(const bf16_t* p) { const u32x2 w = *(const u32x2*)p; return (f32x4){bflo(w.x), bfhi(w.x), bflo(w.y), bfhi(w.y)}; }
__device__ __forceinline__ f32x4 mfma16(const bf16x8 a, const bf16x8 b, const f32x4 c) { return __builtin_amdgcn_mfma_f32_16x16x32_bf16(a, b, c, 0, 0, 0); }

struct KVRegs { u32x4 k[4], v[4]; };
__device__ __forceinline__ void attn_kv_load(KVRegs& r, int unit, const bf16_t* kb, const bf16_t* vb, int tid) {
    const int kvh = unit & 3, nb = (unit >> 2) & 63, b = unit >> 8, R0 = b * SEQ + nb * 128;
#pragma unroll
    for (int i = 0; i < 4; ++i) { const int c = tid + 512 * i, s = c >> 3, seg = c & 7; const bool ok = (nb > 0) || (s >= 128);
        r.k[i] = (u32x4){0u, 0u, 0u, 0u}; r.v[i] = (u32x4){0u, 0u, 0u, 0u};
        if (ok) { const size_t go = (size_t)(R0 - 128 + s) * 256 + kvh * 64 + seg * 8; r.k[i] = *(const u32x4*)(kb + go); r.v[i] = *(const u32x4*)(vb + go); } }
}
__device__ __forceinline__ void attn_kv_store(const KVRegs& r, LAS unsigned char* lds, int tid) {
    LAS bf16_t* Ks = (LAS bf16_t*)lds; LAS bf16_t* Vt = (LAS bf16_t*)(lds + 256 * 72 * 2);
#pragma unroll
    for (int i = 0; i < 4; ++i) { const int c = tid + 512 * i, s = c >> 3, seg = c & 7;
        *(LAS u32x4*)(Ks + s * 72 + seg * 8) = r.k[i];
        LAS bf16_t* vp = Vt + (seg * 8) * 264 + (s ^ (seg * 8)); const u32x4 vv = r.v[i];
        vp[0 * 264] = (bf16_t)(vv.x & 0xffffu); vp[1 * 264] = (bf16_t)(vv.x >> 16); vp[2 * 264] = (bf16_t)(vv.y & 0xffffu); vp[3 * 264] = (bf16_t)(vv.y >> 16);
        vp[4 * 264] = (bf16_t)(vv.z & 0xffffu); vp[5 * 264] = (bf16_t)(vv.z >> 16); vp[6 * 264] = (bf16_t)(vv.w & 0xffffu); vp[7 * 264] = (bf16_t)(vv.w >> 16); }
}
__device__ __forceinline__ void attn_prompt_math(LAS unsigned char* lds, int unit, const bf16_t* qb, bf16_t* ob, const float* sinks, int wave, int lane) {
    const int kvh = unit & 3, nb = (unit >> 2) & 63, b = unit >> 8, R0 = b * SEQ + nb * 128;
    const LAS bf16_t* Ks = (const LAS bf16_t*)lds; const LAS bf16_t* Vt = (const LAS bf16_t*)(lds + 256 * 72 * 2);
    const int g = wave >> 1, half = wave & 1, h = kvh * 4 + g, fr = lane & 15, fq = lane >> 4;
    const float sink = sinks[h];
    bf16x8 qf[4][2];
#pragma unroll
    for (int sb = 0; sb < 4; ++sb) { const bf16_t* qp = qb + (size_t)(R0 + half * 64 + sb * 16 + fr) * 1024 + h * 64 + fq * 8; qf[sb][0] = *(const bf16x8*)qp; qf[sb][1] = *(const bf16x8*)(qp + 32); }
#pragma unroll
    for (int sb = 0; sb < 4; ++sb) {
        const int qi0 = half * 64 + sb * 16, kt0 = qi0 >> 4, q = qi0 + fr;
        f32x4 S[9];
#pragma unroll
        for (int j = 0; j < 9; ++j) { const LAS bf16_t* kp = Ks + ((kt0 + j) * 16 + fr) * 72 + fq * 8;
            f32x4 acc = {0.f, 0.f, 0.f, 0.f}; acc = mfma16(*(const LAS bf16x8*)kp, qf[sb][0], acc); acc = mfma16(*(const LAS bf16x8*)(kp + 32), qf[sb][1], acc); S[j] = acc; }
        float mx = sink; const int e = fr - 4 * fq;
#pragma unroll
        for (int j = 0; j < 9; ++j) { const bool tok = (nb > 0) || (kt0 + j >= 8);
#pragma unroll
            for (int jj = 0; jj < 4; ++jj) { bool valid = tok; if (j == 0) valid = valid && (e < jj); if (j == 8) valid = valid && (e >= jj);
                const float v = valid ? S[j][jj] : -1e30f; S[j][jj] = v; mx = fmaxf(mx, v); } }
        mx = fmaxf(mx, __shfl_xor(mx, 16)); mx = fmaxf(mx, __shfl_xor(mx, 32));
        float l = 0.f;
#pragma unroll
        for (int j = 0; j < 9; ++j)
#pragma unroll
            for (int jj = 0; jj < 4; ++jj) { const float p = __expf(S[j][jj] - mx); S[j][jj] = p; l += p; }
        l += __shfl_xor(l, 16); l += __shfl_xor(l, 32); l += __expf(sink - mx);
        const float inv = 1.0f / l;
        f32x4 O[4];
#pragma unroll
        for (int dt = 0; dt < 4; ++dt) O[dt] = (f32x4){0.f, 0.f, 0.f, 0.f};
#pragma unroll
        for (int jp = 0; jp < 5; ++jp) {
            u32x4 pw; pw.x = cvt_pk_bf16_v(S[2 * jp][0], S[2 * jp][1]); pw.y = cvt_pk_bf16_v(S[2 * jp][2], S[2 * jp][3]);
            if (jp < 4) { pw.z = cvt_pk_bf16_v(S[2 * jp + 1 < 9 ? 2 * jp + 1 : 8][0], S[2 * jp + 1 < 9 ? 2 * jp + 1 : 8][1]); pw.w = cvt_pk_bf16_v(S[2 * jp + 1 < 9 ? 2 * jp + 1 : 8][2], S[2 * jp + 1 < 9 ? 2 * jp + 1 : 8][3]); } else { pw.z = 0u; pw.w = 0u; }
            const bf16x8 pf = __builtin_bit_cast(bf16x8, pw);
#pragma unroll
            for (int dt = 0; dt < 4; ++dt) { const int d = dt * 16 + fr, sw = ((d >> 3) & 7) * 8, s0 = (kt0 + 2 * jp) * 16 + fq * 4; const LAS bf16_t* vr = Vt + d * 264;
                const s16x4 lo = *(const LAS s16x4*)(vr + (s0 ^ sw)); s16x4 hi = {0, 0, 0, 0}; if (jp < 4) hi = *(const LAS s16x4*)(vr + ((s0 + 16) ^ sw));
                const bf16x8 vf = {lo[0], lo[1], lo[2], lo[3], hi[0], hi[1], hi[2], hi[3]};
                O[dt] = mfma16(vf, pf, O[dt]); }
        }
        bf16_t* op = ob + (size_t)(R0 + q) * 1024 + h * 64 + fq * 4;
#pragma unroll
        for (int dt = 0; dt < 4; ++dt) { const f32x4 o = O[dt] * inv; u32x2 w; w.x = cvt_pk_bf16(o[0], o[1]); w.y = cvt_pk_bf16(o[2], o[3]); *(u32x2*)(op + dt * 16) = w; }
    }
}
__device__ __forceinline__ void attn_prompt_all(LAS unsigned char* lds, const bf16_t* qb, const bf16_t* kb, const bf16_t* vb, bf16_t* ob, const float* sinks, int tid, int wave, int lane) {
    const int G = gridDim.x; int unit = blockIdx.x; if (unit >= 512) return;
    KVRegs r; attn_kv_load(r, unit, kb, vb, tid);
    for (;;) {
        attn_kv_store(r, lds, tid);
        __syncthreads();
        const int nxt = unit + G;
        if (nxt < 512) attn_kv_load(r, nxt, kb, vb, tid);
        attn_prompt_math(lds, unit, qb, ob, sinks, wave, lane);
        __syncthreads();
        if (nxt >= 512) break;
        unit = nxt;
    }
}

__device__ __forceinline__ void attn_sample_unit(LAS unsigned char* lds, int unit, const bf16_t* qb, const bf16_t* kb, const bf16_t* vb, bf16_t* ob, const float* cache_k, const float* cache_v, const float* sinks, float* out, int tid, int wave, int lane) {
    const int kvh = unit & 3, b = unit >> 2; const size_t row = MPR + b;
    LAS float* sc = (LAS float*)lds;
    LAS float* lsum = sc + 4 * 132;
    LAS float* opart = sc + 4 * 132 + 16;
    const int jq = lane >> 4, dq = lane & 15;
    f32x4 qv[4];
#pragma unroll
    for (int g = 0; g < 4; ++g) qv[g] = ld4bf(qb + row * 1024 + (kvh * 4 + g) * 64 + dq * 4);
    f32x4 kv[4], vv[4];
#pragma unroll
    for (int i = 0; i < 4; ++i) { const int j = wave * 16 + i * 4 + jq; const size_t off = ((size_t)(b * 128 + j) * 4 + kvh) * 64 + dq * 4;
        kv[i] = __builtin_nontemporal_load((const f32x4*)(cache_k + off)); vv[i] = __builtin_nontemporal_load((const f32x4*)(cache_v + off)); }
    const f32x4 knew = ld4bf(kb + row * 256 + kvh * 64 + dq * 4);
#pragma unroll
    for (int i = 0; i < 4; ++i) { const int j = wave * 16 + i * 4 + jq;
        if (j >= 1) { const size_t off = ((size_t)(b * 128 + j - 1) * 4 + kvh) * 64 + dq * 4; __builtin_nontemporal_store(kv[i], (f32x4*)(out + O_NKS + off)); __builtin_nontemporal_store(vv[i], (f32x4*)(out + O_NVS + off)); } }
#pragma unroll
    for (int i = 0; i < 5; ++i) { const f32x4 kk = i < 4 ? kv[i < 4 ? i : 0] : knew; float mine = 0.f;
#pragma unroll
        for (int g = 0; g < 4; ++g) { float p = sum4(kk * qv[g]); p += __shfl_xor(p, 1); p += __shfl_xor(p, 2); p += __shfl_xor(p, 4); p += __shfl_xor(p, 8); if (dq == g) mine = p; }
        if (i < 4) { if (dq < 4) sc[dq * 132 + wave * 16 + i * 4 + jq] = mine; }
        else if (wave == 0 && jq == 0 && dq < 4) sc[dq * 132 + 128] = mine; }
    __syncthreads();
    if (wave < 4) { const int g = wave; float a = sc[g * 132 + lane]; const float b2 = sc[g * 132 + 64 + lane], n = sc[g * 132 + 128], sink = sinks[kvh * 4 + g];
        if (lane == 0) a = -1e30f;
        const float mx = fmaxf(fmaxf(wave_max(fmaxf(a, b2)), n), sink);
        const float pa = __expf(a - mx), pb = __expf(b2 - mx), pnw = __expf(n - mx); const float l = wave_sum(pa + pb) + pnw + __expf(sink - mx);
        sc[g * 132 + lane] = pa; sc[g * 132 + 64 + lane] = pb; if (lane == 0) { sc[g * 132 + 128] = pnw; lsum[g] = 1.0f / l; } }
    __syncthreads();
    f32x4 o[4];
#pragma unroll
    for (int g = 0; g < 4; ++g) o[g] = (f32x4){0.f, 0.f, 0.f, 0.f};
#pragma unroll
    for (int i = 0; i < 4; ++i) { const int j = wave * 16 + i * 4 + jq;
#pragma unroll
        for (int g = 0; g < 4; ++g) o[g] += vv[i] * sc[g * 132 + j]; }
#pragma unroll
    for (int g = 0; g < 4; ++g)
#pragma unroll
        for (int e = 0; e < 4; ++e) { float t = o[g][e]; t += __shfl_xor(t, 16); t += __shfl_xor(t, 32); o[g][e] = t; }
    if (jq == 0) {
#pragma unroll
        for (int g = 0; g < 4; ++g) *(LAS f32x4*)(opart + (wave * 4 + g) * 64 + dq * 4) = o[g]; }
    __syncthreads();
    if (tid < 256) { const int g = tid >> 6, d = tid & 63; float acc = 0.f;
#pragma unroll
        for (int w = 0; w < 8; ++w) acc += opart[(w * 4 + g) * 64 + d];
        acc += sc[g * 132 + 128] * bflo((unsigned)vb[row * 256 + kvh * 64 + d]);
        ob[row * 1024 + (kvh * 4 + g) * 64 + d] = (bf16_t)f2bf(acc * lsum[g]); }
    __syncthreads();
}

template <int W>
__device__ __forceinline__ void pool_item(const bf16_t* __restrict__ ub, bf16_t* __restrict__ mb, const float* __restrict__ state, int row, int ch) {
    f32x4 u0, u1; unpack8(*(const u32x4*)(ub + (size_t)row * 512 + ch), u0, u1);
    f32x4 s0 = u0, s1 = u1; float cnt;
    if (row < MPR) { const int t = row & (SEQ - 1); cnt = (float)((t + 1 < W) ? t + 1 : W);
        u32x4 w[W - 1];
#pragma unroll
        for (int i = 1; i < W; ++i) { w[i - 1] = (u32x4){0u, 0u, 0u, 0u}; if (i <= t) w[i - 1] = *(const u32x4*)(ub + (size_t)(row - i) * 512 + ch); }
#pragma unroll
        for (int i = 1; i < W; ++i) { f32x4 a0, a1; unpack8(w[i - 1], a0, a1); s0 += a0; s1 += a1; } }
    else { const int b = row - MPR; cnt = (float)W;
#pragma unroll
        for (int i = 1; i < W; ++i) { const float* sp = state + ((size_t)b * 15 + 15 - i) * 512 + ch; s0 += *(const f32x4*)sp; s1 += *(const f32x4*)(sp + 4); } }
    const float ic = 1.0f / cnt;
    *(u32x4*)(mb + (size_t)row * 512 + ch) = pack8(s0 * ic - u0, s1 * ic - u1);
}
template <int W>
__device__ __forceinline__ void pool_block4(const bf16_t* __restrict__ ub, bf16_t* __restrict__ mb, const float* __restrict__ state, int row0, int ch) {
    if (row0 >= MPR) {
#pragma unroll
        for (int r = 0; r < 4; ++r) pool_item<W>(ub, mb, state, row0 + r, ch);
        return;
    }
    const int t0 = row0 & (SEQ - 1);
    u32x4 w[W + 3];
#pragma unroll
    for (int j = 0; j < W + 3; ++j) { w[j] = (u32x4){0u, 0u, 0u, 0u}; if (t0 + j - (W - 1) >= 0) w[j] = *(const u32x4*)(ub + (size_t)(row0 + j - (W - 1)) * 512 + ch); }
    f32x4 s0 = {0.f, 0.f, 0.f, 0.f}, s1 = {0.f, 0.f, 0.f, 0.f};
#pragma unroll
    for (int j = 0; j < W - 1; ++j) { f32x4 a0, a1; unpack8(w[j], a0, a1); s0 += a0; s1 += a1; }
#pragma unroll
    for (int r = 0; r < 4; ++r) {
        f32x4 u0, u1; unpack8(w[W - 1 + r], u0, u1); s0 += u0; s1 += u1;
        const int n = (t0 + r + 1 < W) ? t0 + r + 1 : W; const float ic = 1.0f / (float)n;
        *(u32x4*)(mb + (size_t)(row0 + r) * 512 + ch) = pack8(s0 * ic - u0, s1 * ic - u1);
        f32x4 o0, o1; unpack8(w[r], o0, o1); s0 -= o0; s1 -= o1;
    }
}
__device__ __forceinline__ void pool_items(unsigned char* ws, const float* __restrict__ state, int tid) {
    const bf16_t* __restrict__ ub = (const bf16_t*)(ws + WS_UB); bf16_t* __restrict__ mb = (bf16_t*)(ws + WS_MB);
    for (int idx = blockIdx.x * 512 + tid; idx < (MREAL / 4) * 64; idx += gridDim.x * 512) {
        const int cgk = idx & 15, g = (idx >> 6) & 3, rb = (idx >> 8) * 4 + ((idx >> 4) & 3), row0 = rb * 4, ch = g * 128 + cgk * 8;
        if (g == 0) pool_block4<2>(ub, mb, state, row0, ch); else if (g == 1) pool_block4<4>(ub, mb, state, row0, ch); else if (g == 2) pool_block4<8>(ub, mb, state, row0, ch); else pool_block4<16>(ub, mb, state, row0, ch);
    }
}

template <int K, class F>
__device__ __forceinline__ void skinny_gemm(LAS unsigned char* lds, const bf16_t* A, const bf16_t* Bt, int wave, int lane, const F& f) {
    constexpr int KQ = K / 4;
    const int fr = lane & 15, fq = lane >> 4, ks = wave & 3;
    for (int tp = blockIdx.x; tp < 256; tp += gridDim.x) {
        const int t = tp * 2 + (wave >> 2), cb = t & 63, rb = t >> 6;
        const bf16_t* ap = A + (size_t)(rb * 16 + fr) * K + ks * KQ + fq * 8;
        const bf16_t* bp = Bt + (size_t)(cb * 16 + fr) * K + ks * KQ + fq * 8;
        f32x4 acc = {0.f, 0.f, 0.f, 0.f};
#pragma unroll 8
        for (int k = 0; k < KQ; k += 32) acc = mfma16(*(const bf16x8*)(bp + k), *(const bf16x8*)(ap + k), acc);
        LAS f32x4* red = (LAS f32x4*)lds;
        red[wave * 64 + lane] = acc;
        __syncthreads();
        if (ks == 0) { acc = (red[wave * 64 + lane] + red[(wave + 1) * 64 + lane]) + (red[(wave + 2) * 64 + lane] + red[(wave + 3) * 64 + lane]);
            f(MPR + rb * 16 + fr, cb * 16 + fq * 4, acc, fq, cb); }
        __syncthreads();
    }
}
__device__ __forceinline__ void st4bf(bf16_t* p, const f32x4 v) { u32x2 w; w.x = cvt_pk_bf16(v[0], v[1]); w.y = cvt_pk_bf16(v[2], v[3]); *(u32x2*)p = w; }
__device__ __forceinline__ void ss_part(float* ss, int row, int cb, int fq, float q) { q += __shfl_xor(q, 16); q += __shfl_xor(q, 32); if (fq == 0) ss[(size_t)MPR * 16 + (size_t)(row - MPR) * 64 + cb] = q; }
template <int K1, int K2, class F>
__device__ __forceinline__ void skinny_gemm2(LAS unsigned char* lds, const bf16_t* A1, const bf16_t* Bt1, const bf16_t* A2, const bf16_t* Bt2, int wave, int lane, const F& f) {
    constexpr int KQ1 = K1 / 4, KQ2 = K2 / 4;
    const int fr = lane & 15, fq = lane >> 4, ks = wave & 3;
    for (int tp = blockIdx.x; tp < 256; tp += gridDim.x) {
        const int t = tp * 2 + (wave >> 2), cb = t & 63, rb = t >> 6;
        const bf16_t* ap1 = A1 + (size_t)(rb * 16 + fr) * K1 + ks * KQ1 + fq * 8; const bf16_t* bp1 = Bt1 + (size_t)(cb * 16 + fr) * K1 + ks * KQ1 + fq * 8;
        const bf16_t* ap2 = A2 + (size_t)(rb * 16 + fr) * K2 + ks * KQ2 + fq * 8; const bf16_t* bp2 = Bt2 + (size_t)(cb * 16 + fr) * K2 + ks * KQ2 + fq * 8;
        f32x4 acc1 = {0.f, 0.f, 0.f, 0.f}, acc2 = {0.f, 0.f, 0.f, 0.f};
#pragma unroll 8
        for (int k = 0; k < KQ2; k += 32) acc2 = mfma16(*(const bf16x8*)(bp2 + k), *(const bf16x8*)(ap2 + k), acc2);
#pragma unroll 8
        for (int k = 0; k < KQ1; k += 32) acc1 = mfma16(*(const bf16x8*)(bp1 + k), *(const bf16x8*)(ap1 + k), acc1);
        LAS f32x4* red = (LAS f32x4*)lds;
        red[wave * 64 + lane] = acc1; red[512 + wave * 64 + lane] = acc2;
        __syncthreads();
        if (ks == 0) { acc1 = (red[wave * 64 + lane] + red[(wave + 1) * 64 + lane]) + (red[(wave + 2) * 64 + lane] + red[(wave + 3) * 64 + lane]);
            acc2 = (red[512 + wave * 64 + lane] + red[512 + (wave + 1) * 64 + lane]) + (red[512 + (wave + 2) * 64 + lane] + red[512 + (wave + 3) * 64 + lane]);
            f(MPR + rb * 16 + fr, cb * 16 + fq * 4, acc1, acc2, fq, cb); }
        __syncthreads();
    }
}
struct SMerge2 { bf16_t* mg; const bf16_t* gb;
    __device__ __forceinline__ void operator()(int row, int col, f32x4 v1, f32x4 v2, int, int) const { st4bf(mg + (size_t)row * DM + col, ld4bf(gb + (size_t)row * 2048 + col) * v1 + ld4bf(gb + (size_t)row * 2048 + 1024 + col) * v2); } };
struct SRes2Eraw { bf16_t* hb; bf16_t* er; float* ss;
    __device__ __forceinline__ void operator()(int row, int col, f32x4 v1, f32x4 v2, int fq, int cb) const {
        bf16_t* hp = hb + (size_t)row * DM + col; st4bf(hp, ld4bf(hp) + v1); st4bf(er + (size_t)row * DM + col, v2); ss_part(ss, row, cb, fq, sum4(v2 * v2)); } };
struct SMergeA { bf16_t* mg; const bf16_t* gb;
    __device__ __forceinline__ void operator()(int row, int col, f32x4 v, int, int) const { st4bf(mg + (size_t)row * DM + col, ld4bf(gb + (size_t)row * 2048 + col) * v); } };
struct SMergeB { bf16_t* mg; const bf16_t* gb;
    __device__ __forceinline__ void operator()(int row, int col, f32x4 v, int, int) const { bf16_t* p = mg + (size_t)row * DM + col; st4bf(p, ld4bf(p) + ld4bf(gb + (size_t)row * 2048 + 1024 + col) * v); } };
struct SRes1 { const float *xs; bf16_t* hb; float* ss;
    __device__ __forceinline__ void operator()(int row, int col, f32x4 v, int fq, int cb) const {
        v += *(const f32x4*)(xs + (size_t)(row - MPR) * DM + col); st4bf(hb + (size_t)row * DM + col, v); ss_part(ss, row, cb, fq, sum4(v * v)); } };
struct SRes2 { bf16_t* hb;
    __device__ __forceinline__ void operator()(int row, int col, f32x4 v, int, int) const { bf16_t* hp = hb + (size_t)row * DM + col; st4bf(hp, ld4bf(hp) + v); } };
struct SEraw { bf16_t* er; float* ss;
    __device__ __forceinline__ void operator()(int row, int col, f32x4 v, int fq, int cb) const { st4bf(er + (size_t)row * DM + col, v); ss_part(ss, row, cb, fq, sum4(v * v)); } };
struct SPle { bf16_t* ob; const bf16_t* hb; const bf16_t* er; const float *sse, *pn; float* sso;
    __device__ __forceinline__ void operator()(int row, int col, f32x4 v, int fq, int cb) const {
        const float rs = row_rs(sse, row);
        v = ld4bf(hb + (size_t)row * DM + col) + sigm4(v) * (ld4bf(er + (size_t)row * DM + col) * rs * *(const f32x4*)(pn + col)); st4bf(ob + (size_t)row * DM + col, v); ss_part(sso, row, cb, fq, sum4(v * v)); } };

#define XB_TMO      128
#define XB_XCNT(j)  (256  + 64 * (j))
#define XB_XSUB(j)  (1280 + 64 * (j))
#define XB_XGEN(j)  (2304 + 64 * (j))
#define XB_TOP      3328
#define XB_TOPGEN   3392
#define XCD_BAR_WORDS 3456
#define XB_SPIN_CAP (1u << 18)

__device__ __forceinline__ unsigned xb_ld(unsigned* p)              { return __hip_atomic_load(p, __ATOMIC_RELAXED, __HIP_MEMORY_SCOPE_AGENT); }
__device__ __forceinline__ unsigned xb_add(unsigned* p, unsigned v) { return __hip_atomic_fetch_add(p, v, __ATOMIC_RELAXED, __HIP_MEMORY_SCOPE_AGENT); }
__device__ __forceinline__ unsigned xb_xcc_id() { return (unsigned)__builtin_amdgcn_s_getreg((3 << 11) | 20) & 0xFu; }
#define XB_SPIN(cond, bar) do { unsigned _sp = 0; while (cond) { __builtin_amdgcn_s_sleep(1); \
    if ((++_sp & 255u) == 0u) { if (xb_ld(&(bar)[XB_TMO])) break; if (_sp > XB_SPIN_CAP) { atomicAdd(&(bar)[XB_TMO], 1u); break; } } } } while (0)

__device__ __forceinline__ bool is_thread0(int wave_s) { int l = (int)__builtin_amdgcn_mbcnt_hi(~0u, __builtin_amdgcn_mbcnt_lo(~0u, 0u)); asm volatile("" : "+v"(l)); return wave_s == 0 && l == 0; }
struct XcdBarrier {
    unsigned* bar; unsigned x;
    volatile LAS unsigned* st;
};

__device__ __forceinline__ XcdBarrier xcd_barrier_post(unsigned* bar, volatile LAS unsigned* st) {
    XcdBarrier b; b.bar = bar; b.x = xb_xcc_id(); b.st = st;
    if (threadIdx.x == 0) (void)xb_add(&bar[XB_XCNT(b.x)], 1u);
    return b;
}
__device__ __forceinline__ void xcd_barrier_complete(unsigned* bar, unsigned x, unsigned& nloc, unsigned& nx) {
    const unsigned G = gridDim.x * gridDim.y * gridDim.z;
    unsigned sum, cnt, mine, sp = 0u;
    for (;;) {
        sum = 0u; cnt = 0u; mine = 0u;
#pragma unroll
        for (unsigned j = 0; j < 16; ++j) { const unsigned c = xb_ld(&bar[XB_XCNT(j)]); sum += c; cnt += (c > 0u) ? 1u : 0u; mine = (j == x) ? c : mine; }
        if (sum == G) break;
        __builtin_amdgcn_s_sleep(1);
        if ((++sp & 255u) == 0u) { if (xb_ld(&bar[XB_TMO])) break; if (sp > XB_SPIN_CAP) { atomicAdd(&bar[XB_TMO], 1u); break; } }
    }
    nloc = mine > 0u ? mine : 1u; nx = cnt > 0u ? cnt : 1u;
}

__device__ __forceinline__ void xcd_barrier(const XcdBarrier& b, const int wave_s) {
    asm volatile("s_waitcnt vmcnt(0)" ::: "memory");
    __syncthreads();
    if (is_thread0(wave_s)) {
        unsigned* bar = b.bar;
        __builtin_amdgcn_s_waitcnt(0);
        unsigned nloc = b.st[0], nx = b.st[1];
        if (nloc == 0u) { xcd_barrier_complete(bar, b.x, nloc, nx); b.st[0] = nloc; b.st[1] = nx; }
        const unsigned old = xb_add(&bar[XB_XSUB(b.x)], 1u);
        const unsigned gen = old / nloc;
        if (old + 1u == (gen + 1u) * nloc) {
            __builtin_amdgcn_fence(__ATOMIC_RELEASE, "agent");
            asm volatile("s_waitcnt vmcnt(0)" ::: "memory");
            const unsigned og = xb_add(&bar[XB_TOP], 1u);
            const unsigned tg = og / nx;
            if (og + 1u == (tg + 1u) * nx) xb_add(&bar[XB_TOPGEN], 1u);
            else XB_SPIN(xb_ld(&bar[XB_TOPGEN]) == tg, bar);
            __builtin_amdgcn_fence(__ATOMIC_ACQUIRE, "agent");
            xb_add(&bar[XB_XGEN(b.x)], 1u);
            asm volatile("s_waitcnt vmcnt(0)" ::: "memory");
        } else {
            XB_SPIN(xb_ld(&bar[XB_XGEN(b.x)]) == gen, bar);
            __builtin_amdgcn_fence(__ATOMIC_ACQUIRE, "agent");
            asm volatile("s_waitcnt vmcnt(0)" ::: "memory");
        }
    }
    __syncthreads();
}

constexpr size_t WS_BAR = 5 * MiB; constexpr int BAR_BYTES = 16384;
__global__ void __launch_bounds__(512, 2) fwd_kernel(Args a) {
    extern __shared__ __attribute__((aligned(16))) unsigned char lds_raw[];
    LAS unsigned char* lds = (LAS unsigned char*)lds_raw;
    const int wave = __builtin_amdgcn_readfirstlane((int)threadIdx.x >> 6);
    if (threadIdx.x < 64) ((volatile LAS unsigned*)(lds + 131072))[threadIdx.x] = 0u;
    __syncthreads();
    XcdBarrier xbar; xbar.bar = (unsigned*)(karg_ws() + WS_BAR); xbar.x = 0; xbar.st = nullptr;
    if (a.ph_hi - a.ph_lo > 1) xbar = xcd_barrier_post((unsigned*)(karg_ws() + WS_BAR), (volatile LAS unsigned*)(lds + 131072) + 8);
#define TID_LANE() int lane = (int)__builtin_amdgcn_mbcnt_hi(~0u, __builtin_amdgcn_mbcnt_lo(~0u, 0u)); asm volatile("" : "+v"(lane)); const int tid = wave * 64 + lane; (void)tid
    const int lo = a.ph_lo, hi = a.ph_hi;
#define IN(k) (lo <= (k) && (k) < hi)
#define SEAM(k) do { if (IN(k) && IN((k) + 1)) { xcd_barrier(xbar, wave); } } while (0)
    const int G = gridDim.x, c = blockIdx.x;

    if (a.ph_hi > NPHASE) cg::this_grid().sync();
    if (IN(0)) { TID_LANE(); p0_prologue<0>(lds, tid, wave, lane, (int)blockIdx.x, (int)gridDim.x); }
    SEAM(0);
    if (IN(1)) {
        unsigned char* ws = karg_ws();
        bf16_t* RA = (bf16_t*)(ws + WS_RA); bf16_t* GB = (bf16_t*)(ws + WS_RG); bf16_t* ER = (bf16_t*)(ws + WS_RG);
        bf16_t* UB = (bf16_t*)(ws + WS_UB); bf16_t* QB = (bf16_t*)(ws + WS_QB); bf16_t* KB = (bf16_t*)(ws + WS_KB); bf16_t* VB = (bf16_t*)(ws + WS_VB);
        bf16_t* MB = (bf16_t*)(ws + WS_MB); bf16_t* MG = (bf16_t*)(ws + WS_MG); bf16_t* ACT = (bf16_t*)(ws + WS_ACT);
        float* SS2 = (float*)(ws + WS_SS2); float* SSE = (float*)(ws + WS_SSE); float* SSO = (float*)(ws + WS_SSO);
        (void)RA; (void)GB; (void)ER; (void)UB; (void)QB; (void)KB; (void)VB; (void)MB; (void)MG; (void)ACT; (void)SS2; (void)SSE; (void)SSO;
        Gemm g{RA, (const bf16_t*)(ws + WS_WIN), MPAD, INC, 1024}; StaticOrder S; S.init(MPAD, INC, G, c);
        EpiIn E{UB, QB, KB, VB, GB, karg_out(), (const float*)(ws + WS_ROPE)};
        gemm_phase<EpiIn, StaticOrder, true, true, 1024>(lds, g, S, E, wave);
        { const int nwg = (MPAD / 256) * (INC / 256), extra = nwg % G;
          TID_LANE(); if (extra == 0) p0_prologue<1>(lds, tid, wave, lane, c, G); else if (c >= extra) p0_prologue<1>(lds, tid, wave, lane, c - extra, G - extra); }
    }
    SEAM(1);
    if (IN(2)) {
        TID_LANE();
        unsigned char* ws = karg_ws();
        bf16_t* RA = (bf16_t*)(ws + WS_RA); bf16_t* GB = (bf16_t*)(ws + WS_RG); bf16_t* ER = (bf16_t*)(ws + WS_RG);
        bf16_t* UB = (bf16_t*)(ws + WS_UB); bf16_t* QB = (bf16_t*)(ws + WS_QB); bf16_t* KB = (bf16_t*)(ws + WS_KB); bf16_t* VB = (bf16_t*)(ws + WS_VB);
        bf16_t* MB = (bf16_t*)(ws + WS_MB); bf16_t* MG = (bf16_t*)(ws + WS_MG); bf16_t* ACT = (bf16_t*)(ws + WS_ACT);
        float* SS2 = (float*)(ws + WS_SS2); float* SSE = (float*)(ws + WS_SSE); float* SSO = (float*)(ws + WS_SSO);
        (void)RA; (void)GB; (void)ER; (void)UB; (void)QB; (void)KB; (void)VB; (void)MB; (void)MG; (void)ACT; (void)SS2; (void)SSE; (void)SSO;
        { const float* const sinks_ = karg_in(11); const float* const ck_ = karg_in(4); const float* const cv_ = karg_in(5); float* const out_ = karg_out();
        attn_prompt_all(lds, QB, KB, VB, RA, sinks_, tid, wave, lane);
        for (int unit = c; unit < 512; unit += G) attn_sample_unit(lds, unit, QB, KB, VB, RA, ck_, cv_, sinks_, out_, tid, wave, lane); }
        pool_items(ws, karg_in(6), tid);
        __syncthreads();
    }
    SEAM(2);
    if (IN(3)) {
        unsigned char* ws = karg_ws();
        bf16_t* RA = (bf16_t*)(ws + WS_RA); bf16_t* GB = (bf16_t*)(ws + WS_RG); bf16_t* ER = (bf16_t*)(ws + WS_RG);
        bf16_t* UB = (bf16_t*)(ws + WS_UB); bf16_t* QB = (bf16_t*)(ws + WS_QB); bf16_t* KB = (bf16_t*)(ws + WS_KB); bf16_t* VB = (bf16_t*)(ws + WS_VB);
        bf16_t* MB = (bf16_t*)(ws + WS_MB); bf16_t* MG = (bf16_t*)(ws + WS_MG); bf16_t* ACT = (bf16_t*)(ws + WS_ACT);
        float* SS2 = (float*)(ws + WS_SS2); float* SSE = (float*)(ws + WS_SSE); float* SSO = (float*)(ws + WS_SSO);
        (void)RA; (void)GB; (void)ER; (void)UB; (void)QB; (void)KB; (void)VB; (void)MB; (void)MG; (void)ACT; (void)SS2; (void)SSE; (void)SSO;
        TID_LANE();
        { const bf16_t* mbs = MB + (size_t)MPR * 512; const bf16_t* ras = RA + (size_t)MPR * DM;
          SMerge2 Em{MG, GB}; skinny_gemm2<512, 1024>(lds, mbs, (const bf16_t*)(ws + WS_WEFF), ras, (const bf16_t*)(ws + WS_WAB), wave, lane, Em); }
        StaticOrder S; S.init(MPR, 1024, G, c);
        { Gemm g{MB, (const bf16_t*)(ws + WS_WEFF), MPR, 1024, 512}; EpiMergeA E{MG, GB}; gemm_phase<EpiMergeA, StaticOrder, true, true, 512>(lds, g, S, E, wave); }
        { Gemm g{RA, (const bf16_t*)(ws + WS_WAB), MPR, 1024, 1024}; EpiMergeB E{MG, GB}; gemm_phase<EpiMergeB, StaticOrder, true, true, 1024>(lds, g, S, E, wave); }
    }
    SEAM(3);
    if (IN(4)) {
        unsigned char* ws = karg_ws();
        bf16_t* RA = (bf16_t*)(ws + WS_RA); bf16_t* GB = (bf16_t*)(ws + WS_RG); bf16_t* ER = (bf16_t*)(ws + WS_RG);
        bf16_t* UB = (bf16_t*)(ws + WS_UB); bf16_t* QB = (bf16_t*)(ws + WS_QB); bf16_t* KB = (bf16_t*)(ws + WS_KB); bf16_t* VB = (bf16_t*)(ws + WS_VB);
        bf16_t* MB = (bf16_t*)(ws + WS_MB); bf16_t* MG = (bf16_t*)(ws + WS_MG); bf16_t* ACT = (bf16_t*)(ws + WS_ACT);
        float* SS2 = (float*)(ws + WS_SS2); float* SSE = (float*)(ws + WS_SSE); float* SSO = (float*)(ws + WS_SSO);
        (void)RA; (void)GB; (void)ER; (void)UB; (void)QB; (void)KB; (void)VB; (void)MB; (void)MG; (void)ACT; (void)SS2; (void)SSE; (void)SSO;
        TID_LANE();
        { SRes1 Es{karg_in(1), RA, SS2}; skinny_gemm<1024>(lds, MG + (size_t)MPR * DM, (const bf16_t*)(ws + WS_WOUT), wave, lane, Es); }
        Gemm g{MG, (const bf16_t*)(ws + WS_WOUT), MPR, 1024, 1024}; StaticOrder S; S.init(MPR, 1024, G, c);
        EpiRes1 E{karg_in(0), RA, SS2};
        gemm_phase<EpiRes1, StaticOrder, true, true, 1024>(lds, g, S, E, wave);
    }
    SEAM(4);
    if (IN(5)) {
        unsigned char* ws = karg_ws();
        bf16_t* RA = (bf16_t*)(ws + WS_RA); bf16_t* GB = (bf16_t*)(ws + WS_RG); bf16_t* ER = (bf16_t*)(ws + WS_RG);
        bf16_t* UB = (bf16_t*)(ws + WS_UB); bf16_t* QB = (bf16_t*)(ws + WS_QB); bf16_t* KB = (bf16_t*)(ws + WS_KB); bf16_t* VB = (bf16_t*)(ws + WS_VB);
        bf16_t* MB = (bf16_t*)(ws + WS_MB); bf16_t* MG = (bf16_t*)(ws + WS_MG); bf16_t* ACT = (bf16_t*)(ws + WS_ACT);
        float* SS2 = (float*)(ws + WS_SS2); float* SSE = (float*)(ws + WS_SSE); float* SSO = (float*)(ws + WS_SSO);
        (void)RA; (void)GB; (void)ER; (void)UB; (void)QB; (void)KB; (void)VB; (void)MB; (void)MG; (void)ACT; (void)SS2; (void)SSE; (void)SSO;
        Gemm g{RA, (const bf16_t*)(ws + WS_WFI), MPAD, 2 * FFH, 1024}; StaticOrder S; S.init(MPAD, 2 * FFH, G, c);
        EpiSwiglu E{ACT, SS2};
        gemm_phase<EpiSwiglu, StaticOrder, true, true, 1024>(lds, g, S, E, wave);
        { const int nwg5 = (MPAD / 256) * (2 * FFH / 256), extra5 = nwg5 % G;
          TailOrder T; T.init(MPR, 1024, G, c, extra5); Gemm gp{(const bf16_t*)(ws + WS_PB), (const bf16_t*)(ws + WS_WPP), MPR, 1024, PLE}; EpiEraw Ee{ER, SSE};
          gemm_phase<EpiEraw, TailOrder, true, true, PLE>(lds, gp, T, Ee, wave); }
    }
    SEAM(5);
    if (IN(6)) {
        unsigned char* ws = karg_ws();
        bf16_t* RA = (bf16_t*)(ws + WS_RA); bf16_t* GB = (bf16_t*)(ws + WS_RG); bf16_t* ER = (bf16_t*)(ws + WS_RG);
        bf16_t* UB = (bf16_t*)(ws + WS_UB); bf16_t* QB = (bf16_t*)(ws + WS_QB); bf16_t* KB = (bf16_t*)(ws + WS_KB); bf16_t* VB = (bf16_t*)(ws + WS_VB);
        bf16_t* MB = (bf16_t*)(ws + WS_MB); bf16_t* MG = (bf16_t*)(ws + WS_MG); bf16_t* ACT = (bf16_t*)(ws + WS_ACT);
        float* SS2 = (float*)(ws + WS_SS2); float* SSE = (float*)(ws + WS_SSE); float* SSO = (float*)(ws + WS_SSO);
        (void)RA; (void)GB; (void)ER; (void)UB; (void)QB; (void)KB; (void)VB; (void)MB; (void)MG; (void)ACT; (void)SS2; (void)SSE; (void)SSO;
        TID_LANE();
        { SRes2Eraw Es{RA, ER, SSE}; skinny_gemm2<FFH, PLE>(lds, ACT + (size_t)MPR * FFH, (const bf16_t*)(ws + WS_WFO), (const bf16_t*)(ws + WS_PB) + (size_t)MPR * PLE, (const bf16_t*)(ws + WS_WPP), wave, lane, Es); }
        StaticOrder S; S.init(MPR, 1024, G, c);
        { Gemm g{ACT, (const bf16_t*)(ws + WS_WFO), MPR, 1024, FFH}; EpiRes2 E{RA}; gemm_phase<EpiRes2, StaticOrder, true, true, FFH>(lds, g, S, E, wave); }
    }
    SEAM(6);
    if (IN(7)) {
        unsigned char* ws = karg_ws();
        bf16_t* RA = (bf16_t*)(ws + WS_RA); bf16_t* GB = (bf16_t*)(ws + WS_RG); bf16_t* ER = (bf16_t*)(ws + WS_RG);
        bf16_t* UB = (bf16_t*)(ws + WS_UB); bf16_t* QB = (bf16_t*)(ws + WS_QB); bf16_t* KB = (bf16_t*)(ws + WS_KB); bf16_t* VB = (bf16_t*)(ws + WS_VB);
        bf16_t* MB = (bf16_t*)(ws + WS_MB); bf16_t* MG = (bf16_t*)(ws + WS_MG); bf16_t* ACT = (bf16_t*)(ws + WS_ACT);
        float* SS2 = (float*)(ws + WS_SS2); float* SSE = (float*)(ws + WS_SSE); float* SSO = (float*)(ws + WS_SSO);
        (void)RA; (void)GB; (void)ER; (void)UB; (void)QB; (void)KB; (void)VB; (void)MB; (void)MG; (void)ACT; (void)SS2; (void)SSE; (void)SSO;
        TID_LANE();
        { SPle Es{ACT, RA, ER, SSE, karg_in(19), SSO}; skinny_gemm<1024>(lds, RA + (size_t)MPR * DM, (const bf16_t*)(ws + WS_WPG), wave, lane, Es); }
        Gemm g{RA, (const bf16_t*)(ws + WS_WPG), MPR, 1024, 1024}; StaticOrder S; S.init(MPR, 1024, G, c);
        EpiPle E{ACT, RA, ER, SSE, karg_in(19), SSO};
        gemm_phase<EpiPle, StaticOrder, true, true, 1024>(lds, g, S, E, wave);
    }
    SEAM(7);
    if (IN(8)) {
        TID_LANE();
        unsigned char* ws = karg_ws();
        bf16_t* RA = (bf16_t*)(ws + WS_RA); bf16_t* GB = (bf16_t*)(ws + WS_RG); bf16_t* ER = (bf16_t*)(ws + WS_RG);
        bf16_t* UB = (bf16_t*)(ws + WS_UB); bf16_t* QB = (bf16_t*)(ws + WS_QB); bf16_t* KB = (bf16_t*)(ws + WS_KB); bf16_t* VB = (bf16_t*)(ws + WS_VB);
        bf16_t* MB = (bf16_t*)(ws + WS_MB); bf16_t* MG = (bf16_t*)(ws + WS_MG); bf16_t* ACT = (bf16_t*)(ws + WS_ACT);
        float* SS2 = (float*)(ws + WS_SS2); float* SSE = (float*)(ws + WS_SSE); float* SSO = (float*)(ws + WS_SSO);
        (void)RA; (void)GB; (void)ER; (void)UB; (void)QB; (void)KB; (void)VB; (void)MB; (void)MG; (void)ACT; (void)SS2; (void)SSE; (void)SSO;
        const float* fn = karg_in(21); float* const out_ = karg_out();
        f32x4 f0[2], f1[2];
#pragma unroll
        for (int hh = 0; hh < 2; ++hh) { f0[hh] = *(const f32x4*)(fn + hh * 512 + lane * 8); f1[hh] = *(const f32x4*)(fn + hh * 512 + lane * 8 + 4); }
        for (int m = (c * 8 + wave) * 2; m < MREAL; m += G * 16) {
            u32x4 w[2][2];
#pragma unroll
            for (int r = 0; r < 2; ++r)
#pragma unroll
                for (int hh = 0; hh < 2; ++hh) w[r][hh] = *(const u32x4*)(ACT + (size_t)(m + r) * DM + hh * 512 + lane * 8);
#pragma unroll
            for (int r = 0; r < 2; ++r) { const float rs = row_rs(SSO, m + r);
#pragma unroll
                for (int hh = 0; hh < 2; ++hh) { f32x4 v0, v1; unpack8(w[r][hh], v0, v1); float* yp = out_ + (size_t)(m + r) * DM + hh * 512 + lane * 8;
                    __builtin_nontemporal_store(v0 * rs * f0[hh], (f32x4*)yp); __builtin_nontemporal_store(v1 * rs * f1[hh], (f32x4*)(yp + 4)); } }
        }
    }
#undef IN
#undef SEAM
}

extern "C" void kernel_launch(void* const* d_in, const int* in_sizes, int n_in, void* d_out, int out_size, void* d_ws, size_t ws_size, hipStream_t stream) {
    static int grid = 0;
    if (grid == 0) {
        if (n_in != 22 || out_size != (int)O_END || ws_size < WS_END) { fprintf(stderr, "kernel_launch: unexpected sizes: n_in %d out %d ws %zu (need %zu)\n", n_in, out_size, ws_size, (size_t)WS_END); grid = -1; return; }
        int dev = 0, cus = 0, per_cu = 0;
        hipGetDevice(&dev); hipDeviceGetAttribute(&cus, hipDeviceAttributeMultiprocessorCount, dev);
        if (hipFuncSetAttribute((const void*)fwd_kernel, hipFuncAttributeMaxDynamicSharedMemorySize, LDS_BYTES) != hipSuccess) { fprintf(stderr, "kernel_launch: hipFuncSetAttribute failed\n"); grid = -1; return; }
        if (hipOccupancyMaxActiveBlocksPerMultiprocessor(&per_cu, (const void*)fwd_kernel, 512, LDS_BYTES) != hipSuccess || per_cu < 1) { fprintf(stderr, "kernel_launch: occupancy query failed (%d)\n", per_cu); grid = -1; return; }
        grid = cus * per_cu;
        fprintf(stderr, "kernel_launch: cus %d per_cu %d grid %d\n", cus, per_cu, grid);
    }
    if (grid < 0) return;
    Args a{};
    for (int i = 0; i < 22; ++i) a.in[i] = (const float*)d_in[i];
    a.out = (float*)d_out; a.ws = (unsigned char*)d_ws;
#if N_LAUNCH == 1
    if (hipMemsetAsync((char*)d_ws + WS_BAR, 0, BAR_BYTES, stream) != hipSuccess) { fprintf(stderr, "kernel_launch: memset failed\n"); return; }
    a.ph_lo = 0; a.ph_hi = NPHASE;
    void* args[] = {&a};
    hipError_t e = hipLaunchCooperativeKernel((const void*)fwd_kernel, dim3(grid), dim3(512), args, LDS_BYTES, stream);
    if (e != hipSuccess) fprintf(stderr, "cooperative launch failed: %s (grid %d)\n", hipGetErrorString(e), grid);
#else
    for (int p = 0; p < NPHASE; ++p) { a.ph_lo = p; a.ph_hi = p + 1; hipLaunchKernelGGL(fwd_kernel, dim3(grid), dim3(512), LDS_BYTES, stream, a); }
#endif
}
```

```cpp
#include <hip/hip_runtime.h>
#include <hip/hip_cooperative_groups.h>
#include <cstdio>
#include <cstdint>
namespace cg = cooperative_groups;
namespace pg8 {
#define PG8_LAS __attribute__((address_space(3)))
typedef unsigned short bf16_t;
typedef short bf16x8 __attribute__((ext_vector_type(8)));
typedef float f32x4 __attribute__((ext_vector_type(4)));
typedef unsigned u32x4 __attribute__((ext_vector_type(4)));
constexpr int BM = 256, BK = 64, HALF = 128, HTB = HALF * BK * 2  , STAGE_BYTES = 8 * HTB, NXCD = 8, WGM = 8;

__host__ __device__ __forceinline__ int lds_byte(int r, int c) { const int st = (r >> 4) * 2 + (c >> 5), rr = r & 15, cc = c & 31, ob = rr * 64 + cc * 2; return st * 1024 + (ob ^ (((ob >> 9) & 1) << 5)); }
__host__ __device__ __forceinline__ void stage_rc(int b, int& R, int& C) { const int st = b / 1024, sb = b % 1024, swz = sb ^ (((sb >> 9) & 1) << 5); R = (st >> 1) * 16 + swz / 64; C = (st & 1) * 32 + (swz % 64) / 2; }
__host__ __device__ __forceinline__ int perm32(int rho) { const int n = rho >> 4, i = rho & 15; return 8 * (i >> 2) + 4 * n + (i & 3); }

struct Unit { int pm, pn; };
struct Gemm { const bf16_t* A; const bf16_t* Bt; int M, N, K; };

struct StaticOrder {
    int nM, nN, nwg, G, c;
    __host__ __device__ void init(int M, int N, int G_, int c_) { nM = M / BM; nN = N / BM; nwg = nM * nN; G = G_; c = c_; }
    __host__ __device__ bool next(int i, Unit& u) const {
        const long L = (long)i * G + c; if (L >= nwg) return false;
        int wgid = (int)L; { const int q = nwg / NXCD, r = nwg % NXCD, xcd = wgid % NXCD, off = wgid / NXCD; wgid = (xcd < r ? xcd * (q + 1) : r * (q + 1) + (xcd - r) * q) + off; }
        const int nig = WGM * nN, gid = wgid / nig, fm = gid * WGM, gsz = (nM - fm) < WGM ? (nM - fm) : WGM;
        u.pm = fm + ((wgid % nig) % gsz); u.pn = (wgid % nig) / gsz; return true;
    }
    __device__ __forceinline__ void a_ready(const Unit&) const {}
    __device__ __forceinline__ void done(const Unit&) const {}
};

struct TailOrder {
    int nwg, first, cnt, c;
    __host__ __device__ void init(int M, int N, int G_, int c_, int first_) { nwg = (M / BM) * (N / BM); first = first_ < G_ ? first_ : 0; cnt = G_ - first; c = c_; }
    __host__ __device__ bool next(int i, Unit& u) const {
        if (c < first) return false; const int t = (c - first) + i * cnt; if (t >= nwg) return false;
        u.pm = t >> 2; u.pn = t & 3; return true;
    }
    __device__ __forceinline__ void a_ready(const Unit&) const {}
    __device__ __forceinline__ void done(const Unit&) const {}
};

__device__ __forceinline__ unsigned cvt_pk_bf16(float lo, float hi) { unsigned r; asm volatile("s_nop 0\n\tv_cvt_pk_bf16_f32 %0, %1, %2" : "=v"(r) : "v"(lo), "v"(hi)); return r; }
typedef float f32x2_cv __attribute__((ext_vector_type(2))); typedef __bf16 bf16x2_cv __attribute__((ext_vector_type(2)));
__device__ __forceinline__ unsigned cvt_pk_bf16_v(float lo, float hi) { const f32x2_cv v = {lo, hi}; const bf16x2_cv b = __builtin_convertvector(v, bf16x2_cv); return __builtin_bit_cast(unsigned, b); }
typedef float f32x2 __attribute__((ext_vector_type(2)));

constexpr int DM = 1024, SEQ = 8192, MPR = 16384, MSM = 128, MREAL = MPR + MSM, MPAD = 16640;
constexpr int INC = 4096, FFH = 2816, PLE = 256;
constexpr float EPS = 1e-6f;
constexpr size_t O_Y = 0, O_NKP = (size_t)MREAL * DM, O_NVP = O_NKP + 65536, O_NPP = O_NVP + 65536, O_NKS = O_NPP + 15360, O_NVS = O_NKS + 4194304, O_NPS = O_NVS + 4194304, O_END = O_NPS + 983040;

typedef unsigned u32x2 __attribute__((ext_vector_type(2)));
__device__ __forceinline__ float bflo(unsigned w) { return __builtin_bit_cast(float, w << 16); }
__device__ __forceinline__ float bfhi(unsigned w) { return __builtin_bit_cast(float, w & 0xffff0000u); }
__device__ __forceinline__ u32x4 pack8(const f32x4 a, const f32x4 b) { u32x4 w; w.x = cvt_pk_bf16(a[0], a[1]); w.y = cvt_pk_bf16(a[2], a[3]); w.z = cvt_pk_bf16(b[0], b[1]); w.w = cvt_pk_bf16(b[2], b[3]); return w; }
__device__ __forceinline__ u32x4 pack8v(const f32x4 a, const f32x4 b) { u32x4 w; w.x = cvt_pk_bf16_v(a[0], a[1]); w.y = cvt_pk_bf16_v(a[2], a[3]); w.z = cvt_pk_bf16_v(b[0], b[1]); w.w = cvt_pk_bf16_v(b[2], b[3]); return w; }
__device__ __forceinline__ void unpack8(const u32x4 w, f32x4& a, f32x4& b) { a = (f32x4){bflo(w.x), bfhi(w.x), bflo(w.y), bfhi(w.y)}; b = (f32x4){bflo(w.z), bfhi(w.z), bflo(w.w), bfhi(w.w)}; }
__device__ __forceinline__ float sigm(float x) { return __builtin_amdgcn_rcpf(1.0f + __expf(-x)); }
__device__ __forceinline__ f32x4 sigm4(const f32x4 x) { return (f32x4){sigm(x[0]), sigm(x[1]), sigm(x[2]), sigm(x[3])}; }
__device__ __forceinline__ float sum4(const f32x4 x) { return (x[0] + x[1]) + (x[2] + x[3]); }
__device__ __forceinline__ float row_rs(const float* ss, int row) {
    if (row < MPR) { const f32x4* p = (const f32x4*)(ss + (size_t)row * 16); const f32x4 a = p[0], b = p[1], c = p[2], d = p[3];
        return rsqrtf(((sum4(a) + sum4(b)) + (sum4(c) + sum4(d))) * (1.0f / DM) + EPS); }
    const f32x4* p = (const f32x4*)(ss + (size_t)MPR * 16 + (size_t)(row - MPR) * 64); f32x4 t = p[0];
#pragma unroll
    for (int i = 1; i < 16; ++i) t += p[i];
    return rsqrtf(sum4(t) * (1.0f / DM) + EPS);
}
#define EPI_ROW(ai, m) (u.pm * BM + (ai) * HALF + wr * 64 + (m) * 16 + fr)
#define EPI_LOOP_AM _Pragma("unroll") for (int ai = 0; ai < 2; ++ai) _Pragma("unroll") for (int m = 0; m < 4; ++m)
#define EPI_LOOP_BJ _Pragma("unroll") for (int bj = 0; bj < 2; ++bj)

struct EpiIn {
    static constexpr bool PERM = true, AFTER_DRAIN = false;
    bf16_t *ub, *qb, *kb, *vb, *gb; float* out; const float* rope;
    __device__ __forceinline__ void operator()(const f32x4 (&acc)[2][2][4][2], const Unit& u, int wr, int wc, int fr, int fq) const {
        const int colt = u.pn * BM, cw = wc * 32 + 8 * fq;
        const bool tail = (u.pm == 31) || (u.pm == 63) || (u.pm == 64);
        EPI_LOOP_AM {
            const int row = EPI_ROW(ai, m);
            if (colt >= 2048) {
                EPI_LOOP_BJ { const int col = colt - 2048 + bj * HALF + cw; *(u32x4*)(gb + (size_t)row * 2048 + col) = pack8v(sigm4(acc[ai][bj][m][0]), sigm4(acc[ai][bj][m][1])); }
            } else if (colt < 512) {
                EPI_LOOP_BJ { const int col = colt + bj * HALF + cw; const f32x4 v0 = acc[ai][bj][m][0], v1 = acc[ai][bj][m][1];
                    *(u32x4*)(ub + (size_t)row * 512 + col) = pack8(v0, v1);
                    if (tail) { float* dst = nullptr;
                        if (row >= MPR) { if (row < MREAL) dst = out + O_NPS + ((size_t)(row - MPR) * 15 + 14) * 512 + col; }
                        else { const int t = row & (SEQ - 1); if (t >= SEQ - 15) dst = out + O_NPP + ((size_t)(row >> 13) * 15 + (t - (SEQ - 15))) * 512 + col; }
                        if (dst) { *(f32x4*)dst = v0; *(f32x4*)(dst + 4) = v1; } } }
            } else if (colt < 1792) {
                const bool isq = colt < 1536;
                const int pidx = row < MPR ? (row & (SEQ - 1)) : SEQ;
                EPI_LOOP_BJ { f32x4 v0 = acc[ai][bj][m][0], v1 = acc[ai][bj][m][1];
                    if ((wc & 1) == 0) {
                        f32x4 p0, p1;
#pragma unroll
                        for (int j = 0; j < 4; ++j) { p0[j] = __shfl_xor(v0[j], 16); p1[j] = __shfl_xor(v1[j], 16); }
                        if (fq < 2) { const f32x4* rp = (const f32x4*)(rope + (size_t)pidx * 16); const f32x4 c0 = rp[0], c1 = rp[1]; f32x4 s0 = rp[2], s1 = rp[3];
                            if (fq == 0) { s0 = -s0; s1 = -s1; }
                            v0 = v0 * c0 + p0 * s0; v1 = v1 * c1 + p1 * s1; }
                    }
                    if (isq) { v0 = v0 * 0.125f; v1 = v1 * 0.125f; *(u32x4*)(qb + (size_t)row * 1024 + (colt - 512) + bj * HALF + cw) = pack8(v0, v1); }
                    else { const int col = bj * HALF + cw; *(u32x4*)(kb + (size_t)row * 256 + col) = pack8(v0, v1);
                        if (tail) { float* dst = nullptr;
                            if (row >= MPR) { if (row < MREAL) dst = out + O_NKS + ((size_t)(row - MPR) * 128 + 127) * 256 + col; }
                            else { const int t = row & (SEQ - 1); if (t >= SEQ - 128) dst = out + O_NKP + ((size_t)(row >> 13) * 128 + (t - (SEQ - 128))) * 256 + col; }
                            if (dst) { *(f32x4*)dst = v0; *(f32x4*)(dst + 4) = v1; } } } }
            } else {
                EPI_LOOP_BJ { const int col = bj * HALF + cw; const f32x4 v0 = acc[ai][bj][m][0], v1 = acc[ai][bj][m][1];
                    *(u32x4*)(vb + (size_t)row * 256 + col) = pack8(v0, v1);
                    if (tail) { float* dst = nullptr;
                        if (row >= MPR) { if (row < MREAL) dst = out + O_NVS + ((size_t)(row - MPR) * 128 + 127) * 256 + col; }
                        else { const int t = row & (SEQ - 1); if (t >= SEQ - 128) dst = out + O_NVP + ((size_t)(row >> 13) * 128 + (t - (SEQ - 128))) * 256 + col; }
                        if (dst) { *(f32x4*)dst = v0; *(f32x4*)(dst + 4) = v1; } } }
            }
        }
    }
};
struct EpiMergeA {
    static constexpr bool PERM = true, AFTER_DRAIN = false;
    bf16_t* mg; const bf16_t* gb;
    __device__ __forceinline__ void operator()(const f32x4 (&acc)[2][2][4][2], const Unit& u, int wr, int wc, int fr, int fq) const {
        const int cw = u.pn * BM + wc * 32 + 8 * fq;
        EPI_LOOP_AM { const int row = EPI_ROW(ai, m);
            EPI_LOOP_BJ { const int col = cw + bj * HALF; f32x4 g0, g1; unpack8(*(const u32x4*)(gb + (size_t)row * 2048 + col), g0, g1);
                *(u32x4*)(mg + (size_t)row * DM + col) = pack8(g0 * acc[ai][bj][m][0], g1 * acc[ai][bj][m][1]); } }
    }
};
struct EpiMergeB {
    static constexpr bool PERM = true, AFTER_DRAIN = false;
    bf16_t* mg; const bf16_t* gb;
    __device__ __forceinline__ void operator()(const f32x4 (&acc)[2][2][4][2], const Unit& u, int wr, int wc, int fr, int fq) const {
        const int cw = u.pn * BM + wc * 32 + 8 * fq;
        EPI_LOOP_AM { const int row = EPI_ROW(ai, m);
            EPI_LOOP_BJ { const int col = cw + bj * HALF; f32x4 g0, g1, t0, t1; unpack8(*(const u32x4*)(gb + (size_t)row * 2048 + 1024 + col), g0, g1);
                unpack8(*(const u32x4*)(mg + (size_t)row * DM + col), t0, t1);
                *(u32x4*)(mg + (size_t)row * DM + col) = pack8(t0 + g0 * acc[ai][bj][m][0], t1 + g1 * acc[ai][bj][m][1]); } }
    }
};
struct EpiRes1 {
    static constexpr bool PERM = true, AFTER_DRAIN = false;
    const float *xp; bf16_t* hb; float* ss;
    __device__ __forceinline__ void operator()(const f32x4 (&acc)[2][2][4][2], const Unit& u, int wr, int wc, int fr, int fq) const {
        const int cw = u.pn * BM + wc * 32 + 8 * fq;
        EPI_LOOP_AM { const int row = EPI_ROW(ai, m); const float* xr = xp + (size_t)row * DM; float q = 0.f;
            EPI_LOOP_BJ { const int col = cw + bj * HALF; const f32x4 v0 = acc[ai][bj][m][0] + __builtin_nontemporal_load((const f32x4*)(xr + col)), v1 = acc[ai][bj][m][1] + __builtin_nontemporal_load((const f32x4*)(xr + col + 4));
                q += sum4(v0 * v0) + sum4(v1 * v1);
                *(u32x4*)(hb + (size_t)row * DM + col) = pack8(v0, v1); }
            q += __shfl_xor(q, 16); q += __shfl_xor(q, 32);
            if (fq == 0) ss[(size_t)row * 16 + u.pn * 4 + wc] = q; }
    }
};
struct EpiSwiglu {
    static constexpr bool PERM = true, AFTER_DRAIN = false;
    bf16_t* act; const float* ss;
    __device__ __forceinline__ void operator()(const f32x4 (&acc)[2][2][4][2], const Unit& u, int wr, int wc, int fr, int fq) const {
        const int cw = u.pn * 128 + wc * 16 + 4 * fq;
        EPI_LOOP_AM { const int row = EPI_ROW(ai, m); const float rs = row_rs(ss, row);
            EPI_LOOP_BJ { const f32x4 g = acc[ai][bj][m][0] * rs, up = acc[ai][bj][m][1] * rs; const f32x4 a = g * sigm4(g) * up;
                u32x2 w; w.x = cvt_pk_bf16(a[0], a[1]); w.y = cvt_pk_bf16(a[2], a[3]);
                *(u32x2*)(act + (size_t)row * FFH + cw + bj * 64) = w; } }
    }
};
struct EpiRes2 {
    static constexpr bool PERM = true, AFTER_DRAIN = false;
    bf16_t* hb;
    __device__ __forceinline__ void operator()(const f32x4 (&acc)[2][2][4][2], const Unit& u, int wr, int wc, int fr, int fq) const {
        const int cw = u.pn * BM + wc * 32 + 8 * fq;
        EPI_LOOP_AM { const int row = EPI_ROW(ai, m);
            EPI_LOOP_BJ { bf16_t* hp = hb + (size_t)row * DM + cw + bj * HALF; f32x4 h0, h1; unpack8(*(const u32x4*)hp, h0, h1);
                *(u32x4*)hp = pack8(h0 + acc[ai][bj][m][0], h1 + acc[ai][bj][m][1]); } }
    }
};
struct EpiEraw {
    static constexpr bool PERM = true, AFTER_DRAIN = false;
    bf16_t* er; float* ss;
    __device__ __forceinline__ void operator()(const f32x4 (&acc)[2][2][4][2], const Unit& u, int wr, int wc, int fr, int fq) const {
        const int cw = u.pn * BM + wc * 32 + 8 * fq;
        EPI_LOOP_AM { const int row = EPI_ROW(ai, m); float q = 0.f;
            EPI_LOOP_BJ { const int col = cw + bj * HALF; const f32x4 v0 = acc[ai][bj][m][0], v1 = acc[ai][bj][m][1];
                q += sum4(v0 * v0) + sum4(v1 * v1); *(u32x4*)(er + (size_t)row * DM + col) = pack8(v0, v1); }
            q += __shfl_xor(q, 16); q += __shfl_xor(q, 32);
            if (fq == 0) ss[(size_t)row * 16 + u.pn * 4 + wc] = q; }
    }
};
struct EpiPle {
    static constexpr bool PERM = true, AFTER_DRAIN = false;
    bf16_t* ob; const bf16_t* hb; const bf16_t* er; const float *sse, *pn; float* sso;
    __device__ __forceinline__ void operator()(const f32x4 (&acc)[2][2][4][2], const Unit& u, int wr, int wc, int fr, int fq) const {
        const int cw = u.pn * BM + wc * 32 + 8 * fq;
        EPI_LOOP_AM { const int row = EPI_ROW(ai, m); const float rs = row_rs(sse, row); float q = 0.f;
            EPI_LOOP_BJ { const int col = cw + bj * HALF; f32x4 e0, e1, h0, h1; unpack8(*(const u32x4*)(er + (size_t)row * DM + col), e0, e1); unpack8(*(const u32x4*)(hb + (size_t)row * DM + col), h0, h1);
                const f32x4 n0 = *(const f32x4*)(pn + col), n1 = *(const f32x4*)(pn + col + 4);
                const f32x4 v0 = h0 + sigm4(acc[ai][bj][m][0]) * (e0 * rs * n0), v1 = h1 + sigm4(acc[ai][bj][m][1]) * (e1 * rs * n1);
                *(u32x4*)(ob + (size_t)row * DM + col) = pack8(v0, v1);
                q += sum4(v0 * v0) + sum4(v1 * v1); }
            q += __shfl_xor(q, 16); q += __shfl_xor(q, 32);
            if (fq == 0) sso[(size_t)row * 16 + u.pn * 4 + wc] = q; }
    }
};
template <class Epi, class Sched, bool ALIGN_EPI = false, bool SP2 = false, int KC = 0>
__device__ __forceinline__ void gemm_phase(PG8_LAS unsigned char* lds, const Gemm g, const Sched& S, const Epi& E, const int wave_s) {
    int lane_ = (int)__builtin_amdgcn_mbcnt_hi(~0u, __builtin_amdgcn_mbcnt_lo(~0u, 0u)); asm volatile("" : "+v"(lane_));
    const int wid = wave_s, lane = lane_, tid = wid * 64 + lane, wr = wid >> 2, wc = wid & 3, fr = lane & 15, fq = lane >> 4;
    const int K = KC > 0 ? KC : g.K, nt = K / BK;
    unsigned voffA[2], voffB[2];
#pragma unroll
    for (int i = 0; i < 2; ++i) { int R, C; stage_rc(tid * 16 + i * 8192, R, C); const int Rb = Epi::PERM ? ((R & ~31) + perm32(R & 31)) : R;
        voffA[i] = (unsigned)(R * K + C) * 2u; voffB[i] = (unsigned)(Rb * K + C) * 2u; }
    const size_t kstep = (size_t)(BK * 2);
    const size_t hstep = (size_t)HALF * K * 2;
    const size_t tstep = 2 * hstep;
    const unsigned ldsw = (unsigned)wid * 1024u;
    const int aoff = lds_byte(wr * 64 + fr, fq * 8), boff = lds_byte(wc * 32 + fr, fq * 8);
#define PG8_SA(b, h) (((b) * 2 + (h)) * HTB)
#define PG8_SB(b, h) ((4 + (b) * 2 + (h)) * HTB)
#define PG8_STAGE(bufoff, gbase, voff) do { _Pragma("unroll") for (int _i = 0; _i < 2; ++_i) \
        __builtin_amdgcn_global_load_lds((const unsigned*)((const char*)(gbase) + (voff)[_i]), (PG8_LAS unsigned*)(lds + (bufoff) + ldsw + _i * 8192), 16, 0, 0); } while (0)
#define PG8_LDA(dst, b, h) do { _Pragma("unroll") for (int m = 0; m < 4; ++m) _Pragma("unroll") for (int k = 0; k < 2; ++k) dst[m][k] = *(const PG8_LAS bf16x8*)(lds + PG8_SA(b, h) + aoff + m * 2048 + k * 1024); } while (0)
#define PG8_LDB(dst, b, h) do { _Pragma("unroll") for (int n = 0; n < 2; ++n) _Pragma("unroll") for (int k = 0; k < 2; ++k) dst[n][k] = *(const PG8_LAS bf16x8*)(lds + PG8_SB(b, h) + boff + n * 2048 + k * 1024); } while (0)
#define PG8_MMA(ai, bj, At, Bt) do { __builtin_amdgcn_s_setprio(1); _Pragma("unroll") for (int m = 0; m < 4; ++m) _Pragma("unroll") for (int n = 0; n < 2; ++n) _Pragma("unroll") for (int k = 0; k < 2; ++k) \
        acc[ai][bj][m][n] = __builtin_amdgcn_mfma_f32_16x16x32_bf16(Bt[n][k], At[m][k], acc[ai][bj][m][n], 0, 0, 0); __builtin_amdgcn_s_setprio(0); } while (0)
#define PG8_WAIT_V(n) asm volatile("s_waitcnt vmcnt(" #n ")" ::: "memory")
#define PG8_WAIT_L(n) asm volatile("s_waitcnt lgkmcnt(" #n ")" ::: "memory")
#define PG8_BAR __builtin_amdgcn_s_barrier()
#define PG8_SCHED __builtin_amdgcn_sched_barrier(0)
    Unit cur, nxt; int ui = 0;
    if (!S.next(0, cur)) return;
    f32x4 acc[2][2][4][2];
#pragma unroll
    for (int a = 0; a < 2; ++a)
#pragma unroll
        for (int b = 0; b < 2; ++b)
#pragma unroll
            for (int m = 0; m < 4; ++m)
#pragma unroll
                for (int n = 0; n < 2; ++n) acc[a][b][m][n] = (f32x4){0.f, 0.f, 0.f, 0.f};
    bf16x8 At[4][2], B0[2][2], B1[2][2];
    const char* cA = (const char*)g.A + (size_t)cur.pm * tstep; const char* cB = (const char*)g.Bt + (size_t)cur.pn * tstep;
    S.a_ready(cur);
    if constexpr (SP2) {
        PG8_STAGE(PG8_SB(0, 0), cB, voffB); PG8_STAGE(PG8_SB(0, 1), cB + hstep, voffB); PG8_STAGE(PG8_SA(0, 0), cA, voffA); PG8_STAGE(PG8_SA(0, 1), cA + hstep, voffA);
        if (wr == 1) PG8_BAR;
        PG8_WAIT_V(2); PG8_BAR;
        PG8_STAGE(PG8_SB(1, 0), cB + kstep, voffB); PG8_STAGE(PG8_SA(1, 0), cA + kstep, voffA); PG8_STAGE(PG8_SB(1, 1), cB + hstep + kstep, voffB);
        PG8_WAIT_V(6); PG8_BAR;
    } else {
        PG8_STAGE(PG8_SB(0, 0), cB, voffB); PG8_STAGE(PG8_SA(0, 0), cA, voffA); PG8_STAGE(PG8_SB(0, 1), cB + hstep, voffB); PG8_STAGE(PG8_SA(0, 1), cA + hstep, voffA);
        if (wr == 1) PG8_BAR;
        PG8_WAIT_V(4); PG8_BAR;
        PG8_STAGE(PG8_SB(1, 0), cB + kstep, voffB); PG8_STAGE(PG8_SA(1, 0), cA + kstep, voffA); PG8_STAGE(PG8_SB(1, 1), cB + hstep + kstep, voffB);
        PG8_WAIT_V(6); PG8_BAR;
    }
    for (;;) {
        const bool has_next = S.next(ui + 1, nxt);
        const char* nA = has_next ? (const char*)g.A + (size_t)nxt.pm * tstep : cA; const char* nB = has_next ? (const char*)g.Bt + (size_t)nxt.pn * tstep : cB;
        for (int t = 0; t < nt; t += 2) {
            const bool last = (t == nt - 2);
            const char* a1 = cA + (size_t)(t + 1) * kstep;
            const char* a2 = last ? nA : cA + (size_t)(t + 2) * kstep; const char* b2 = last ? nB : cB + (size_t)(t + 2) * kstep;
            const char* a3 = a2 + kstep; const char* b3 = b2 + kstep;
            if (last && has_next) S.a_ready(nxt);
            if constexpr (SP2) {
            PG8_LDB(B0, 0, 0); PG8_LDB(B1, 0, 1); PG8_SCHED; PG8_LDA(At, 0, 0); PG8_STAGE(PG8_SA(1, 1), a1 + hstep, voffA);
            PG8_WAIT_V(8); PG8_WAIT_L(0); PG8_BAR; PG8_MMA(0, 0, At, B0); PG8_MMA(0, 1, At, B1); PG8_BAR; PG8_SCHED;
            PG8_LDA(At, 0, 1); PG8_STAGE(PG8_SB(0, 0), b2, voffB); PG8_STAGE(PG8_SB(0, 1), b2 + hstep, voffB); PG8_STAGE(PG8_SA(0, 0), a2, voffA);
            PG8_WAIT_V(8); PG8_WAIT_L(0); PG8_BAR; PG8_MMA(1, 0, At, B0); PG8_MMA(1, 1, At, B1); PG8_BAR; PG8_SCHED;
            PG8_LDB(B0, 1, 0); PG8_LDB(B1, 1, 1); PG8_SCHED; PG8_LDA(At, 1, 0); PG8_STAGE(PG8_SA(0, 1), a2 + hstep, voffA);
            PG8_WAIT_V(8); PG8_WAIT_L(0); PG8_BAR; PG8_MMA(0, 0, At, B0); PG8_MMA(0, 1, At, B1); PG8_BAR; PG8_SCHED;
            PG8_LDA(At, 1, 1); PG8_STAGE(PG8_SB(1, 0), b3, voffB); PG8_STAGE(PG8_SB(1, 1), b3 + hstep, voffB); PG8_STAGE(PG8_SA(1, 0), a3, voffA);
            PG8_WAIT_V(8); PG8_WAIT_L(0); PG8_BAR; PG8_MMA(1, 0, At, B0); PG8_MMA(1, 1, At, B1); PG8_BAR; PG8_SCHED;
            } else {
            PG8_LDB(B0, 0, 0); PG8_SCHED; PG8_LDA(At, 0, 0); PG8_STAGE(PG8_SA(1, 1), a1 + hstep, voffA);
            PG8_WAIT_L(8); PG8_BAR; PG8_WAIT_L(0); PG8_MMA(0, 0, At, B0); PG8_BAR; PG8_SCHED;
            PG8_LDB(B1, 0, 1); PG8_STAGE(PG8_SB(0, 0), b2, voffB);
            PG8_BAR; PG8_WAIT_L(0); PG8_MMA(0, 1, At, B1); PG8_BAR;
            PG8_LDA(At, 0, 1); PG8_STAGE(PG8_SA(0, 0), a2, voffA);
            PG8_BAR; PG8_WAIT_L(0); PG8_MMA(1, 0, At, B0); PG8_BAR; PG8_SCHED;
            PG8_STAGE(PG8_SB(0, 1), b2 + hstep, voffB);
            PG8_WAIT_V(6); PG8_BAR; PG8_MMA(1, 1, At, B1); PG8_BAR;
            PG8_LDB(B0, 1, 0); PG8_SCHED; PG8_LDA(At, 1, 0); PG8_STAGE(PG8_SA(0, 1), a2 + hstep, voffA);
            PG8_WAIT_L(8); PG8_BAR; PG8_WAIT_L(0); PG8_MMA(0, 0, At, B0); PG8_BAR; PG8_SCHED;
            PG8_LDB(B1, 1, 1); PG8_STAGE(PG8_SB(1, 0), b3, voffB);
            PG8_BAR; PG8_WAIT_L(0); PG8_MMA(0, 1, At, B1); PG8_BAR;
            PG8_LDA(At, 1, 1); PG8_STAGE(PG8_SA(1, 0), a3, voffA);
            PG8_BAR; PG8_WAIT_L(0); PG8_MMA(1, 0, At, B0); PG8_BAR; PG8_SCHED;
            PG8_STAGE(PG8_SB(1, 1), b3 + hstep, voffB);
            PG8_WAIT_V(6); PG8_BAR; PG8_MMA(1, 1, At, B1); PG8_BAR;
            }
        }
        if constexpr (ALIGN_EPI) { if (wr == 0) PG8_BAR; }
        if constexpr (!Epi::AFTER_DRAIN) { E(acc, cur, wr, wc, fr, fq); S.done(cur); }
        if (!has_next) break;
#pragma unroll
        for (int a = 0; a < 2; ++a)
#pragma unroll
            for (int b = 0; b < 2; ++b)
#pragma unroll
                for (int m = 0; m < 4; ++m)
#pragma unroll
                    for (int n = 0; n < 2; ++n) acc[a][b][m][n] = (f32x4){0.f, 0.f, 0.f, 0.f};
        cur = nxt; cA = nA; cB = nB; ++ui;
        if constexpr (ALIGN_EPI) { if (wr == 1) PG8_BAR; }
    }
    PG8_WAIT_V(0);
    if constexpr (!ALIGN_EPI) { if (wr == 0) PG8_BAR; }
    PG8_BAR;
    if constexpr (Epi::AFTER_DRAIN) { E.fused(acc, cur, wr, wc, fr, fq, lds, wid, lane); S.done(cur); }
#undef PG8_SA
#undef PG8_SB
#undef PG8_STAGE
#undef PG8_LDA
#undef PG8_LDB
#undef PG8_MMA
#undef PG8_WAIT_V
#undef PG8_WAIT_L
#undef PG8_BAR
#undef PG8_SCHED
}
}

using namespace pg8;
#define LAS __attribute__((address_space(3)))
typedef short s16x4 __attribute__((ext_vector_type(4)));
#ifndef N_LAUNCH
#define N_LAUNCH 1
#endif
constexpr int NPHASE = 9;
constexpr int LDS_BYTES = 135168;
constexpr size_t MiB = 1u << 20;
constexpr size_t WS_SS2 = 0, WS_SSE = 1310720, WS_SSO = 2621440, WS_ROPE = 3932160;
constexpr size_t WS_WIN = 6 * MiB, WS_WEFF = 14 * MiB, WS_WAB = 15 * MiB, WS_WOUT = 17 * MiB, WS_WFI = 19 * MiB, WS_WFO = 30 * MiB, WS_WPP = 35 * MiB + 524288, WS_WPG = 36 * MiB;
constexpr size_t WS_PB = 38 * MiB;
constexpr size_t WS_RA = 47 * MiB;
constexpr size_t WS_RG = 80 * MiB;
constexpr size_t WS_UB = 145 * MiB, WS_QB = 161 * MiB + 262144, WS_KB = 193 * MiB + 786432, WS_VB = 201 * MiB + 917504, WS_MB = 210 * MiB;
constexpr size_t WS_MG = WS_QB;
constexpr size_t WS_ACT = 145 * MiB;
constexpr size_t WS_END = 256 * MiB;
static_assert(WS_UB + (size_t)MPAD * 512 * 2 == WS_QB && WS_QB + (size_t)MPAD * 1024 * 2 == WS_KB && WS_KB + (size_t)MPAD * 256 * 2 == WS_VB && WS_VB + (size_t)MPAD * 256 * 2 == WS_MB, "ws map");
static_assert(WS_MB + (size_t)MPAD * 512 * 2 <= WS_END && WS_ACT + (size_t)MPAD * FFH * 2 <= WS_END && WS_RA + (size_t)MPAD * 2048 <= WS_RG && WS_RG + (size_t)MPAD * 4096 <= WS_UB && WS_PB + (size_t)MPAD * 512 <= WS_RA, "ws map 2");
static_assert(WS_ROPE + 8193 * 64 <= WS_WIN && (size_t)MPAD * 64 <= WS_SSE, "ws map 3");

__device__ const float ROPE_INV[8] = {1.0f, 0.19392274474868576f, 0.03760603093086393f, 0.007292664737217109f, 0.001414213562373095f, 0.0002742481756762073f, 5.318295896944988e-05f, 1.031338537721246e-05f};

__device__ __forceinline__ unsigned f2bf(float f) { unsigned u = __builtin_bit_cast(unsigned, f); return (u + 0x7fffu + ((u >> 16) & 1u)) >> 16; }
__device__ __forceinline__ unsigned pk2(float lo, float hi) { return f2bf(lo) | (f2bf(hi) << 16); }
__device__ __forceinline__ float wave_sum(float v) {
#pragma unroll
    for (int o = 1; o < 64; o <<= 1) v += __shfl_xor(v, o);
    return v;
}
__device__ __forceinline__ float wave_max(float v) {
#pragma unroll
    for (int o = 1; o < 64; o <<= 1) v = fmaxf(v, __shfl_xor(v, o));
    return v;
}
#define LDS_WAIT() asm volatile("s_waitcnt lgkmcnt(0)" ::: "memory")

struct Args { const float* in[22]; float* out; unsigned char* ws; int ph_lo, ph_hi; };
typedef const float* cfp_t;
__device__ __forceinline__ cfp_t karg_in(int k) { const __attribute__((address_space(4))) char* kp = (const __attribute__((address_space(4))) char*)__builtin_amdgcn_kernarg_segment_ptr(); return *(const volatile __attribute__((address_space(4))) cfp_t*)(kp + 8 * k); }
__device__ __forceinline__ float* karg_out() { return (float*)karg_in(22); }
__device__ __forceinline__ unsigned char* karg_ws() { return (unsigned char*)karg_in(23); }
struct TItem { const float* W; bf16_t* WT; int K, N, mode, r; };
__device__ __forceinline__ TItem p0_item(unsigned char* ws, int it) {
    constexpr int I_IN = 16 * 128, I_AB = 16 * 32, I_OUT = 16 * 32, I_FI = 16 * 176, I_FO = 44 * 32, I_PP = 4 * 32;
    int r = it;
    if (r < I_IN) return TItem{karg_in(8), (bf16_t*)(ws + WS_WIN), 1024, INC, 0, r}; r -= I_IN;
    if (r < I_AB) return TItem{karg_in(13), (bf16_t*)(ws + WS_WAB), 1024, 1024, 0, r}; r -= I_AB;
    if (r < I_OUT) return TItem{karg_in(14), (bf16_t*)(ws + WS_WOUT), 1024, 1024, 0, r}; r -= I_OUT;
    if (r < I_FI) return TItem{karg_in(16), (bf16_t*)(ws + WS_WFI), 1024, 2 * FFH, 1, r}; r -= I_FI;
    if (r < I_FO) return TItem{karg_in(17), (bf16_t*)(ws + WS_WFO), FFH, 1024, 0, r}; r -= I_FO;
    if (r < I_PP) return TItem{karg_in(18), (bf16_t*)(ws + WS_WPP), PLE, 1024, 0, r}; r -= I_PP;
    return TItem{karg_in(20), (bf16_t*)(ws + WS_WPG), 1024, 1024, 0, r};
}
__device__ __forceinline__ void p0_item_load(const TItem& t, float (&wv)[32], int lane) {
    const int nblk = t.N / 32, kb = t.r / nblk, nb = t.r % nblk, k0 = 64 * kb, n0 = 32 * nb;
#pragma unroll
    for (int i = 0; i < 32; ++i) wv[i] = __builtin_nontemporal_load(t.W + (size_t)(k0 + 2 * i + (lane >> 5)) * t.N + n0 + (lane & 31));
}
__device__ __forceinline__ void p0_item_finish(const TItem& t, const float (&wv)[32], LAS float* scr, int lane, const float* kscale) {
    const int nblk = t.N / 32, kb = t.r / nblk, nb = t.r % nblk, k0 = 64 * kb, n0 = 32 * nb;
    if (t.mode == 1) {
#pragma unroll
        for (int i = 0; i < 32; ++i) scr[(2 * i + (lane >> 5)) * 33 + (lane & 31)] = wv[i] * kscale[k0 + 2 * i + (lane >> 5)];
    } else {
#pragma unroll
        for (int i = 0; i < 32; ++i) scr[(2 * i + (lane >> 5)) * 33 + (lane & 31)] = wv[i];
    }
    LDS_WAIT();
    const int c = lane & 7;
#pragma unroll
    for (int j = 0; j < 4; ++j) { const int n = (lane >> 3) + 8 * j; const LAS float* s = scr + (8 * c) * 33 + n;
        u32x4 o; o.x = pk2(s[0 * 33], s[1 * 33]); o.y = pk2(s[2 * 33], s[3 * 33]); o.z = pk2(s[4 * 33], s[5 * 33]); o.w = pk2(s[6 * 33], s[7 * 33]);
        int nn = n0 + n;
        if (t.mode == 1) { const int up = nn >= FFH ? 1 : 0; const int jj = nn - up * FFH; nn = 8 * (jj >> 2) + 4 * up + (jj & 3); }
        *(u32x4*)(t.WT + (size_t)nn * t.K + k0 + 8 * c) = o; }
    LDS_WAIT();
}
__device__ __forceinline__ void rms_row_to_bf16(const float* xrow, const float* gamma, bf16_t* orow, int lane) {
    const f32x4* xr = (const f32x4*)xrow + lane; f32x4 v[4]; float s = 0.f;
#pragma unroll
    for (int j = 0; j < 4; ++j) { v[j] = xr[64 * j]; s += sum4(v[j] * v[j]); }
    const float rs = rsqrtf(wave_sum(s) * (1.0f / DM) + EPS);
    u32x2* o8 = (u32x2*)orow + lane;
#pragma unroll
    for (int j = 0; j < 4; ++j) { const f32x4 g = ((const f32x4*)gamma)[lane + 64 * j]; const f32x4 y = v[j] * rs * g; u32x2 w; w.x = pk2(y[0], y[1]); w.y = pk2(y[2], y[3]); o8[64 * j] = w; }
}


template <int PART>
__device__ __forceinline__ void p0_prologue(LAS unsigned char* lds, int tid, int wave, int lane, int cidx, int cnum) {
    unsigned char* ws = karg_ws(); float* const aout = karg_out(); (void)aout;
    LAS float* scr = (LAS float*)(lds + wave * 16384);
    const int gw = cidx * 8 + wave, NGW = cnum * 8;
    const int gt = cidx * 512 + tid, NGT = cnum * 512;
    constexpr int I_IN = 16 * 128, I_AB = 16 * 32, I_OUT = 16 * 32, I_FI = 16 * 176, I_FO = 44 * 32, I_PP = 4 * 32, I_PG = 16 * 32;
    constexpr int NITEMS = I_IN + I_AB + I_OUT + I_FI + I_FO + I_PP + I_PG;
    {
        const int it_end = (PART == 0 ? I_IN : NITEMS); int it = (PART == 0 ? gw : I_IN + gw); const float* const ln2_ = karg_in(15);
        if (it < it_end) {
            TItem cur = p0_item(ws, it); float wv[32]; p0_item_load(cur, wv, lane);
            for (;;) {
                const int nx = it + NGW; const bool more = nx < it_end; TItem nxt = cur; float wn[32];
                if (more) { nxt = p0_item(ws, nx); p0_item_load(nxt, wn, lane); }
                p0_item_finish(cur, wv, scr, lane, ln2_);
                if (!more) break;
                cur = nxt; it = nx;
#pragma unroll
                for (int i = 0; i < 32; ++i) wv[i] = wn[i];
            }
        }
    }
    if (PART == 1) {
        const float* gwt = karg_in(9); const float* sc = karg_in(10); const float* wpb = karg_in(12); bf16_t* weff = (bf16_t*)(ws + WS_WEFF);
        const int fr = lane & 15, fq = lane >> 4;
        for (int t = gw; t < 4 * 8 * 64; t += NGW) {
            const int nt = t & 63, kt = (t >> 6) & 7, g = t >> 9;
            const float* ga = gwt + (size_t)(g * 128 + kt * 16 + fr) * 128 + fq * 8;
            const float* wb = wpb + (size_t)(g * 128 + fq * 8) * 1024 + nt * 16 + fr;
            const float* sg = sc + g * 128 + fq * 8;
            f32x4 a0[4], a1[4]; float bv[4][8], sv[4][8];
#pragma unroll
            for (int cs = 0; cs < 4; ++cs) { a0[cs] = *(const f32x4*)(ga + cs * 32); a1[cs] = *(const f32x4*)(ga + cs * 32 + 4);
#pragma unroll
                for (int e = 0; e < 8; ++e) { bv[cs][e] = wb[(size_t)(cs * 32 + e) * 1024]; sv[cs][e] = sg[cs * 32 + e]; } }
            f32x4 acc = {0.f, 0.f, 0.f, 0.f};
#pragma unroll
            for (int cs = 0; cs < 4; ++cs) {
                u32x4 aw; aw.x = pk2(a0[cs][0], a0[cs][1]); aw.y = pk2(a0[cs][2], a0[cs][3]); aw.z = pk2(a1[cs][0], a1[cs][1]); aw.w = pk2(a1[cs][2], a1[cs][3]);
                u32x4 bw; bw.x = pk2(bv[cs][0] * sv[cs][0], bv[cs][1] * sv[cs][1]); bw.y = pk2(bv[cs][2] * sv[cs][2], bv[cs][3] * sv[cs][3]); bw.z = pk2(bv[cs][4] * sv[cs][4], bv[cs][5] * sv[cs][5]); bw.w = pk2(bv[cs][6] * sv[cs][6], bv[cs][7] * sv[cs][7]);
                acc = __builtin_amdgcn_mfma_f32_16x16x32_bf16(__builtin_bit_cast(bf16x8, aw), __builtin_bit_cast(bf16x8, bw), acc, 0, 0, 0); }
            u32x2 o; o.x = pk2(acc[0], acc[1]); o.y = pk2(acc[2], acc[3]);
            *(u32x2*)(weff + (size_t)(nt * 16 + fr) * 512 + g * 128 + kt * 16 + 4 * fq) = o;
        }
    }
    if (PART == 0) { const float* const xp_ = karg_in(0); const float* const xs_ = karg_in(1); const float* const ln1_ = karg_in(7);
    int mx = gw < MSM ? MPR + gw : -1;
    for (int m = gw * 2; m < MPR; m += NGW * 2) {
        const int m1 = m + 1;
        const f32x4* x0 = (const f32x4*)(xp_ + (size_t)m * DM) + lane; const f32x4* x1 = (const f32x4*)(xp_ + (size_t)m1 * DM) + lane;
        f32x4 v0[4], v1[4], v2[4]; float s0 = 0.f, s1 = 0.f, s2 = 0.f;
#pragma unroll
        for (int j = 0; j < 4; ++j) { v0[j] = __builtin_nontemporal_load(x0 + 64 * j); v1[j] = __builtin_nontemporal_load(x1 + 64 * j); }
        if (mx >= 0) { const f32x4* x2 = (const f32x4*)(xs_ + (size_t)(mx - MPR) * DM) + lane;
#pragma unroll
            for (int j = 0; j < 4; ++j) v2[j] = __builtin_nontemporal_load(x2 + 64 * j); }
#pragma unroll
        for (int j = 0; j < 4; ++j) { s0 += sum4(v0[j] * v0[j]); s1 += sum4(v1[j] * v1[j]); }
        const float r0 = rsqrtf(wave_sum(s0) * (1.0f / DM) + EPS), r1 = rsqrtf(wave_sum(s1) * (1.0f / DM) + EPS);
        u32x2* o0 = (u32x2*)((bf16_t*)(ws + WS_RA) + (size_t)m * DM) + lane; u32x2* o1 = (u32x2*)((bf16_t*)(ws + WS_RA) + (size_t)m1 * DM) + lane;
#pragma unroll
        for (int j = 0; j < 4; ++j) { const f32x4 g = ((const f32x4*)ln1_)[lane + 64 * j]; const f32x4 y0 = v0[j] * r0 * g, y1 = v1[j] * r1 * g;
            u32x2 w0, w1; w0.x = pk2(y0[0], y0[1]); w0.y = pk2(y0[2], y0[3]); w1.x = pk2(y1[0], y1[1]); w1.y = pk2(y1[2], y1[3]); o0[64 * j] = w0; o1[64 * j] = w1; }
        if (mx >= 0) {
#pragma unroll
            for (int j = 0; j < 4; ++j) s2 += sum4(v2[j] * v2[j]);
            const float r2 = rsqrtf(wave_sum(s2) * (1.0f / DM) + EPS); u32x2* o2 = (u32x2*)((bf16_t*)(ws + WS_RA) + (size_t)mx * DM) + lane;
#pragma unroll
            for (int j = 0; j < 4; ++j) { const f32x4 g = ((const f32x4*)ln1_)[lane + 64 * j]; const f32x4 y2 = v2[j] * r2 * g; u32x2 w2; w2.x = pk2(y2[0], y2[1]); w2.y = pk2(y2[2], y2[3]); o2[64 * j] = w2; }
            mx = -1; }
    }
    for (int r = (mx >= 0 ? gw : gw + NGW); r < MSM; r += NGW) rms_row_to_bf16(xs_ + (size_t)r * DM, ln1_, (bf16_t*)(ws + WS_RA) + (size_t)(MPR + r) * DM, lane);
    }
    if (PART == 1) { const float* const pp_ = karg_in(2); const float* const ps_ = karg_in(3);
    for (int idx0 = gt; idx0 < MREAL * 32; idx0 += NGT * 4) {
        f32x4 v0[4], v1[4];
#pragma unroll
        for (int q = 0; q < 4; ++q) { const int idx = idx0 + q * NGT; if (idx < MREAL * 32) { const int m = idx >> 5, c = (idx & 31) * 8; const float* pr = (m < MPR ? pp_ + (size_t)m * PLE : ps_ + (size_t)(m - MPR) * PLE) + c; v0[q] = __builtin_nontemporal_load((const f32x4*)pr); v1[q] = __builtin_nontemporal_load((const f32x4*)(pr + 4)); } }
#pragma unroll
        for (int q = 0; q < 4; ++q) { const int idx = idx0 + q * NGT; if (idx < MREAL * 32) { const int m = idx >> 5, c = (idx & 31) * 8;
            u32x4 w; w.x = pk2(v0[q][0], v0[q][1]); w.y = pk2(v0[q][2], v0[q][3]); w.z = pk2(v1[q][0], v1[q][1]); w.w = pk2(v1[q][2], v1[q][3]);
            *(u32x4*)((bf16_t*)(ws + WS_PB) + (size_t)m * PLE + c) = w; } }
    } }
    if (PART == 0) for (int idx = gt; idx < 8193 * 8; idx += NGT) {
        const int pi = idx >> 3, i = idx & 7; const float pos = pi < SEQ ? (float)pi : 16384.0f; const float ang = pos * ROPE_INV[i];
        const double tw = 6.283185307179586476925; const double kq = __builtin_rint((double)ang * (1.0 / tw)); const float r = (float)((double)ang - kq * tw);
        float* rp = (float*)(ws + WS_ROPE) + (size_t)pi * 16; rp[i] = __cosf(r); rp[8 + i] = __sinf(r);
    }
    if (PART == 1) { const float* const st_ = karg_in(6);
    for (int idx = gt; idx < MSM * 14 * 128; idx += NGT) {
        const int b = idx / (14 * 128), rem = idx % (14 * 128), r = rem >> 7, c = (rem & 127) * 4;
        *(f32x4*)(aout + O_NPS + ((size_t)b * 15 + r) * 512 + c) = *(const f32x4*)(st_ + ((size_t)b * 15 + r + 1) * 512 + c);
    } }
}

__device__ __forceinline__ f32x4 ld4bf(const bf16_t* p) { const u32x2 w = *(const u32x2*)p; return (f32x4){bflo(w.x), bfhi(w.x), bflo(w.y), bfhi(w.y)}; }
__device__ __forceinline__ f32x4 mfma16(const bf16x8 a, const bf16x8 b, const f32x4 c) { return __builtin_amdgcn_mfma_f32_16x16x32_bf16(a, b, c, 0, 0, 0); }

struct KVRegs { u32x4 k[4], v[4]; };
__device__ __forceinline__ void attn_kv_load(KVRegs& r, int unit, const bf16_t* kb, const bf16_t* vb, int tid) {
    const int kvh = unit & 3, nb = (unit >> 2) & 63, b = unit >> 8, R0 = b * SEQ + nb * 128;
#pragma unroll
    for (int i = 0; i < 4; ++i) { const int c = tid + 512 * i, s = c >> 3, seg = c & 7; const bool ok = (nb > 0) || (s >= 128);
        r.k[i] = (u32x4){0u, 0u, 0u, 0u}; r.v[i] = (u32x4){0u, 0u, 0u, 0u};
        if (ok) { const size_t go = (size_t)(R0 - 128 + s) * 256 + kvh * 64 + seg * 8; r.k[i] = *(const u32x4*)(kb + go); r.v[i] = *(const u32x4*)(vb + go); } }
}
__device__ __forceinline__ void attn_kv_store(const KVRegs& r, LAS unsigned char* lds, int tid) {
    LAS bf16_t* Ks = (LAS bf16_t*)lds; LAS bf16_t* Vt = (LAS bf16_t*)(lds + 256 * 72 * 2);
#pragma unroll
    for (int i = 0; i < 4; ++i) { const int c = tid + 512 * i, s = c >> 3, seg = c & 7;
        *(LAS u32x4*)(Ks + s * 72 + seg * 8) = r.k[i];
        LAS bf16_t* vp = Vt + (seg * 8) * 264 + (s ^ (seg * 8)); const u32x4 vv = r.v[i];
        vp[0 * 264] = (bf16_t)(vv.x & 0xffffu); vp[1 * 264] = (bf16_t)(vv.x >> 16); vp[2 * 264] = (bf16_t)(vv.y & 0xffffu); vp[3 * 264] = (bf16_t)(vv.y >> 16);
        vp[4 * 264] = (bf16_t)(vv.z & 0xffffu); vp[5 * 264] = (bf16_t)(vv.z >> 16); vp[6 * 264] = (bf16_t)(vv.w & 0xffffu); vp[7 * 264] = (bf16_t)(vv.w >> 16); }
}
__device__ __forceinline__ void attn_prompt_math(LAS unsigned char* lds, int unit, const bf16_t* qb, bf16_t* ob, const float* sinks, int wave, int lane) {
    const int kvh = unit & 3, nb = (unit >> 2) & 63, b = unit >> 8, R0 = b * SEQ + nb * 128;
    const LAS bf16_t* Ks = (const LAS bf16_t*)lds; const LAS bf16_t* Vt = (const LAS bf16_t*)(lds + 256 * 72 * 2);
    const int g = wave >> 1, half = wave & 1, h = kvh * 4 + g, fr = lane & 15, fq = lane >> 4;
    const float sink = sinks[h];
    bf16x8 qf[4][2];
#pragma unroll
    for (int sb = 0; sb < 4; ++sb) { const bf16_t* qp = qb + (size_t)(R0 + half * 64 + sb * 16 + fr) * 1024 + h * 64 + fq * 8; qf[sb][0] = *(const bf16x8*)qp; qf[sb][1] = *(const bf16x8*)(qp + 32); }
#pragma unroll
    for (int sb = 0; sb < 4; ++sb) {
        const int qi0 = half * 64 + sb * 16, kt0 = qi0 >> 4, q = qi0 + fr;
        f32x4 S[9];
#pragma unroll
        for (int j = 0; j < 9; ++j) { const LAS bf16_t* kp = Ks + ((kt0 + j) * 16 + fr) * 72 + fq * 8;
            f32x4 acc = {0.f, 0.f, 0.f, 0.f}; acc = mfma16(*(const LAS bf16x8*)kp, qf[sb][0], acc); acc = mfma16(*(const LAS bf16x8*)(kp + 32), qf[sb][1], acc); S[j] = acc; }
        float mx = sink; const int e = fr - 4 * fq;
#pragma unroll
        for (int j = 0; j < 9; ++j) { const bool tok = (nb > 0) || (kt0 + j >= 8);
#pragma unroll
            for (int jj = 0; jj < 4; ++jj) { bool valid = tok; if (j == 0) valid = valid && (e < jj); if (j == 8) valid = valid && (e >= jj);
                const float v = valid ? S[j][jj] : -1e30f; S[j][jj] = v; mx = fmaxf(mx, v); } }
        mx = fmaxf(mx, __shfl_xor(mx, 16)); mx = fmaxf(mx, __shfl_xor(mx, 32));
        float l = 0.f;
#pragma unroll
        for (int j = 0; j < 9; ++j)
#pragma unroll
            for (int jj = 0; jj < 4; ++jj) { const float p = __expf(S[j][jj] - mx); S[j][jj] = p; l += p; }
        l += __shfl_xor(l, 16); l += __shfl_xor(l, 32); l += __expf(sink - mx);
        const float inv = 1.0f / l;
        f32x4 O[4];
#pragma unroll
        for (int dt = 0; dt < 4; ++dt) O[dt] = (f32x4){0.f, 0.f, 0.f, 0.f};
#pragma unroll
        for (int jp = 0; jp < 5; ++jp) {
            u32x4 pw; pw.x = cvt_pk_bf16_v(S[2 * jp][0], S[2 * jp][1]); pw.y = cvt_pk_bf16_v(S[2 * jp][2], S[2 * jp][3]);
            if (jp < 4) { pw.z = cvt_pk_bf16_v(S[2 * jp + 1 < 9 ? 2 * jp + 1 : 8][0], S[2 * jp + 1 < 9 ? 2 * jp + 1 : 8][1]); pw.w = cvt_pk_bf16_v(S[2 * jp + 1 < 9 ? 2 * jp + 1 : 8][2], S[2 * jp + 1 < 9 ? 2 * jp + 1 : 8][3]); } else { pw.z = 0u; pw.w = 0u; }
            const bf16x8 pf = __builtin_bit_cast(bf16x8, pw);
#pragma unroll
            for (int dt = 0; dt < 4; ++dt) { const int d = dt * 16 + fr, sw = ((d >> 3) & 7) * 8, s0 = (kt0 + 2 * jp) * 16 + fq * 4; const LAS bf16_t* vr = Vt + d * 264;
                const s16x4 lo = *(const LAS s16x4*)(vr + (s0 ^ sw)); s16x4 hi = {0, 0, 0, 0}; if (jp < 4) hi = *(const LAS s16x4*)(vr + ((s0 + 16) ^ sw));
                const bf16x8 vf = {lo[0], lo[1], lo[2], lo[3], hi[0], hi[1], hi[2], hi[3]};
                O[dt] = mfma16(vf, pf, O[dt]); }
        }
        bf16_t* op = ob + (size_t)(R0 + q) * 1024 + h * 64 + fq * 4;
#pragma unroll
        for (int dt = 0; dt < 4; ++dt) { const f32x4 o = O[dt] * inv; u32x2 w; w.x = cvt_pk_bf16(o[0], o[1]); w.y = cvt_pk_bf16(o[2], o[3]); *(u32x2*)(op + dt * 16) = w; }
    }
}
__device__ __forceinline__ void attn_prompt_all(LAS unsigned char* lds, const bf16_t* qb, const bf16_t* kb, const bf16_t* vb, bf16_t* ob, const float* sinks, int tid, int wave, int lane) {
    const int G = gridDim.x; int unit = blockIdx.x; if (unit >= 512) return;
    KVRegs r; attn_kv_load(r, unit, kb, vb, tid);
    for (;;) {
        attn_kv_store(r, lds, tid);
        __syncthreads();
        const int nxt = unit + G;
        if (nxt < 512) attn_kv_load(r, nxt, kb, vb, tid);
        attn_prompt_math(lds, unit, qb, ob, sinks, wave, lane);
        __syncthreads();
        if (nxt >= 512) break;
        unit = nxt;
    }
}

__device__ __forceinline__ void attn_sample_unit(LAS unsigned char* lds, int unit, const bf16_t* qb, const bf16_t* kb, const bf16_t* vb, bf16_t* ob, const float* cache_k, const float* cache_v, const float* sinks, float* out, int tid, int wave, int lane) {
    const int kvh = unit & 3, b = unit >> 2; const size_t row = MPR + b;
    LAS float* sc = (LAS float*)lds;
    LAS float* lsum = sc + 4 * 132;
    LAS float* opart = sc + 4 * 132 + 16;
    const int jq = lane >> 4, dq = lane & 15;
    f32x4 qv[4];
#pragma unroll
    for (int g = 0; g < 4; ++g) qv[g] = ld4bf(qb + row * 1024 + (kvh * 4 + g) * 64 + dq * 4);
    f32x4 kv[4], vv[4];
#pragma unroll
    for (int i = 0; i < 4; ++i) { const int j = wave * 16 + i * 4 + jq; const size_t off = ((size_t)(b * 128 + j) * 4 + kvh) * 64 + dq * 4;
        kv[i] = __builtin_nontemporal_load((const f32x4*)(cache_k + off)); vv[i] = __builtin_nontemporal_load((const f32x4*)(cache_v + off)); }
    const f32x4 knew = ld4bf(kb + row * 256 + kvh * 64 + dq * 4);
#pragma unroll
    for (int i = 0; i < 4; ++i) { const int j = wave * 16 + i * 4 + jq;
        if (j >= 1) { const size_t off = ((size_t)(b * 128 + j - 1) * 4 + kvh) * 64 + dq * 4; __builtin_nontemporal_store(kv[i], (f32x4*)(out + O_NKS + off)); __builtin_nontemporal_store(vv[i], (f32x4*)(out + O_NVS + off)); } }
#pragma unroll
    for (int i = 0; i < 5; ++i) { const f32x4 kk = i < 4 ? kv[i < 4 ? i : 0] : knew; float mine = 0.f;
#pragma unroll
        for (int g = 0; g < 4; ++g) { float p = sum4(kk * qv[g]); p += __shfl_xor(p, 1); p += __shfl_xor(p, 2); p += __shfl_xor(p, 4); p += __shfl_xor(p, 8); if (dq == g) mine = p; }
        if (i < 4) { if (dq < 4) sc[dq * 132 + wave * 16 + i * 4 + jq] = mine; }
        else if (wave == 0 && jq == 0 && dq < 4) sc[dq * 132 + 128] = mine; }
    __syncthreads();
    if (wave < 4) { const int g = wave; float a = sc[g * 132 + lane]; const float b2 = sc[g * 132 + 64 + lane], n = sc[g * 132 + 128], sink = sinks[kvh * 4 + g];
        if (lane == 0) a = -1e30f;
        const float mx = fmaxf(fmaxf(wave_max(fmaxf(a, b2)), n), sink);
        const float pa = __expf(a - mx), pb = __expf(b2 - mx), pnw = __expf(n - mx); const float l = wave_sum(pa + pb) + pnw + __expf(sink - mx);
        sc[g * 132 + lane] = pa; sc[g * 132 + 64 + lane] = pb; if (lane == 0) { sc[g * 132 + 128] = pnw; lsum[g] = 1.0f / l; } }
    __syncthreads();
    f32x4 o[4];
#pragma unroll
    for (int g = 0; g < 4; ++g) o[g] = (f32x4){0.f, 0.f, 0.f, 0.f};
#pragma unroll
    for (int i = 0; i < 4; ++i) { const int j = wave * 16 + i * 4 + jq;
#pragma unroll
        for (int g = 0; g < 4; ++g) o[g] += vv[i] * sc[g * 132 + j]; }
#pragma unroll
    for (int g = 0; g < 4; ++g)
#pragma unroll
        for (int e = 0; e < 4; ++e) { float t = o[g][e]; t += __shfl_xor(t, 16); t += __shfl_xor(t, 32); o[g][e] = t; }
    if (jq == 0) {
#pragma unroll
        for (int g = 0; g < 4; ++g) *(LAS f32x4*)(opart + (wave * 4 + g) * 64 + dq * 4) = o[g]; }
    __syncthreads();
    if (tid < 256) { const int g = tid >> 6, d = tid & 63; float acc = 0.f;
#pragma unroll
        for (int w = 0; w < 8; ++w) acc += opart[(w * 4 + g) * 64 + d];
        acc += sc[g * 132 + 128] * bflo((unsigned)vb[row * 256 + kvh * 64 + d]);
        ob[row * 1024 + (kvh * 4 + g) * 64 + d] = (bf16_t)f2bf(acc * lsum[g]); }
    __syncthreads();
}

template <int W>
__device__ __forceinline__ void pool_item(const bf16_t* __restrict__ ub, bf16_t* __restrict__ mb, const float* __restrict__ state, int row, int ch) {
    f32x4 u0, u1; unpack8(*(const u32x4*)(ub + (size_t)row * 512 + ch), u0, u1);
    f32x4 s0 = u0, s1 = u1; float cnt;
    if (row < MPR) { const int t = row & (SEQ - 1); cnt = (float)((t + 1 < W) ? t + 1 : W);
        u32x4 w[W - 1];
#pragma unroll
        for (int i = 1; i < W; ++i) { w[i - 1] = (u32x4){0u, 0u, 0u, 0u}; if (i <= t) w[i - 1] = *(const u32x4*)(ub + (size_t)(row - i) * 512 + ch); }
#pragma unroll
        for (int i = 1; i < W; ++i) { f32x4 a0, a1; unpack8(w[i - 1], a0, a1); s0 += a0; s1 += a1; } }
    else { const int b = row - MPR; cnt = (float)W;
#pragma unroll
        for (int i = 1; i < W; ++i) { const float* sp = state + ((size_t)b * 15 + 15 - i) * 512 + ch; s0 += *(const f32x4*)sp; s1 += *(const f32x4*)(sp + 4); } }
    const float ic = 1.0f / cnt;
    *(u32x4*)(mb + (size_t)row * 512 + ch) = pack8(s0 * ic - u0, s1 * ic - u1);
}
template <int W>
__device__ __forceinline__ void pool_block4(const bf16_t* __restrict__ ub, bf16_t* __restrict__ mb, const float* __restrict__ state, int row0, int ch) {
    if (row0 >= MPR) {
#pragma unroll
        for (int r = 0; r < 4; ++r) pool_item<W>(ub, mb, state, row0 + r, ch);
        return;
    }
    const int t0 = row0 & (SEQ - 1);
    u32x4 w[W + 3];
#pragma unroll
    for (int j = 0; j < W + 3; ++j) { w[j] = (u32x4){0u, 0u, 0u, 0u}; if (t0 + j - (W - 1) >= 0) w[j] = *(const u32x4*)(ub + (size_t)(row0 + j - (W - 1)) * 512 + ch); }
    f32x4 s0 = {0.f, 0.f, 0.f, 0.f}, s1 = {0.f, 0.f, 0.f, 0.f};
#pragma unroll
    for (int j = 0; j < W - 1; ++j) { f32x4 a0, a1; unpack8(w[j], a0, a1); s0 += a0; s1 += a1; }
#pragma unroll
    for (int r = 0; r < 4; ++r) {
        f32x4 u0, u1; unpack8(w[W - 1 + r], u0, u1); s0 += u0; s1 += u1;
        const int n = (t0 + r + 1 < W) ? t0 + r + 1 : W; const float ic = 1.0f / (float)n;
        *(u32x4*)(mb + (size_t)(row0 + r) * 512 + ch) = pack8(s0 * ic - u0, s1 * ic - u1);
        f32x4 o0, o1; unpack8(w[r], o0, o1); s0 -= o0; s1 -= o1;
    }
}
__device__ __forceinline__ void pool_items(unsigned char* ws, const float* __restrict__ state, int tid) {
    const bf16_t* __restrict__ ub = (const bf16_t*)(ws + WS_UB); bf16_t* __restrict__ mb = (bf16_t*)(ws + WS_MB);
    for (int idx = blockIdx.x * 512 + tid; idx < (MREAL / 4) * 64; idx += gridDim.x * 512) {
        const int cgk = idx & 15, g = (idx >> 6) & 3, rb = (idx >> 8) * 4 + ((idx >> 4) & 3), row0 = rb * 4, ch = g * 128 + cgk * 8;
        if (g == 0) pool_block4<2>(ub, mb, state, row0, ch); else if (g == 1) pool_block4<4>(ub, mb, state, row0, ch); else if (g == 2) pool_block4<8>(ub, mb, state, row0, ch); else pool_block4<16>(ub, mb, state, row0, ch);
    }
}

template <int K, class F>
__device__ __forceinline__ void skinny_gemm(LAS unsigned char* lds, const bf16_t* A, const bf16_t* Bt, int wave, int lane, const F& f) {
    constexpr int KQ = K / 4;
    const int fr = lane & 15, fq = lane >> 4, ks = wave & 3;
    for (int tp = blockIdx.x; tp < 256; tp += gridDim.x) {
        const int t = tp * 2 + (wave >> 2), cb = t & 63, rb = t >> 6;
        const bf16_t* ap = A + (size_t)(rb * 16 + fr) * K + ks * KQ + fq * 8;
        const bf16_t* bp = Bt + (size_t)(cb * 16 + fr) * K + ks * KQ + fq * 8;
        f32x4 acc = {0.f, 0.f, 0.f, 0.f};
#pragma unroll 8
        for (int k = 0; k < KQ; k += 32) acc = mfma16(*(const bf16x8*)(bp + k), *(const bf16x8*)(ap + k), acc);
        LAS f32x4* red = (LAS f32x4*)lds;
        red[wave * 64 + lane] = acc;
        __syncthreads();
        if (ks == 0) { acc = (red[wave * 64 + lane] + red[(wave + 1) * 64 + lane]) + (red[(wave + 2) * 64 + lane] + red[(wave + 3) * 64 + lane]);
            f(MPR + rb * 16 + fr, cb * 16 + fq * 4, acc, fq, cb); }
        __syncthreads();
    }
}
__device__ __forceinline__ void st4bf(bf16_t* p, const f32x4 v) { u32x2 w; w.x = cvt_pk_bf16(v[0], v[1]); w.y = cvt_pk_bf16(v[2], v[3]); *(u32x2*)p = w; }
__device__ __forceinline__ void ss_part(float* ss, int row, int cb, int fq, float q) { q += __shfl_xor(q, 16); q += __shfl_xor(q, 32); if (fq == 0) ss[(size_t)MPR * 16 + (size_t)(row - MPR) * 64 + cb] = q; }
template <int K1, int K2, class F>
__device__ __forceinline__ void skinny_gemm2(LAS unsigned char* lds, const bf16_t* A1, const bf16_t* Bt1, const bf16_t* A2, const bf16_t* Bt2, int wave, int lane, const F& f) {
    constexpr int KQ1 = K1 / 4, KQ2 = K2 / 4;
    const int fr = lane & 15, fq = lane >> 4, ks = wave & 3;
    for (int tp = blockIdx.x; tp < 256; tp += gridDim.x) {
        const int t = tp * 2 + (wave >> 2), cb = t & 63, rb = t >> 6;
        const bf16_t* ap1 = A1 + (size_t)(rb * 16 + fr) * K1 + ks * KQ1 + fq * 8; const bf16_t* bp1 = Bt1 + (size_t)(cb * 16 + fr) * K1 + ks * KQ1 + fq * 8;
        const bf16_t* ap2 = A2 + (size_t)(rb * 16 + fr) * K2 + ks * KQ2 + fq * 8; const bf16_t* bp2 = Bt2 + (size_t)(cb * 16 + fr) * K2 + ks * KQ2 + fq * 8;
        f32x4 acc1 = {0.f, 0.f, 0.f, 0.f}, acc2 = {0.f, 0.f, 0.f, 0.f};
#pragma unroll 8
        for (int k = 0; k < KQ2; k += 32) acc2 = mfma16(*(const bf16x8*)(bp2 + k), *(const bf16x8*)(ap2 + k), acc2);
#pragma unroll 8
        for (int k = 0; k < KQ1; k += 32) acc1 = mfma16(*(const bf16x8*)(bp1 + k), *(const bf16x8*)(ap1 + k), acc1);
        LAS f32x4* red = (LAS f32x4*)lds;
        red[wave * 64 + lane] = acc1; red[512 + wave * 64 + lane] = acc2;
        __syncthreads();
        if (ks == 0) { acc1 = (red[wave * 64 + lane] + red[(wave + 1) * 64 + lane]) + (red[(wave + 2) * 64 + lane] + red[(wave + 3) * 64 + lane]);
            acc2 = (red[512 + wave * 64 + lane] + red[512 + (wave + 1) * 64 + lane]) + (red[512 + (wave + 2) * 64 + lane] + red[512 + (wave + 3) * 64 + lane]);
            f(MPR + rb * 16 + fr, cb * 16 + fq * 4, acc1, acc2, fq, cb); }
        __syncthreads();
    }
}
struct SMerge2 { bf16_t* mg; const bf16_t* gb;
    __device__ __forceinline__ void operator()(int row, int col, f32x4 v1, f32x4 v2, int, int) const { st4bf(mg + (size_t)row * DM + col, ld4bf(gb + (size_t)row * 2048 + col) * v1 + ld4bf(gb + (size_t)row * 2048 + 1024 + col) * v2); } };
struct SRes2Eraw { bf16_t* hb; bf16_t* er; float* ss;
    __device__ __forceinline__ void operator()(int row, int col, f32x4 v1, f32x4 v2, int fq, int cb) const {
        bf16_t* hp = hb + (size_t)row * DM + col; st4bf(hp, ld4bf(hp) + v1); st4bf(er + (size_t)row * DM + col, v2); ss_part(ss, row, cb, fq, sum4(v2 * v2)); } };
struct SMergeA { bf16_t* mg; const bf16_t* gb;
    __device__ __forceinline__ void operator()(int row, int col, f32x4 v, int, int) const { st4bf(mg + (size_t)row * DM + col, ld4bf(gb + (size_t)row * 2048 + col) * v); } };
struct SMergeB { bf16_t* mg; const bf16_t* gb;
    __device__ __forceinline__ void operator()(int row, int col, f32x4 v, int, int) const { bf16_t* p = mg + (size_t)row * DM + col; st4bf(p, ld4bf(p) + ld4bf(gb + (size_t)row * 2048 + 1024 + col) * v); } };
struct SRes1 { const float *xs; bf16_t* hb; float* ss;
    __device__ __forceinline__ void operator()(int row, int col, f32x4 v, int fq, int cb) const {
        v += *(const f32x4*)(xs + (size_t)(row - MPR) * DM + col); st4bf(hb + (size_t)row * DM + col, v); ss_part(ss, row, cb, fq, sum4(v * v)); } };
struct SRes2 { bf16_t* hb;
    __device__ __forceinline__ void operator()(int row, int col, f32x4 v, int, int) const { bf16_t* hp = hb + (size_t)row * DM + col; st4bf(hp, ld4bf(hp) + v); } };
struct SEraw { bf16_t* er; float* ss;
    __device__ __forceinline__ void operator()(int row, int col, f32x4 v, int fq, int cb) const { st4bf(er + (size_t)row * DM + col, v); ss_part(ss, row, cb, fq, sum4(v * v)); } };
struct SPle { bf16_t* ob; const bf16_t* hb; const bf16_t* er; const float *sse, *pn; float* sso;
    __device__ __forceinline__ void operator()(int row, int col, f32x4 v, int fq, int cb) const {
        const float rs = row_rs(sse, row);
        v = ld4bf(hb + (size_t)row * DM + col) + sigm4(v) * (ld4bf(er + (size_t)row * DM + col) * rs * *(const f32x4*)(pn + col)); st4bf(ob + (size_t)row * DM + col, v); ss_part(sso, row, cb, fq, sum4(v * v)); } };

#define XB_TMO      128
#define XB_XCNT(j)  (256  + 64 * (j))
#define XB_XSUB(j)  (1280 + 64 * (j))
#define XB_XGEN(j)  (2304 + 64 * (j))
#define XB_TOP      3328
#define XB_TOPGEN   3392
#define XCD_BAR_WORDS 3456
#define XB_SPIN_CAP (1u << 18)

__device__ __forceinline__ unsigned xb_ld(unsigned* p)              { return __hip_atomic_load(p, __ATOMIC_RELAXED, __HIP_MEMORY_SCOPE_AGENT); }
__device__ __forceinline__ unsigned xb_add(unsigned* p, unsigned v) { return __hip_atomic_fetch_add(p, v, __ATOMIC_RELAXED, __HIP_MEMORY_SCOPE_AGENT); }
__device__ __forceinline__ unsigned xb_xcc_id() { return (unsigned)__builtin_amdgcn_s_getreg((3 << 11) | 20) & 0xFu; }
#define XB_SPIN(cond, bar) do { unsigned _sp = 0; while (cond) { __builtin_amdgcn_s_sleep(1); \
    if ((++_sp & 255u) == 0u) { if (xb_ld(&(bar)[XB_TMO])) break; if (_sp > XB_SPIN_CAP) { atomicAdd(&(bar)[XB_TMO], 1u); break; } } } } while (0)

__device__ __forceinline__ bool is_thread0(int wave_s) { int l = (int)__builtin_amdgcn_mbcnt_hi(~0u, __builtin_amdgcn_mbcnt_lo(~0u, 0u)); asm volatile("" : "+v"(l)); return wave_s == 0 && l == 0; }
struct XcdBarrier {
    unsigned* bar; unsigned x;
    volatile LAS unsigned* st;
};

__device__ __forceinline__ XcdBarrier xcd_barrier_post(unsigned* bar, volatile LAS unsigned* st) {
    XcdBarrier b; b.bar = bar; b.x = xb_xcc_id(); b.st = st;
    if (threadIdx.x == 0) (void)xb_add(&bar[XB_XCNT(b.x)], 1u);
    return b;
}
__device__ __forceinline__ void xcd_barrier_complete(unsigned* bar, unsigned x, unsigned& nloc, unsigned& nx) {
    const unsigned G = gridDim.x * gridDim.y * gridDim.z;
    unsigned sum, cnt, mine, sp = 0u;
    for (;;) {
        sum = 0u; cnt = 0u; mine = 0u;
#pragma unroll
        for (unsigned j = 0; j < 16; ++j) { const unsigned c = xb_ld(&bar[XB_XCNT(j)]); sum += c; cnt += (c > 0u) ? 1u : 0u; mine = (j == x) ? c : mine; }
        if (sum == G) break;
        __builtin_amdgcn_s_sleep(1);
        if ((++sp & 255u) == 0u) { if (xb_ld(&bar[XB_TMO])) break; if (sp > XB_SPIN_CAP) { atomicAdd(&bar[XB_TMO], 1u); break; } }
    }
    nloc = mine > 0u ? mine : 1u; nx = cnt > 0u ? cnt : 1u;
}

__device__ __forceinline__ void xcd_barrier(const XcdBarrier& b, const int wave_s) {
    asm volatile("s_waitcnt vmcnt(0)" ::: "memory");
    __syncthreads();
    if (is_thread0(wave_s)) {
        unsigned* bar = b.bar;
        __builtin_amdgcn_s_waitcnt(0);
        unsigned nloc = b.st[0], nx = b.st[1];
        if (nloc == 0u) { xcd_barrier_complete(bar, b.x, nloc, nx); b.st[0] = nloc; b.st[1] = nx; }
        const unsigned old = xb_add(&bar[XB_XSUB(b.x)], 1u);
        const unsigned gen = old / nloc;
        if (old + 1u == (gen + 1u) * nloc) {
            __builtin_amdgcn_fence(__ATOMIC_RELEASE, "agent");
            asm volatile("s_waitcnt vmcnt(0)" ::: "memory");
            const unsigned og = xb_add(&bar[XB_TOP], 1u);
            const unsigned tg = og / nx;
            if (og + 1u == (tg + 1u) * nx) xb_add(&bar[XB_TOPGEN], 1u);
            else XB_SPIN(xb_ld(&bar[XB_TOPGEN]) == tg, bar);
            __builtin_amdgcn_fence(__ATOMIC_ACQUIRE, "agent");
            xb_add(&bar[XB_XGEN(b.x)], 1u);
            asm volatile("s_waitcnt vmcnt(0)" ::: "memory");
        } else {
            XB_SPIN(xb_ld(&bar[XB_XGEN(b.x)]) == gen, bar);
            __builtin_amdgcn_fence(__ATOMIC_ACQUIRE, "agent");
            asm volatile("s_waitcnt vmcnt(0)" ::: "memory");
        }
    }
    __syncthreads();
}

constexpr size_t WS_BAR = 5 * MiB; constexpr int BAR_BYTES = 16384;
__global__ void __launch_bounds__(512, 2) fwd_kernel(Args a) {
    extern __shared__ __attribute__((aligned(16))) unsigned char lds_raw[];
    LAS unsigned char* lds = (LAS unsigned char*)lds_raw;
    const int wave = __builtin_amdgcn_readfirstlane((int)threadIdx.x >> 6);
    if (threadIdx.x < 64) ((volatile LAS unsigned*)(lds + 131072))[threadIdx.x] = 0u;
    __syncthreads();
    XcdBarrier xbar; xbar.bar = (unsigned*)(karg_ws() + WS_BAR); xbar.x = 0; xbar.st = nullptr;
    if (a.ph_hi - a.ph_lo > 1) xbar = xcd_barrier_post((unsigned*)(karg_ws() + WS_BAR), (volatile LAS unsigned*)(lds + 131072) + 8);
#define TID_LANE() int lane = (int)__builtin_amdgcn_mbcnt_hi(~0u, __builtin_amdgcn_mbcnt_lo(~0u, 0u)); asm volatile("" : "+v"(lane)); const int tid = wave * 64 + lane; (void)tid
    const int lo = a.ph_lo, hi = a.ph_hi;
#define IN(k) (lo <= (k) && (k) < hi)
#define SEAM(k) do { if (IN(k) && IN((k) + 1)) { xcd_barrier(xbar, wave); } } while (0)
    const int G = gridDim.x, c = blockIdx.x;

    if (a.ph_hi > NPHASE) cg::this_grid().sync();
    if (IN(0)) { TID_LANE(); p0_prologue<0>(lds, tid, wave, lane, (int)blockIdx.x, (int)gridDim.x); }
    SEAM(0);
    if (IN(1)) {
        unsigned char* ws = karg_ws();
        bf16_t* RA = (bf16_t*)(ws + WS_RA); bf16_t* GB = (bf16_t*)(ws + WS_RG); bf16_t* ER = (bf16_t*)(ws + WS_RG);
        bf16_t* UB = (bf16_t*)(ws + WS_UB); bf16_t* QB = (bf16_t*)(ws + WS_QB); bf16_t* KB = (bf16_t*)(ws + WS_KB); bf16_t* VB = (bf16_t*)(ws + WS_VB);
        bf16_t* MB = (bf16_t*)(ws + WS_MB); bf16_t* MG = (bf16_t*)(ws + WS_MG); bf16_t* ACT = (bf16_t*)(ws + WS_ACT);
        float* SS2 = (float*)(ws + WS_SS2); float* SSE = (float*)(ws + WS_SSE); float* SSO = (float*)(ws + WS_SSO);
        (void)RA; (void)GB; (void)ER; (void)UB; (void)QB; (void)KB; (void)VB; (void)MB; (void)MG; (void)ACT; (void)SS2; (void)SSE; (void)SSO;
        Gemm g{RA, (const bf16_t*)(ws + WS_WIN), MPAD, INC, 1024}; StaticOrder S; S.init(MPAD, INC, G, c);
        EpiIn E{UB, QB, KB, VB, GB, karg_out(), (const float*)(ws + WS_ROPE)};
        gemm_phase<EpiIn, StaticOrder, true, true, 1024>(lds, g, S, E, wave);
        { const int nwg = (MPAD / 256) * (INC / 256), extra = nwg % G;
          TID_LANE(); if (extra == 0) p0_prologue<1>(lds, tid, wave, lane, c, G); else if (c >= extra) p0_prologue<1>(lds, tid, wave, lane, c - extra, G - extra); }
    }
    SEAM(1);
    if (IN(2)) {
        TID_LANE();
        unsigned char* ws = karg_ws();
        bf16_t* RA = (bf16_t*)(ws + WS_RA); bf16_t* GB = (bf16_t*)(ws + WS_RG); bf16_t* ER = (bf16_t*)(ws + WS_RG);
        bf16_t* UB = (bf16_t*)(ws + WS_UB); bf16_t* QB = (bf16_t*)(ws + WS_QB); bf16_t* KB = (bf16_t*)(ws + WS_KB); bf16_t* VB = (bf16_t*)(ws + WS_VB);
        bf16_t* MB = (bf16_t*)(ws + WS_MB); bf16_t* MG = (bf16_t*)(ws + WS_MG); bf16_t* ACT = (bf16_t*)(ws + WS_ACT);
        float* SS2 = (float*)(ws + WS_SS2); float* SSE = (float*)(ws + WS_SSE); float* SSO = (float*)(ws + WS_SSO);
        (void)RA; (void)GB; (void)ER; (void)UB; (void)QB; (void)KB; (void)VB; (void)MB; (void)MG; (void)ACT; (void)SS2; (void)SSE; (void)SSO;
        { const float* const sinks_ = karg_in(11); const float* const ck_ = karg_in(4); const float* const cv_ = karg_in(5); float* const out_ = karg_out();
        attn_prompt_all(lds, QB, KB, VB, RA, sinks_, tid, wave, lane);
        for (int unit = c; unit < 512; unit += G) attn_sample_unit(lds, unit, QB, KB, VB, RA, ck_, cv_, sinks_, out_, tid, wave, lane); }
        pool_items(ws, karg_in(6), tid);
        __syncthreads();
    }
    SEAM(2);
    if (IN(3)) {
        unsigned char* ws = karg_ws();
        bf16_t* RA = (bf16_t*)(ws + WS_RA); bf16_t* GB = (bf16_t*)(ws + WS_RG); bf16_t* ER = (bf16_t*)(ws + WS_RG);
        bf16_t* UB = (bf16_t*)(ws + WS_UB); bf16_t* QB = (bf16_t*)(ws + WS_QB); bf16_t* KB = (bf16_t*)(ws + WS_KB); bf16_t* VB = (bf16_t*)(ws + WS_VB);
        bf16_t* MB = (bf16_t*)(ws + WS_MB); bf16_t* MG = (bf16_t*)(ws + WS_MG); bf16_t* ACT = (bf16_t*)(ws + WS_ACT);
        float* SS2 = (float*)(ws + WS_SS2); float* SSE = (float*)(ws + WS_SSE); float* SSO = (float*)(ws + WS_SSO);
        (void)RA; (void)GB; (void)ER; (void)UB; (void)QB; (void)KB; (void)VB; (void)MB; (void)MG; (void)ACT; (void)SS2; (void)SSE; (void)SSO;
        TID_LANE();
        { const bf16_t* mbs = MB + (size_t)MPR * 512; const bf16_t* ras = RA + (size_t)MPR * DM;
          SMerge2 Em{MG, GB}; skinny_gemm2<512, 1024>(lds, mbs, (const bf16_t*)(ws + WS_WEFF), ras, (const bf16_t*)(ws + WS_WAB), wave, lane, Em); }
        StaticOrder S; S.init(MPR, 1024, G, c);
        { Gemm g{MB, (const bf16_t*)(ws + WS_WEFF), MPR, 1024, 512}; EpiMergeA E{MG, GB}; gemm_phase<EpiMergeA, StaticOrder, true, true, 512>(lds, g, S, E, wave); }
        { Gemm g{RA, (const bf16_t*)(ws + WS_WAB), MPR, 1024, 1024}; EpiMergeB E{MG, GB}; gemm_phase<EpiMergeB, StaticOrder, true, true, 1024>(lds, g, S, E, wave); }
    }
    SEAM(3);
    if (IN(4)) {
        unsigned char* ws = karg_ws();
        bf16_t* RA = (bf16_t*)(ws + WS_RA); bf16_t* GB = (bf16_t*)(ws + WS_RG); bf16_t* ER = (bf16_t*)(ws + WS_RG);
        bf16_t* UB = (bf16_t*)(ws + WS_UB); bf16_t* QB = (bf16_t*)(ws + WS_QB); bf16_t* KB = (bf16_t*)(ws + WS_KB); bf16_t* VB = (bf16_t*)(ws + WS_VB);
        bf16_t* MB = (bf16_t*)(ws + WS_MB); bf16_t* MG = (bf16_t*)(ws + WS_MG); bf16_t* ACT = (bf16_t*)(ws + WS_ACT);
        float* SS2 = (float*)(ws + WS_SS2); float* SSE = (float*)(ws + WS_SSE); float* SSO = (float*)(ws + WS_SSO);
        (void)RA; (void)GB; (void)ER; (void)UB; (void)QB; (void)KB; (void)VB; (void)MB; (void)MG; (void)ACT; (void)SS2; (void)SSE; (void)SSO;
        TID_LANE();
        { SRes1 Es{karg_in(1), RA, SS2}; skinny_gemm<1024>(lds, MG + (size_t)MPR * DM, (const bf16_t*)(ws + WS_WOUT), wave, lane, Es); }
        Gemm g{MG, (const bf16_t*)(ws + WS_WOUT), MPR, 1024, 1024}; StaticOrder S; S.init(MPR, 1024, G, c);
        EpiRes1 E{karg_in(0), RA, SS2};
        gemm_phase<EpiRes1, StaticOrder, true, true, 1024>(lds, g, S, E, wave);
    }
    SEAM(4);
    if (IN(5)) {
        unsigned char* ws = karg_ws();
        bf16_t* RA = (bf16_t*)(ws + WS_RA); bf16_t* GB = (bf16_t*)(ws + WS_RG); bf16_t* ER = (bf16_t*)(ws + WS_RG);
        bf16_t* UB = (bf16_t*)(ws + WS_UB); bf16_t* QB = (bf16_t*)(ws + WS_QB); bf16_t* KB = (bf16_t*)(ws + WS_KB); bf16_t* VB = (bf16_t*)(ws + WS_VB);
        bf16_t* MB = (bf16_t*)(ws + WS_MB); bf16_t* MG = (bf16_t*)(ws + WS_MG); bf16_t* ACT = (bf16_t*)(ws + WS_ACT);
        float* SS2 = (float*)(ws + WS_SS2); float* SSE = (float*)(ws + WS_SSE); float* SSO = (float*)(ws + WS_SSO);
        (void)RA; (void)GB; (void)ER; (void)UB; (void)QB; (void)KB; (void)VB; (void)MB; (void)MG; (void)ACT; (void)SS2; (void)SSE; (void)SSO;
        Gemm g{RA, (const bf16_t*)(ws + WS_WFI), MPAD, 2 * FFH, 1024}; StaticOrder S; S.init(MPAD, 2 * FFH, G, c);
        EpiSwiglu E{ACT, SS2};
        gemm_phase<EpiSwiglu, StaticOrder, true, true, 1024>(lds, g, S, E, wave);
        { const int nwg5 = (MPAD / 256) * (2 * FFH / 256), extra5 = nwg5 % G;
          TailOrder T; T.init(MPR, 1024, G, c, extra5); Gemm gp{(const bf16_t*)(ws + WS_PB), (const bf16_t*)(ws + WS_WPP), MPR, 1024, PLE}; EpiEraw Ee{ER, SSE};
          gemm_phase<EpiEraw, TailOrder, true, true, PLE>(lds, gp, T, Ee, wave); }
    }
    SEAM(5);
    if (IN(6)) {
        unsigned char* ws = karg_ws();
        bf16_t* RA = (bf16_t*)(ws + WS_RA); bf16_t* GB = (bf16_t*)(ws + WS_RG); bf16_t* ER = (bf16_t*)(ws + WS_RG);
        bf16_t* UB = (bf16_t*)(ws + WS_UB); bf16_t* QB = (bf16_t*)(ws + WS_QB); bf16_t* KB = (bf16_t*)(ws + WS_KB); bf16_t* VB = (bf16_t*)(ws + WS_VB);
        bf16_t* MB = (bf16_t*)(ws + WS_MB); bf16_t* MG = (bf16_t*)(ws + WS_MG); bf16_t* ACT = (bf16_t*)(ws + WS_ACT);
        float* SS2 = (float*)(ws + WS_SS2); float* SSE = (float*)(ws + WS_SSE); float* SSO = (float*)(ws + WS_SSO);
        (void)RA; (void)GB; (void)ER; (void)UB; (void)QB; (void)KB; (void)VB; (void)MB; (void)MG; (void)ACT; (void)SS2; (void)SSE; (void)SSO;
        TID_LANE();
        { SRes2Eraw Es{RA, ER, SSE}; skinny_gemm2<FFH, PLE>(lds, ACT + (size_t)MPR * FFH, (const bf16_t*)(ws + WS_WFO), (const bf16_t*)(ws + WS_PB) + (size_t)MPR * PLE, (const bf16_t*)(ws + WS_WPP), wave, lane, Es); }
        StaticOrder S; S.init(MPR, 1024, G, c);
        { Gemm g{ACT, (const bf16_t*)(ws + WS_WFO), MPR, 1024, FFH}; EpiRes2 E{RA}; gemm_phase<EpiRes2, StaticOrder, true, true, FFH>(lds, g, S, E, wave); }
    }
    SEAM(6);
    if (IN(7)) {
        unsigned char* ws = karg_ws();
        bf16_t* RA = (bf16_t*)(ws + WS_RA); bf16_t* GB = (bf16_t*)(ws + WS_RG); bf16_t* ER = (bf16_t*)(ws + WS_RG);
        bf16_t* UB = (bf16_t*)(ws + WS_UB); bf16_t* QB = (bf16_t*)(ws + WS_QB); bf16_t* KB = (bf16_t*)(ws + WS_KB); bf16_t* VB = (bf16_t*)(ws + WS_VB);
        bf16_t* MB = (bf16_t*)(ws + WS_MB); bf16_t* MG = (bf16_t*)(ws + WS_MG); bf16_t* ACT = (bf16_t*)(ws + WS_ACT);
        float* SS2 = (float*)(ws + WS_SS2); float* SSE = (float*)(ws + WS_SSE); float* SSO = (float*)(ws + WS_SSO);
        (void)RA; (void)GB; (void)ER; (void)UB; (void)QB; (void)KB; (void)VB; (void)MB; (void)MG; (void)ACT; (void)SS2; (void)SSE; (void)SSO;
        TID_LANE();
        { SPle Es{ACT, RA, ER, SSE, karg_in(19), SSO}; skinny_gemm<1024>(lds, RA + (size_t)MPR * DM, (const bf16_t*)(ws + WS_WPG), wave, lane, Es); }
        Gemm g{RA, (const bf16_t*)(ws + WS_WPG), MPR, 1024, 1024}; StaticOrder S; S.init(MPR, 1024, G, c);
        EpiPle E{ACT, RA, ER, SSE, karg_in(19), SSO};
        gemm_phase<EpiPle, StaticOrder, true, true, 1024>(lds, g, S, E, wave);
    }
    SEAM(7);
    if (IN(8)) {
        TID_LANE();
        unsigned char* ws = karg_ws();
        bf16_t* RA = (bf16_t*)(ws + WS_RA); bf16_t* GB = (bf16_t*)(ws + WS_RG); bf16_t* ER = (bf16_t*)(ws + WS_RG);
        bf16_t* UB = (bf16_t*)(ws + WS_UB); bf16_t* QB = (bf16_t*)(ws + WS_QB); bf16_t* KB = (bf16_t*)(ws + WS_KB); bf16_t* VB = (bf16_t*)(ws + WS_VB);
        bf16_t* MB = (bf16_t*)(ws + WS_MB); bf16_t* MG = (bf16_t*)(ws + WS_MG); bf16_t* ACT = (bf16_t*)(ws + WS_ACT);
        float* SS2 = (float*)(ws + WS_SS2); float* SSE = (float*)(ws + WS_SSE); float* SSO = (float*)(ws + WS_SSO);
        (void)RA; (void)GB; (void)ER; (void)UB; (void)QB; (void)KB; (void)VB; (void)MB; (void)MG; (void)ACT; (void)SS2; (void)SSE; (void)SSO;
        const float* fn = karg_in(21); float* const out_ = karg_out();
        f32x4 f0[2], f1[2];
#pragma unroll
        for (int hh = 0; hh < 2; ++hh) { f0[hh] = *(const f32x4*)(fn + hh * 512 + lane * 8); f1[hh] = *(const f32x4*)(fn + hh * 512 + lane * 8 + 4); }
        const int gw8 = c * 8 + wave; int mx = gw8 < MSM ? MPR + gw8 : -1;
        for (int m = gw8 * 2; m < MPR || mx >= 0; m += G * 16) {
            const bool hp = m < MPR; u32x4 w[3][2]; int rr[3]; rr[0] = hp ? m : -1; rr[1] = hp ? m + 1 : -1; rr[2] = mx; mx = -1;
#pragma unroll
            for (int r = 0; r < 3; ++r)
#pragma unroll
                for (int hh = 0; hh < 2; ++hh) if (rr[r] >= 0) w[r][hh] = *(const u32x4*)(ACT + (size_t)rr[r] * DM + hh * 512 + lane * 8);
#pragma unroll
            for (int r = 0; r < 3; ++r) if (rr[r] >= 0) { const float rs = row_rs(SSO, rr[r]);
#pragma unroll
                for (int hh = 0; hh < 2; ++hh) { f32x4 v0, v1; unpack8(w[r][hh], v0, v1); float* yp = out_ + (size_t)rr[r] * DM + hh * 512 + lane * 8;
                    __builtin_nontemporal_store(v0 * rs * f0[hh], (f32x4*)yp); __builtin_nontemporal_store(v1 * rs * f1[hh], (f32x4*)(yp + 4)); } }
        }
        for (int r = gw8 + G * 8; r < MSM; r += G * 8) { const int row = MPR + r; const float rs = row_rs(SSO, row);
#pragma unroll
            for (int hh = 0; hh < 2; ++hh) { f32x4 v0, v1; unpack8(*(const u32x4*)(ACT + (size_t)row * DM + hh * 512 + lane * 8), v0, v1); float* yp = out_ + (size_t)row * DM + hh * 512 + lane * 8;
                *(f32x4*)yp = v0 * rs * f0[hh]; *(f32x4*)(yp + 4) = v1 * rs * f1[hh]; } }
    }
#undef IN
#undef SEAM
}

extern "C" void kernel_launch(void* const* d_in, const int* in_sizes, int n_in, void* d_out, int out_size, void* d_ws, size_t ws_size, hipStream_t stream) {
    static int grid = 0;
    if (grid == 0) {
        if (n_in != 22 || out_size != (int)O_END || ws_size < WS_END) { fprintf(stderr, "kernel_launch: unexpected sizes: n_in %d out %d ws %zu (need %zu)\n", n_in, out_size, ws_size, (size_t)WS_END); grid = -1; return; }
        int dev = 0, cus = 0, per_cu = 0;
        hipGetDevice(&dev); hipDeviceGetAttribute(&cus, hipDeviceAttributeMultiprocessorCount, dev);
        if (hipFuncSetAttribute((const void*)fwd_kernel, hipFuncAttributeMaxDynamicSharedMemorySize, LDS_BYTES) != hipSuccess) { fprintf(stderr, "kernel_launch: hipFuncSetAttribute failed\n"); grid = -1; return; }
        if (hipOccupancyMaxActiveBlocksPerMultiprocessor(&per_cu, (const void*)fwd_kernel, 512, LDS_BYTES) != hipSuccess || per_cu < 1) { fprintf(stderr, "kernel_launch: occupancy query failed (%d)\n", per_cu); grid = -1; return; }
        grid = cus * per_cu;
        fprintf(stderr, "kernel_launch: cus %d per_cu %d grid %d\n", cus, per_cu, grid);
    }
    if (grid < 0) return;
    Args a{};
    for (int i = 0; i < 22; ++i) a.in[i] = (const float*)d_in[i];
    a.out = (float*)d_out; a.ws = (unsigned char*)d_ws;
#if N_LAUNCH == 1
    if (hipMemsetAsync((char*)d_ws + WS_BAR, 0, BAR_BYTES, stream) != hipSuccess) { fprintf(stderr, "kernel_launch: memset failed\n"); return; }
    a.ph_lo = 0; a.ph_hi = NPHASE;
    void* args[] = {&a};
    hipError_t e = hipLaunchCooperativeKernel((const void*)fwd_kernel, dim3(grid), dim3(512), args, LDS_BYTES, stream);
    if (e != hipSuccess) fprintf(stderr, "cooperative launch failed: %s (grid %d)\n", hipGetErrorString(e), grid);
#else
    for (int p = 0; p < NPHASE; ++p) { a.ph_lo = p; a.ph_hi = p + 1; hipLaunchKernelGGL(fwd_kernel, dim3(grid), dim3(512), LDS_BYTES, stream, a); }
#endif
}
```

```cpp
#include <hip/hip_runtime.h>
#include <hip/hip_cooperative_groups.h>
#include <cstdio>
#include <cstdint>
namespace cg = cooperative_groups;
namespace pg8 {
#define PG8_LAS __attribute__((address_space(3)))
typedef unsigned short bf16_t;
typedef short bf16x8 __attribute__((ext_vector_type(8)));
typedef float f32x4 __attribute__((ext_vector_type(4)));
typedef unsigned u32x4 __attribute__((ext_vector_type(4)));
constexpr int BM = 256, BK = 64, HALF = 128, HTB = HALF * BK * 2  , STAGE_BYTES = 8 * HTB, NXCD = 8, WGM = 8;

__host__ __device__ __forceinline__ int lds_byte(int r, int c) { const int st = (r >> 4) * 2 + (c >> 5), rr = r & 15, cc = c & 31, ob = rr * 64 + cc * 2; return st * 1024 + (ob ^ (((ob >> 9) & 1) << 5)); }
__host__ __device__ __forceinline__ void stage_rc(int b, int& R, int& C) { const int st = b / 1024, sb = b % 1024, swz = sb ^ (((sb >> 9) & 1) << 5); R = (st >> 1) * 16 + swz / 64; C = (st & 1) * 32 + (swz % 64) / 2; }
__host__ __device__ __forceinline__ int perm32(int rho) { const int n = rho >> 4, i = rho & 15; return 8 * (i >> 2) + 4 * n + (i & 3); }

struct Unit { int pm, pn; };
struct Gemm { const bf16_t* A; const bf16_t* Bt; int M, N, K; };

struct StaticOrder {
    int nM, nN, nwg, G, c;
    __host__ __device__ void init(int M, int N, int G_, int c_) { nM = M / BM; nN = N / BM; nwg = nM * nN; G = G_; c = c_; }
    __host__ __device__ bool next(int i, Unit& u) const {
        const long L = (long)i * G + c; if (L >= nwg) return false;
        int wgid = (int)L; { const int q = nwg / NXCD, r = nwg % NXCD, xcd = wgid % NXCD, off = wgid / NXCD; wgid = (xcd < r ? xcd * (q + 1) : r * (q + 1) + (xcd - r) * q) + off; }
        const int nig = WGM * nN, gid = wgid / nig, fm = gid * WGM, gsz = (nM - fm) < WGM ? (nM - fm) : WGM;
        u.pm = fm + ((wgid % nig) % gsz); u.pn = (wgid % nig) / gsz; return true;
    }
    __device__ __forceinline__ void a_ready(const Unit&) const {}
    __device__ __forceinline__ void done(const Unit&) const {}
};

struct TailOrder {
    int nwg, first, cnt, c;
    __host__ __device__ void init(int M, int N, int G_, int c_, int first_) { nwg = (M / BM) * (N / BM); first = first_ < G_ ? first_ : 0; cnt = G_ - first; c = c_; }
    __host__ __device__ bool next(int i, Unit& u) const {
        if (c < first) return false; const int t = (c - first) + i * cnt; if (t >= nwg) return false;
        u.pm = t >> 2; u.pn = t & 3; return true;
    }
    __device__ __forceinline__ void a_ready(const Unit&) const {}
    __device__ __forceinline__ void done(const Unit&) const {}
};

__device__ __forceinline__ unsigned cvt_pk_bf16(float lo, float hi) { unsigned r; asm volatile("s_nop 0\n\tv_cvt_pk_bf16_f32 %0, %1, %2" : "=v"(r) : "v"(lo), "v"(hi)); return r; }
typedef float f32x2_cv __attribute__((ext_vector_type(2))); typedef __bf16 bf16x2_cv __attribute__((ext_vector_type(2)));
__device__ __forceinline__ unsigned cvt_pk_bf16_v(float lo, float hi) { const f32x2_cv v = {lo, hi}; const bf16x2_cv b = __builtin_convertvector(v, bf16x2_cv); return __builtin_bit_cast(unsigned, b); }
typedef float f32x2 __attribute__((ext_vector_type(2)));

constexpr int DM = 1024, SEQ = 8192, MPR = 16384, MSM = 128, MREAL = MPR + MSM, MPAD = 16640;
constexpr int INC = 4096, FFH = 2816, PLE = 256;
constexpr float EPS = 1e-6f;
constexpr size_t O_Y = 0, O_NKP = (size_t)MREAL * DM, O_NVP = O_NKP + 65536, O_NPP = O_NVP + 65536, O_NKS = O_NPP + 15360, O_NVS = O_NKS + 4194304, O_NPS = O_NVS + 4194304, O_END = O_NPS + 983040;

typedef unsigned u32x2 __attribute__((ext_vector_type(2)));
__device__ __forceinline__ float bflo(unsigned w) { return __builtin_bit_cast(float, w << 16); }
__device__ __forceinline__ float bfhi(unsigned w) { return __builtin_bit_cast(float, w & 0xffff0000u); }
__device__ __forceinline__ u32x4 pack8(const f32x4 a, const f32x4 b) { u32x4 w; w.x = cvt_pk_bf16(a[0], a[1]); w.y = cvt_pk_bf16(a[2], a[3]); w.z = cvt_pk_bf16(b[0], b[1]); w.w = cvt_pk_bf16(b[2], b[3]); return w; }
__device__ __forceinline__ u32x4 pack8v(const f32x4 a, const f32x4 b) { u32x4 w; w.x = cvt_pk_bf16_v(a[0], a[1]); w.y = cvt_pk_bf16_v(a[2], a[3]); w.z = cvt_pk_bf16_v(b[0], b[1]); w.w = cvt_pk_bf16_v(b[2], b[3]); return w; }
__device__ __forceinline__ void unpack8(const u32x4 w, f32x4& a, f32x4& b) { a = (f32x4){bflo(w.x), bfhi(w.x), bflo(w.y), bfhi(w.y)}; b = (f32x4){bflo(w.z), bfhi(w.z), bflo(w.w), bfhi(w.w)}; }
__device__ __forceinline__ float sigm(float x) { return __builtin_amdgcn_rcpf(1.0f + __expf(-x)); }
__device__ __forceinline__ f32x4 sigm4(const f32x4 x) { return (f32x4){sigm(x[0]), sigm(x[1]), sigm(x[2]), sigm(x[3])}; }
__device__ __forceinline__ float sum4(const f32x4 x) { return (x[0] + x[1]) + (x[2] + x[3]); }
__device__ __forceinline__ float row_rs(const float* ss, int row) {
    if (row < MPR) { const f32x4* p = (const f32x4*)(ss + (size_t)row * 16); const f32x4 a = p[0], b = p[1], c = p[2], d = p[3];
        return rsqrtf(((sum4(a) + sum4(b)) + (sum4(c) + sum4(d))) * (1.0f / DM) + EPS); }
    const f32x4* p = (const f32x4*)(ss + (size_t)MPR * 16 + (size_t)(row - MPR) * 64); f32x4 t = p[0];
#pragma unroll
    for (int i = 1; i < 16; ++i) t += p[i];
    return rsqrtf(sum4(t) * (1.0f / DM) + EPS);
}
#define EPI_ROW(ai, m) (u.pm * BM + (ai) * HALF + wr * 64 + (m) * 16 + fr)
#define EPI_LOOP_AM _Pragma("unroll") for (int ai = 0; ai < 2; ++ai) _Pragma("unroll") for (int m = 0; m < 4; ++m)
#define EPI_LOOP_BJ _Pragma("unroll") for (int bj = 0; bj < 2; ++bj)

struct EpiIn {
    static constexpr bool PERM = true, AFTER_DRAIN = false;
    bf16_t *ub, *qb, *kb, *vb, *gb; float* out; const float* rope;
    __device__ __forceinline__ void operator()(const f32x4 (&acc)[2][2][4][2], const Unit& u, int wr, int wc, int fr, int fq) const {
        const int colt = u.pn * BM, cw = wc * 32 + 8 * fq;
        const bool tail = (u.pm == 31) || (u.pm == 63) || (u.pm == 64);
        EPI_LOOP_AM {
            const int row = EPI_ROW(ai, m);
            if (colt >= 2048) {
                EPI_LOOP_BJ { const int col = colt - 2048 + bj * HALF + cw; *(u32x4*)(gb + (size_t)row * 2048 + col) = pack8v(sigm4(acc[ai][bj][m][0]), sigm4(acc[ai][bj][m][1])); }
            } else if (colt < 512) {
                EPI_LOOP_BJ { const int col = colt + bj * HALF + cw; const f32x4 v0 = acc[ai][bj][m][0], v1 = acc[ai][bj][m][1];
                    *(u32x4*)(ub + (size_t)row * 512 + col) = pack8(v0, v1);
                    if (tail) { float* dst = nullptr;
                        if (row >= MPR) { if (row < MREAL) dst = out + O_NPS + ((size_t)(row - MPR) * 15 + 14) * 512 + col; }
                        else { const int t = row & (SEQ - 1); if (t >= SEQ - 15) dst = out + O_NPP + ((size_t)(row >> 13) * 15 + (t - (SEQ - 15))) * 512 + col; }
                        if (dst) { *(f32x4*)dst = v0; *(f32x4*)(dst + 4) = v1; } } }
            } else if (colt < 1792) {
                const bool isq = colt < 1536;
                const int pidx = row < MPR ? (row & (SEQ - 1)) : SEQ;
                EPI_LOOP_BJ { f32x4 v0 = acc[ai][bj][m][0], v1 = acc[ai][bj][m][1];
                    if ((wc & 1) == 0) {
                        f32x4 p0, p1;
#pragma unroll
                        for (int j = 0; j < 4; ++j) { p0[j] = __shfl_xor(v0[j], 16); p1[j] = __shfl_xor(v1[j], 16); }
                        if (fq < 2) { const f32x4* rp = (const f32x4*)(rope + (size_t)pidx * 16); const f32x4 c0 = rp[0], c1 = rp[1]; f32x4 s0 = rp[2], s1 = rp[3];
                            if (fq == 0) { s0 = -s0; s1 = -s1; }
                            v0 = v0 * c0 + p0 * s0; v1 = v1 * c1 + p1 * s1; }
                    }
                    if (isq) { v0 = v0 * 0.125f; v1 = v1 * 0.125f; *(u32x4*)(qb + (size_t)row * 1024 + (colt - 512) + bj * HALF + cw) = pack8(v0, v1); }
                    else { const int col = bj * HALF + cw; *(u32x4*)(kb + (size_t)row * 256 + col) = pack8(v0, v1);
                        if (tail) { float* dst = nullptr;
                            if (row >= MPR) { if (row < MREAL) dst = out + O_NKS + ((size_t)(row - MPR) * 128 + 127) * 256 + col; }
                            else { const int t = row & (SEQ - 1); if (t >= SEQ - 128) dst = out + O_NKP + ((size_t)(row >> 13) * 128 + (t - (SEQ - 128))) * 256 + col; }
                            if (dst) { *(f32x4*)dst = v0; *(f32x4*)(dst + 4) = v1; } } } }
            } else {
                EPI_LOOP_BJ { const int col = bj * HALF + cw; const f32x4 v0 = acc[ai][bj][m][0], v1 = acc[ai][bj][m][1];
                    *(u32x4*)(vb + (size_t)row * 256 + col) = pack8(v0, v1);
                    if (tail) { float* dst = nullptr;
                        if (row >= MPR) { if (row < MREAL) dst = out + O_NVS + ((size_t)(row - MPR) * 128 + 127) * 256 + col; }
                        else { const int t = row & (SEQ - 1); if (t >= SEQ - 128) dst = out + O_NVP + ((size_t)(row >> 13) * 128 + (t - (SEQ - 128))) * 256 + col; }
                        if (dst) { *(f32x4*)dst = v0; *(f32x4*)(dst + 4) = v1; } } }
            }
        }
    }
};
struct EpiMergeA {
    static constexpr bool PERM = true, AFTER_DRAIN = false;
    bf16_t* mg; const bf16_t* gb;
    __device__ __forceinline__ void operator()(const f32x4 (&acc)[2][2][4][2], const Unit& u, int wr, int wc, int fr, int fq) const {
        const int cw = u.pn * BM + wc * 32 + 8 * fq;
        EPI_LOOP_AM { const int row = EPI_ROW(ai, m);
            EPI_LOOP_BJ { const int col = cw + bj * HALF; f32x4 g0, g1; unpack8(*(const u32x4*)(gb + (size_t)row * 2048 + col), g0, g1);
                *(u32x4*)(mg + (size_t)row * DM + col) = pack8(g0 * acc[ai][bj][m][0], g1 * acc[ai][bj][m][1]); } }
    }
};
struct EpiMergeB {
    static constexpr bool PERM = true, AFTER_DRAIN = false;
    bf16_t* mg; const bf16_t* gb;
    __device__ __forceinline__ void operator()(const f32x4 (&acc)[2][2][4][2], const Unit& u, int wr, int wc, int fr, int fq) const {
        const int cw = u.pn * BM + wc * 32 + 8 * fq;
        EPI_LOOP_AM { const int row = EPI_ROW(ai, m);
            EPI_LOOP_BJ { const int col = cw + bj * HALF; f32x4 g0, g1, t0, t1; unpack8(*(const u32x4*)(gb + (size_t)row * 2048 + 1024 + col), g0, g1);
                unpack8(*(const u32x4*)(mg + (size_t)row * DM + col), t0, t1);
                *(u32x4*)(mg + (size_t)row * DM + col) = pack8(t0 + g0 * acc[ai][bj][m][0], t1 + g1 * acc[ai][bj][m][1]); } }
    }
};
struct EpiRes1 {
    static constexpr bool PERM = true, AFTER_DRAIN = false;
    const float *xp; bf16_t* hb; float* ss;
    __device__ __forceinline__ void operator()(const f32x4 (&acc)[2][2][4][2], const Unit& u, int wr, int wc, int fr, int fq) const {
        const int cw = u.pn * BM + wc * 32 + 8 * fq;
        EPI_LOOP_AM { const int row = EPI_ROW(ai, m); const float* xr = xp + (size_t)row * DM; float q = 0.f;
            EPI_LOOP_BJ { const int col = cw + bj * HALF; const f32x4 v0 = acc[ai][bj][m][0] + __builtin_nontemporal_load((const f32x4*)(xr + col)), v1 = acc[ai][bj][m][1] + __builtin_nontemporal_load((const f32x4*)(xr + col + 4));
                q += sum4(v0 * v0) + sum4(v1 * v1);
                *(u32x4*)(hb + (size_t)row * DM + col) = pack8(v0, v1); }
            q += __shfl_xor(q, 16); q += __shfl_xor(q, 32);
            if (fq == 0) ss[(size_t)row * 16 + u.pn * 4 + wc] = q; }
    }
};
struct EpiSwiglu {
    static constexpr bool PERM = true, AFTER_DRAIN = false;
    bf16_t* act; const float* ss;
    __device__ __forceinline__ void operator()(const f32x4 (&acc)[2][2][4][2], const Unit& u, int wr, int wc, int fr, int fq) const {
        const int cw = u.pn * 128 + wc * 16 + 4 * fq;
        EPI_LOOP_AM { const int row = EPI_ROW(ai, m); const float rs = row_rs(ss, row);
            EPI_LOOP_BJ { const f32x4 g = acc[ai][bj][m][0] * rs, up = acc[ai][bj][m][1] * rs; const f32x4 a = g * sigm4(g) * up;
                u32x2 w; w.x = cvt_pk_bf16(a[0], a[1]); w.y = cvt_pk_bf16(a[2], a[3]);
                *(u32x2*)(act + (size_t)row * FFH + cw + bj * 64) = w; } }
    }
};
struct EpiRes2 {
    static constexpr bool PERM = true, AFTER_DRAIN = false;
    bf16_t* hb;
    __device__ __forceinline__ void operator()(const f32x4 (&acc)[2][2][4][2], const Unit& u, int wr, int wc, int fr, int fq) const {
        const int cw = u.pn * BM + wc * 32 + 8 * fq;
        EPI_LOOP_AM { const int row = EPI_ROW(ai, m);
            EPI_LOOP_BJ { bf16_t* hp = hb + (size_t)row * DM + cw + bj * HALF; f32x4 h0, h1; unpack8(*(const u32x4*)hp, h0, h1);
                *(u32x4*)hp = pack8(h0 + acc[ai][bj][m][0], h1 + acc[ai][bj][m][1]); } }
    }
};
struct EpiEraw {
    static constexpr bool PERM = true, AFTER_DRAIN = false;
    bf16_t* er; float* ss;
    __device__ __forceinline__ void operator()(const f32x4 (&acc)[2][2][4][2], const Unit& u, int wr, int wc, int fr, int fq) const {
        const int cw = u.pn * BM + wc * 32 + 8 * fq;
        EPI_LOOP_AM { const int row = EPI_ROW(ai, m); float q = 0.f;
            EPI_LOOP_BJ { const int col = cw + bj * HALF; const f32x4 v0 = acc[ai][bj][m][0], v1 = acc[ai][bj][m][1];
                q += sum4(v0 * v0) + sum4(v1 * v1); *(u32x4*)(er + (size_t)row * DM + col) = pack8(v0, v1); }
            q += __shfl_xor(q, 16); q += __shfl_xor(q, 32);
            if (fq == 0) ss[(size_t)row * 16 + u.pn * 4 + wc] = q; }
    }
};
struct EpiPle {
    static constexpr bool PERM = true, AFTER_DRAIN = false;
    bf16_t* ob; const bf16_t* hb; const bf16_t* er; const float *sse, *pn; float* sso;
    __device__ __forceinline__ void operator()(const f32x4 (&acc)[2][2][4][2], const Unit& u, int wr, int wc, int fr, int fq) const {
        const int cw = u.pn * BM + wc * 32 + 8 * fq;
        EPI_LOOP_AM { const int row = EPI_ROW(ai, m); const float rs = row_rs(sse, row); float q = 0.f;
            EPI_LOOP_BJ { const int col = cw + bj * HALF; f32x4 e0, e1, h0, h1; unpack8(*(const u32x4*)(er + (size_t)row * DM + col), e0, e1); unpack8(*(const u32x4*)(hb + (size_t)row * DM + col), h0, h1);
                const f32x4 n0 = *(const f32x4*)(pn + col), n1 = *(const f32x4*)(pn + col + 4);
                const f32x4 v0 = h0 + sigm4(acc[ai][bj][m][0]) * (e0 * rs * n0), v1 = h1 + sigm4(acc[ai][bj][m][1]) * (e1 * rs * n1);
                *(u32x4*)(ob + (size_t)row * DM + col) = pack8(v0, v1);
                q += sum4(v0 * v0) + sum4(v1 * v1); }
            q += __shfl_xor(q, 16); q += __shfl_xor(q, 32);
            if (fq == 0) sso[(size_t)row * 16 + u.pn * 4 + wc] = q; }
    }
};
template <class Epi, class Sched, bool ALIGN_EPI = false, bool SP2 = false, int KC = 0>
__device__ __forceinline__ void gemm_phase(PG8_LAS unsigned char* lds, const Gemm g, const Sched& S, const Epi& E, const int wave_s) {
    int lane_ = (int)__builtin_amdgcn_mbcnt_hi(~0u, __builtin_amdgcn_mbcnt_lo(~0u, 0u)); asm volatile("" : "+v"(lane_));
    const int wid = wave_s, lane = lane_, tid = wid * 64 + lane, wr = wid >> 2, wc = wid & 3, fr = lane & 15, fq = lane >> 4;
    const int K = KC > 0 ? KC : g.K, nt = K / BK;
    unsigned voffA[2], voffB[2];
#pragma unroll
    for (int i = 0; i < 2; ++i) { int R, C; stage_rc(tid * 16 + i * 8192, R, C); const int Rb = Epi::PERM ? ((R & ~31) + perm32(R & 31)) : R;
        voffA[i] = (unsigned)(R * K + C) * 2u; voffB[i] = (unsigned)(Rb * K + C) * 2u; }
    const size_t kstep = (size_t)(BK * 2);
    const size_t hstep = (size_t)HALF * K * 2;
    const size_t tstep = 2 * hstep;
    const unsigned ldsw = (unsigned)wid * 1024u;
    const int aoff = lds_byte(wr * 64 + fr, fq * 8), boff = lds_byte(wc * 32 + fr, fq * 8);
#define PG8_SA(b, h) (((b) * 2 + (h)) * HTB)
#define PG8_SB(b, h) ((4 + (b) * 2 + (h)) * HTB)
#define PG8_STAGE(bufoff, gbase, voff) do { _Pragma("unroll") for (int _i = 0; _i < 2; ++_i) \
        __builtin_amdgcn_global_load_lds((const unsigned*)((const char*)(gbase) + (voff)[_i]), (PG8_LAS unsigned*)(lds + (bufoff) + ldsw + _i * 8192), 16, 0, 0); } while (0)
#define PG8_LDA(dst, b, h) do { _Pragma("unroll") for (int m = 0; m < 4; ++m) _Pragma("unroll") for (int k = 0; k < 2; ++k) dst[m][k] = *(const PG8_LAS bf16x8*)(lds + PG8_SA(b, h) + aoff + m * 2048 + k * 1024); } while (0)
#define PG8_LDB(dst, b, h) do { _Pragma("unroll") for (int n = 0; n < 2; ++n) _Pragma("unroll") for (int k = 0; k < 2; ++k) dst[n][k] = *(const PG8_LAS bf16x8*)(lds + PG8_SB(b, h) + boff + n * 2048 + k * 1024); } while (0)
#define PG8_MMA(ai, bj, At, Bt) do { __builtin_amdgcn_s_setprio(1); _Pragma("unroll") for (int m = 0; m < 4; ++m) _Pragma("unroll") for (int n = 0; n < 2; ++n) _Pragma("unroll") for (int k = 0; k < 2; ++k) \
        acc[ai][bj][m][n] = __builtin_amdgcn_mfma_f32_16x16x32_bf16(Bt[n][k], At[m][k], acc[ai][bj][m][n], 0, 0, 0); __builtin_amdgcn_s_setprio(0); } while (0)
#define PG8_WAIT_V(n) asm volatile("s_waitcnt vmcnt(" #n ")" ::: "memory")
#define PG8_WAIT_L(n) asm volatile("s_waitcnt lgkmcnt(" #n ")" ::: "memory")
#define PG8_BAR __builtin_amdgcn_s_barrier()
#define PG8_SCHED __builtin_amdgcn_sched_barrier(0)
    Unit cur, nxt; int ui = 0;
    if (!S.next(0, cur)) return;
    f32x4 acc[2][2][4][2];
#pragma unroll
    for (int a = 0; a < 2; ++a)
#pragma unroll
        for (int b = 0; b < 2; ++b)
#pragma unroll
            for (int m = 0; m < 4; ++m)
#pragma unroll
                for (int n = 0; n < 2; ++n) acc[a][b][m][n] = (f32x4){0.f, 0.f, 0.f, 0.f};
    bf16x8 At[4][2], B0[2][2], B1[2][2];
    const char* cA = (const char*)g.A + (size_t)cur.pm * tstep; const char* cB = (const char*)g.Bt + (size_t)cur.pn * tstep;
    S.a_ready(cur);
    if constexpr (SP2) {
        PG8_STAGE(PG8_SB(0, 0), cB, voffB); PG8_STAGE(PG8_SB(0, 1), cB + hstep, voffB); PG8_STAGE(PG8_SA(0, 0), cA, voffA); PG8_STAGE(PG8_SA(0, 1), cA + hstep, voffA);
        if (wr == 1) PG8_BAR;
        PG8_WAIT_V(2); PG8_BAR;
        PG8_STAGE(PG8_SB(1, 0), cB + kstep, voffB); PG8_STAGE(PG8_SA(1, 0), cA + kstep, voffA); PG8_STAGE(PG8_SB(1, 1), cB + hstep + kstep, voffB);
        PG8_WAIT_V(6); PG8_BAR;
    } else {
        PG8_STAGE(PG8_SB(0, 0), cB, voffB); PG8_STAGE(PG8_SA(0, 0), cA, voffA); PG8_STAGE(PG8_SB(0, 1), cB + hstep, voffB); PG8_STAGE(PG8_SA(0, 1), cA + hstep, voffA);
        if (wr == 1) PG8_BAR;
        PG8_WAIT_V(4); PG8_BAR;
        PG8_STAGE(PG8_SB(1, 0), cB + kstep, voffB); PG8_STAGE(PG8_SA(1, 0), cA + kstep, voffA); PG8_STAGE(PG8_SB(1, 1), cB + hstep + kstep, voffB);
        PG8_WAIT_V(6); PG8_BAR;
    }
    for (;;) {
        const bool has_next = S.next(ui + 1, nxt);
        const char* nA = has_next ? (const char*)g.A + (size_t)nxt.pm * tstep : cA; const char* nB = has_next ? (const char*)g.Bt + (size_t)nxt.pn * tstep : cB;
        for (int t = 0; t < nt; t += 2) {
            const bool last = (t == nt - 2);
            const char* a1 = cA + (size_t)(t + 1) * kstep;
            const char* a2 = last ? nA : cA + (size_t)(t + 2) * kstep; const char* b2 = last ? nB : cB + (size_t)(t + 2) * kstep;
            const char* a3 = a2 + kstep; const char* b3 = b2 + kstep;
            if (last && has_next) S.a_ready(nxt);
            if constexpr (SP2) {
            PG8_LDB(B0, 0, 0); PG8_LDB(B1, 0, 1); PG8_SCHED; PG8_LDA(At, 0, 0); PG8_STAGE(PG8_SA(1, 1), a1 + hstep, voffA);
            PG8_WAIT_V(8); PG8_WAIT_L(0); PG8_BAR; PG8_MMA(0, 0, At, B0); PG8_MMA(0, 1, At, B1); PG8_BAR; PG8_SCHED;
            PG8_LDA(At, 0, 1); PG8_STAGE(PG8_SB(0, 0), b2, voffB); PG8_STAGE(PG8_SB(0, 1), b2 + hstep, voffB); PG8_STAGE(PG8_SA(0, 0), a2, voffA);
            PG8_WAIT_V(8); PG8_WAIT_L(0); PG8_BAR; PG8_MMA(1, 0, At, B0); PG8_MMA(1, 1, At, B1); PG8_BAR; PG8_SCHED;
            PG8_LDB(B0, 1, 0); PG8_LDB(B1, 1, 1); PG8_SCHED; PG8_LDA(At, 1, 0); PG8_STAGE(PG8_SA(0, 1), a2 + hstep, voffA);
            PG8_WAIT_V(8); PG8_WAIT_L(0); PG8_BAR; PG8_MMA(0, 0, At, B0); PG8_MMA(0, 1, At, B1); PG8_BAR; PG8_SCHED;
            PG8_LDA(At, 1, 1); PG8_STAGE(PG8_SB(1, 0), b3, voffB); PG8_STAGE(PG8_SB(1, 1), b3 + hstep, voffB); PG8_STAGE(PG8_SA(1, 0), a3, voffA);
            PG8_WAIT_V(8); PG8_WAIT_L(0); PG8_BAR; PG8_MMA(1, 0, At, B0); PG8_MMA(1, 1, At, B1); PG8_BAR; PG8_SCHED;
            } else {
            PG8_LDB(B0, 0, 0); PG8_SCHED; PG8_LDA(At, 0, 0); PG8_STAGE(PG8_SA(1, 1), a1 + hstep, voffA);
            PG8_WAIT_L(8); PG8_BAR; PG8_WAIT_L(0); PG8_MMA(0, 0, At, B0); PG8_BAR; PG8_SCHED;
            PG8_LDB(B1, 0, 1); PG8_STAGE(PG8_SB(0, 0), b2, voffB);
            PG8_BAR; PG8_WAIT_L(0); PG8_MMA(0, 1, At, B1); PG8_BAR;
            PG8_LDA(At, 0, 1); PG8_STAGE(PG8_SA(0, 0), a2, voffA);
            PG8_BAR; PG8_WAIT_L(0); PG8_MMA(1, 0, At, B0); PG8_BAR; PG8_SCHED;
            PG8_STAGE(PG8_SB(0, 1), b2 + hstep, voffB);
            PG8_WAIT_V(6); PG8_BAR; PG8_MMA(1, 1, At, B1); PG8_BAR;
            PG8_LDB(B0, 1, 0); PG8_SCHED; PG8_LDA(At, 1, 0); PG8_STAGE(PG8_SA(0, 1), a2 + hstep, voffA);
            PG8_WAIT_L(8); PG8_BAR; PG8_WAIT_L(0); PG8_MMA(0, 0, At, B0); PG8_BAR; PG8_SCHED;
            PG8_LDB(B1, 1, 1); PG8_STAGE(PG8_SB(1, 0), b3, voffB);
            PG8_BAR; PG8_WAIT_L(0); PG8_MMA(0, 1, At, B1); PG8_BAR;
            PG8_LDA(At, 1, 1); PG8_STAGE(PG8_SA(1, 0), a3, voffA);
            PG8_BAR; PG8_WAIT_L(0); PG8_MMA(1, 0, At, B0); PG8_BAR; PG8_SCHED;
            PG8_STAGE(PG8_SB(1, 1), b3 + hstep, voffB);
            PG8_WAIT_V(6); PG8_BAR; PG8_MMA(1, 1, At, B1); PG8_BAR;
            }
        }
        if constexpr (ALIGN_EPI) { if (wr == 0) PG8_BAR; }
        if constexpr (!Epi::AFTER_DRAIN) { E(acc, cur, wr, wc, fr, fq); S.done(cur); }
        if (!has_next) break;
#pragma unroll
        for (int a = 0; a < 2; ++a)
#pragma unroll
            for (int b = 0; b < 2; ++b)
#pragma unroll
                for (int m = 0; m < 4; ++m)
#pragma unroll
                    for (int n = 0; n < 2; ++n) acc[a][b][m][n] = (f32x4){0.f, 0.f, 0.f, 0.f};
        cur = nxt; cA = nA; cB = nB; ++ui;
        if constexpr (ALIGN_EPI) { if (wr == 1) PG8_BAR; }
    }
    PG8_WAIT_V(0);
    if constexpr (!ALIGN_EPI) { if (wr == 0) PG8_BAR; }
    PG8_BAR;
    if constexpr (Epi::AFTER_DRAIN) { E.fused(acc, cur, wr, wc, fr, fq, lds, wid, lane); S.done(cur); }
#undef PG8_SA
#undef PG8_SB
#undef PG8_STAGE
#undef PG8_LDA
#undef PG8_LDB
#undef PG8_MMA
#undef PG8_WAIT_V
#undef PG8_WAIT_L
#undef PG8_BAR
#undef PG8_SCHED
}
}

using namespace pg8;
#define LAS __attribute__((address_space(3)))
typedef short s16x4 __attribute__((ext_vector_type(4)));
#ifndef N_LAUNCH
#define N_LAUNCH 1
#endif
constexpr int NPHASE = 9;
constexpr int LDS_BYTES = 135168;
constexpr size_t MiB = 1u << 20;
constexpr size_t WS_SS2 = 0, WS_SSE = 1310720, WS_SSO = 2621440, WS_ROPE = 3932160;
constexpr size_t WS_WIN = 6 * MiB, WS_WEFF = 14 * MiB, WS_WAB = 15 * MiB, WS_WOUT = 17 * MiB, WS_WFI = 19 * MiB, WS_WFO = 30 * MiB, WS_WPP = 35 * MiB + 524288, WS_WPG = 36 * MiB;
constexpr size_t WS_PB = 38 * MiB;
constexpr size_t WS_RA = 47 * MiB;
constexpr size_t WS_RG = 80 * MiB;
constexpr size_t WS_UB = 145 * MiB, WS_QB = 161 * MiB + 262144, WS_KB = 193 * MiB + 786432, WS_VB = 201 * MiB + 917504, WS_MB = 210 * MiB;
constexpr size_t WS_MG = WS_QB;
constexpr size_t WS_ACT = 145 * MiB;
constexpr size_t WS_END = 256 * MiB;
static_assert(WS_UB + (size_t)MPAD * 512 * 2 == WS_QB && WS_QB + (size_t)MPAD * 1024 * 2 == WS_KB && WS_KB + (size_t)MPAD * 256 * 2 == WS_VB && WS_VB + (size_t)MPAD * 256 * 2 == WS_MB, "ws map");
static_assert(WS_MB + (size_t)MPAD * 512 * 2 <= WS_END && WS_ACT + (size_t)MPAD * FFH * 2 <= WS_END && WS_RA + (size_t)MPAD * 2048 <= WS_RG && WS_RG + (size_t)MPAD * 4096 <= WS_UB && WS_PB + (size_t)MPAD * 512 <= WS_RA, "ws map 2");
static_assert(WS_ROPE + 8193 * 64 <= WS_WIN && (size_t)MPAD * 64 <= WS_SSE, "ws map 3");

__device__ const float ROPE_INV[8] = {1.0f, 0.19392274474868576f, 0.03760603093086393f, 0.007292664737217109f, 0.001414213562373095f, 0.0002742481756762073f, 5.318295896944988e-05f, 1.031338537721246e-05f};

__device__ __forceinline__ unsigned f2bf(float f) { unsigned u = __builtin_bit_cast(unsigned, f); return (u + 0x7fffu + ((u >> 16) & 1u)) >> 16; }
__device__ __forceinline__ unsigned pk2(float lo, float hi) { return f2bf(lo) | (f2bf(hi) << 16); }
__device__ __forceinline__ float wave_sum(float v) {
#pragma unroll
    for (int o = 1; o < 64; o <<= 1) v += __shfl_xor(v, o);
    return v;
}
__device__ __forceinline__ float wave_max(float v) {
#pragma unroll
    for (int o = 1; o < 64; o <<= 1) v = fmaxf(v, __shfl_xor(v, o));
    return v;
}
#define LDS_WAIT() asm volatile("s_waitcnt lgkmcnt(0)" ::: "memory")

struct Args { const float* in[22]; float* out; unsigned char* ws; int ph_lo, ph_hi; };
typedef const float* cfp_t;
__device__ __forceinline__ cfp_t karg_in(int k) { const __attribute__((address_space(4))) char* kp = (const __attribute__((address_space(4))) char*)__builtin_amdgcn_kernarg_segment_ptr(); return *(const volatile __attribute__((address_space(4))) cfp_t*)(kp + 8 * k); }
__device__ __forceinline__ float* karg_out() { return (float*)karg_in(22); }
__device__ __forceinline__ unsigned char* karg_ws() { return (unsigned char*)karg_in(23); }
struct TItem { const float* W; bf16_t* WT; int K, N, mode, r; };
__device__ __forceinline__ TItem p0_item(unsigned char* ws, int it) {
    constexpr int I_IN = 16 * 128, I_AB = 16 * 32, I_OUT = 16 * 32, I_FI = 16 * 176, I_FO = 44 * 32, I_PP = 4 * 32;
    int r = it;
    if (r < I_IN) return TItem{karg_in(8), (bf16_t*)(ws + WS_WIN), 1024, INC, 0, r}; r -= I_IN;
    if (r < I_AB) return TItem{karg_in(13), (bf16_t*)(ws + WS_WAB), 1024, 1024, 0, r}; r -= I_AB;
    if (r < I_OUT) return TItem{karg_in(14), (bf16_t*)(ws + WS_WOUT), 1024, 1024, 0, r}; r -= I_OUT;
    if (r < I_FI) return TItem{karg_in(16), (bf16_t*)(ws + WS_WFI), 1024, 2 * FFH, 1, r}; r -= I_FI;
    if (r < I_FO) return TItem{karg_in(17), (bf16_t*)(ws + WS_WFO), FFH, 1024, 0, r}; r -= I_FO;
    if (r < I_PP) return TItem{karg_in(18), (bf16_t*)(ws + WS_WPP), PLE, 1024, 0, r}; r -= I_PP;
    return TItem{karg_in(20), (bf16_t*)(ws + WS_WPG), 1024, 1024, 0, r};
}
__device__ __forceinline__ void p0_item_load(const TItem& t, float (&wv)[32], int lane) {
    const int nblk = t.N / 32, kb = t.r / nblk, nb = t.r % nblk, k0 = 64 * kb, n0 = 32 * nb;
#pragma unroll
    for (int i = 0; i < 32; ++i) wv[i] = __builtin_nontemporal_load(t.W + (size_t)(k0 + 2 * i + (lane >> 5)) * t.N + n0 + (lane & 31));
}
__device__ __forceinline__ void p0_item_finish(const TItem& t, const float (&wv)[32], LAS float* scr, int lane, const float* kscale) {
    const int nblk = t.N / 32, kb = t.r / nblk, nb = t.r % nblk, k0 = 64 * kb, n0 = 32 * nb;
    if (t.mode == 1) {
#pragma unroll
        for (int i = 0; i < 32; ++i) scr[(2 * i + (lane >> 5)) * 33 + (lane & 31)] = wv[i] * kscale[k0 + 2 * i + (lane >> 5)];
    } else {
#pragma unroll
        for (int i = 0; i < 32; ++i) scr[(2 * i + (lane >> 5)) * 33 + (lane & 31)] = wv[i];
    }
    LDS_WAIT();
    const int c = lane & 7;
#pragma unroll
    for (int j = 0; j < 4; ++j) { const int n = (lane >> 3) + 8 * j; const LAS float* s = scr + (8 * c) * 33 + n;
        u32x4 o; o.x = pk2(s[0 * 33], s[1 * 33]); o.y = pk2(s[2 * 33], s[3 * 33]); o.z = pk2(s[4 * 33], s[5 * 33]); o.w = pk2(s[6 * 33], s[7 * 33]);
        int nn = n0 + n;
        if (t.mode == 1) { const int up = nn >= FFH ? 1 : 0; const int jj = nn - up * FFH; nn = 8 * (jj >> 2) + 4 * up + (jj & 3); }
        *(u32x4*)(t.WT + (size_t)nn * t.K + k0 + 8 * c) = o; }
    LDS_WAIT();
}
__device__ __forceinline__ void rms_row_to_bf16(const float* xrow, const float* gamma, bf16_t* orow, int lane) {
    const f32x4* xr = (const f32x4*)xrow + lane; f32x4 v[4]; float s = 0.f;
#pragma unroll
    for (int j = 0; j < 4; ++j) { v[j] = xr[64 * j]; s += sum4(v[j] * v[j]); }
    const float rs = rsqrtf(wave_sum(s) * (1.0f / DM) + EPS);
    u32x2* o8 = (u32x2*)orow + lane;
#pragma unroll
    for (int j = 0; j < 4; ++j) { const f32x4 g = ((const f32x4*)gamma)[lane + 64 * j]; const f32x4 y = v[j] * rs * g; u32x2 w; w.x = pk2(y[0], y[1]); w.y = pk2(y[2], y[3]); o8[64 * j] = w; }
}


template <int PART>
__device__ __forceinline__ void p0_prologue(LAS unsigned char* lds, int tid, int wave, int lane, int cidx, int cnum) {
    unsigned char* ws = karg_ws(); float* const aout = karg_out(); (void)aout;
    LAS float* scr = (LAS float*)(lds + wave * 16384);
    const int gw = cidx * 8 + wave, NGW = cnum * 8;
    const int gt = cidx * 512 + tid, NGT = cnum * 512;
    constexpr int I_IN = 16 * 128, I_AB = 16 * 32, I_OUT = 16 * 32, I_FI = 16 * 176, I_FO = 44 * 32, I_PP = 4 * 32, I_PG = 16 * 32;
    constexpr int NITEMS = I_IN + I_AB + I_OUT + I_FI + I_FO + I_PP + I_PG;
    {
        const int it_end = (PART == 0 ? I_IN : NITEMS); int it = (PART == 0 ? gw : I_IN + gw); const float* const ln2_ = karg_in(15);
        if (it < it_end) {
            TItem cur = p0_item(ws, it); float wv[32]; p0_item_load(cur, wv, lane);
            for (;;) {
                const int nx = it + NGW; const bool more = nx < it_end; TItem nxt = cur; float wn[32];
                if (more) { nxt = p0_item(ws, nx); p0_item_load(nxt, wn, lane); }
                p0_item_finish(cur, wv, scr, lane, ln2_);
                if (!more) break;
                cur = nxt; it = nx;
#pragma unroll
                for (int i = 0; i < 32; ++i) wv[i] = wn[i];
            }
        }
    }
    if (PART == 1) {
        const float* gwt = karg_in(9); const float* sc = karg_in(10); const float* wpb = karg_in(12); bf16_t* weff = (bf16_t*)(ws + WS_WEFF);
        const int fr = lane & 15, fq = lane >> 4;
        for (int t = gw; t < 4 * 8 * 64; t += NGW) {
            const int nt = t & 63, kt = (t >> 6) & 7, g = t >> 9;
            const float* ga = gwt + (size_t)(g * 128 + kt * 16 + fr) * 128 + fq * 8;
            const float* wb = wpb + (size_t)(g * 128 + fq * 8) * 1024 + nt * 16 + fr;
            const float* sg = sc + g * 128 + fq * 8;
            f32x4 a0[4], a1[4]; float bv[4][8], sv[4][8];
#pragma unroll
            for (int cs = 0; cs < 4; ++cs) { a0[cs] = *(const f32x4*)(ga + cs * 32); a1[cs] = *(const f32x4*)(ga + cs * 32 + 4);
#pragma unroll
                for (int e = 0; e < 8; ++e) { bv[cs][e] = wb[(size_t)(cs * 32 + e) * 1024]; sv[cs][e] = sg[cs * 32 + e]; } }
            f32x4 acc = {0.f, 0.f, 0.f, 0.f};
#pragma unroll
            for (int cs = 0; cs < 4; ++cs) {
                u32x4 aw; aw.x = pk2(a0[cs][0], a0[cs][1]); aw.y = pk2(a0[cs][2], a0[cs][3]); aw.z = pk2(a1[cs][0], a1[cs][1]); aw.w = pk2(a1[cs][2], a1[cs][3]);
                u32x4 bw; bw.x = pk2(bv[cs][0] * sv[cs][0], bv[cs][1] * sv[cs][1]); bw.y = pk2(bv[cs][2] * sv[cs][2], bv[cs][3] * sv[cs][3]); bw.z = pk2(bv[cs][4] * sv[cs][4], bv[cs][5] * sv[cs][5]); bw.w = pk2(bv[cs][6] * sv[cs][6], bv[cs][7] * sv[cs][7]);
                acc = __builtin_amdgcn_mfma_f32_16x16x32_bf16(__builtin_bit_cast(bf16x8, aw), __builtin_bit_cast(bf16x8, bw), acc, 0, 0, 0); }
            u32x2 o; o.x = pk2(acc[0], acc[1]); o.y = pk2(acc[2], acc[3]);
            *(u32x2*)(weff + (size_t)(nt * 16 + fr) * 512 + g * 128 + kt * 16 + 4 * fq) = o;
        }
    }
    if (PART == 0) { const float* const xp_ = karg_in(0); const float* const xs_ = karg_in(1); const float* const ln1_ = karg_in(7);
    int mx = gw < MSM ? MPR + gw : -1;
    for (int m = gw * 2; m < MPR; m += NGW * 2) {
        const int m1 = m + 1;
        const f32x4* x0 = (const f32x4*)(xp_ + (size_t)m * DM) + lane; const f32x4* x1 = (const f32x4*)(xp_ + (size_t)m1 * DM) + lane;
        f32x4 v0[4], v1[4], v2[4]; float s0 = 0.f, s1 = 0.f, s2 = 0.f;
#pragma unroll
        for (int j = 0; j < 4; ++j) { v0[j] = __builtin_nontemporal_load(x0 + 64 * j); v1[j] = __builtin_nontemporal_load(x1 + 64 * j); }
        if (mx >= 0) { const f32x4* x2 = (const f32x4*)(xs_ + (size_t)(mx - MPR) * DM) + lane;
#pragma unroll
            for (int j = 0; j < 4; ++j) v2[j] = __builtin_nontemporal_load(x2 + 64 * j); }
#pragma unroll
        for (int j = 0; j < 4; ++j) { s0 += sum4(v0[j] * v0[j]); s1 += sum4(v1[j] * v1[j]); }
        const float r0 = rsqrtf(wave_sum(s0) * (1.0f / DM) + EPS), r1 = rsqrtf(wave_sum(s1) * (1.0f / DM) + EPS);
        u32x2* o0 = (u32x2*)((bf16_t*)(ws + WS_RA) + (size_t)m * DM) + lane; u32x2* o1 = (u32x2*)((bf16_t*)(ws + WS_RA) + (size_t)m1 * DM) + lane;
#pragma unroll
        for (int j = 0; j < 4; ++j) { const f32x4 g = ((const f32x4*)ln1_)[lane + 64 * j]; const f32x4 y0 = v0[j] * r0 * g, y1 = v1[j] * r1 * g;
            u32x2 w0, w1; w0.x = pk2(y0[0], y0[1]); w0.y = pk2(y0[2], y0[3]); w1.x = pk2(y1[0], y1[1]); w1.y = pk2(y1[2], y1[3]); o0[64 * j] = w0; o1[64 * j] = w1; }
        if (mx >= 0) {
#pragma unroll
            for (int j = 0; j < 4; ++j) s2 += sum4(v2[j] * v2[j]);
            const float r2 = rsqrtf(wave_sum(s2) * (1.0f / DM) + EPS); u32x2* o2 = (u32x2*)((bf16_t*)(ws + WS_RA) + (size_t)mx * DM) + lane;
#pragma unroll
            for (int j = 0; j < 4; ++j) { const f32x4 g = ((const f32x4*)ln1_)[lane + 64 * j]; const f32x4 y2 = v2[j] * r2 * g; u32x2 w2; w2.x = pk2(y2[0], y2[1]); w2.y = pk2(y2[2], y2[3]); o2[64 * j] = w2; }
            mx = -1; }
    }
    for (int r = (mx >= 0 ? gw : gw + NGW); r < MSM; r += NGW) rms_row_to_bf16(xs_ + (size_t)r * DM, ln1_, (bf16_t*)(ws + WS_RA) + (size_t)(MPR + r) * DM, lane);
    }
    if (PART == 1) { const float* const pp_ = karg_in(2); const float* const ps_ = karg_in(3);
    for (int idx0 = gt; idx0 < MREAL * 32; idx0 += NGT * 4) {
        f32x4 v0[4], v1[4];
#pragma unroll
        for (int q = 0; q < 4; ++q) { const int idx = idx0 + q * NGT; if (idx < MREAL * 32) { const int m = idx >> 5, c = (idx & 31) * 8; const float* pr = (m < MPR ? pp_ + (size_t)m * PLE : ps_ + (size_t)(m - MPR) * PLE) + c; v0[q] = __builtin_nontemporal_load((const f32x4*)pr); v1[q] = __builtin_nontemporal_load((const f32x4*)(pr + 4)); } }
#pragma unroll
        for (int q = 0; q < 4; ++q) { const int idx = idx0 + q * NGT; if (idx < MREAL * 32) { const int m = idx >> 5, c = (idx & 31) * 8;
            u32x4 w; w.x = pk2(v0[q][0], v0[q][1]); w.y = pk2(v0[q][2], v0[q][3]); w.z = pk2(v1[q][0], v1[q][1]); w.w = pk2(v1[q][2], v1[q][3]);
            *(u32x4*)((bf16_t*)(ws + WS_PB) + (size_t)m * PLE + c) = w; } }
    } }
    if (PART == 0) for (int idx = gt; idx < 8193 * 8; idx += NGT) {
        const int pi = idx >> 3, i = idx & 7; const float pos = pi < SEQ ? (float)pi : 16384.0f; const float ang = pos * ROPE_INV[i];
        const double tw = 6.283185307179586476925; const double kq = __builtin_rint((double)ang * (1.0 / tw)); const float r = (float)((double)ang - kq * tw);
        float* rp = (float*)(ws + WS_ROPE) + (size_t)pi * 16; rp[i] = __cosf(r); rp[8 + i] = __sinf(r);
    }
    if (PART == 1) { const float* const st_ = karg_in(6);
    for (int idx = gt; idx < MSM * 14 * 128; idx += NGT) {
        const int b = idx / (14 * 128), rem = idx % (14 * 128), r = rem >> 7, c = (rem & 127) * 4;
        *(f32x4*)(aout + O_NPS + ((size_t)b * 15 + r) * 512 + c) = *(const f32x4*)(st_ + ((size_t)b * 15 + r + 1) * 512 + c);
    } }
}

__device__ __forceinline__ f32x4 ld4bf(const bf16_t* p) { const u32x2 w = *(const u32x2*)p; return (f32x4){bflo(w.x), bfhi(w.x), bflo(w.y), bfhi(w.y)}; }
__device__ __forceinline__ f32x4 mfma16(const bf16x8 a, const bf16x8 b, const f32x4 c) { return __builtin_amdgcn_mfma_f32_16x16x32_bf16(a, b, c, 0, 0, 0); }

struct KVRegs { u32x4 k[4], v[4]; };
__device__ __forceinline__ void attn_kv_load(KVRegs& r, int unit, const bf16_t* kb, const bf16_t* vb, int tid) {
    const int kvh = unit & 3, nb = (unit >> 2) & 63, b = unit >> 8, R0 = b * SEQ + nb * 128;
#pragma unroll
    for (int i = 0; i < 4; ++i) { const int c = tid + 512 * i, s = c >> 3, seg = c & 7; const bool ok = (nb > 0) || (s >= 128);
        r.k[i] = (u32x4){0u, 0u, 0u, 0u}; r.v[i] = (u32x4){0u, 0u, 0u, 0u};
        if (ok) { const size_t go = (size_t)(R0 - 128 + s) * 256 + kvh * 64 + seg * 8; r.k[i] = *(const u32x4*)(kb + go); r.v[i] = *(const u32x4*)(vb + go); } }
}
__device__ __forceinline__ void attn_kv_store(const KVRegs& r, LAS unsigned char* lds, int tid) {
    LAS bf16_t* Ks = (LAS bf16_t*)lds; LAS bf16_t* Vt = (LAS bf16_t*)(lds + 256 * 72 * 2);
#pragma unroll
    for (int i = 0; i < 4; ++i) { const int c = tid + 512 * i, s = c >> 3, seg = c & 7;
        *(LAS u32x4*)(Ks + s * 72 + seg * 8) = r.k[i];
        LAS bf16_t* vp = Vt + (seg * 8) * 264 + (s ^ (seg * 8)); const u32x4 vv = r.v[i];
        vp[0 * 264] = (bf16_t)(vv.x & 0xffffu); vp[1 * 264] = (bf16_t)(vv.x >> 16); vp[2 * 264] = (bf16_t)(vv.y & 0xffffu); vp[3 * 264] = (bf16_t)(vv.y >> 16);
        vp[4 * 264] = (bf16_t)(vv.z & 0xffffu); vp[5 * 264] = (bf16_t)(vv.z >> 16); vp[6 * 264] = (bf16_t)(vv.w & 0xffffu); vp[7 * 264] = (bf16_t)(vv.w >> 16); }
}
__device__ __forceinline__ void attn_prompt_math(LAS unsigned char* lds, int unit, const bf16_t* qb, bf16_t* ob, const float* sinks, int wave, int lane) {
    const int kvh = unit & 3, nb = (unit >> 2) & 63, b = unit >> 8, R0 = b * SEQ + nb * 128;
    const LAS bf16_t* Ks = (const LAS bf16_t*)lds; const LAS bf16_t* Vt = (const LAS bf16_t*)(lds + 256 * 72 * 2);
    const int g = wave >> 1, half = wave & 1, h = kvh * 4 + g, fr = lane & 15, fq = lane >> 4;
    const float sink = sinks[h];
    bf16x8 qf[4][2];
#pragma unroll
    for (int sb = 0; sb < 4; ++sb) { const bf16_t* qp = qb + (size_t)(R0 + half * 64 + sb * 16 + fr) * 1024 + h * 64 + fq * 8; qf[sb][0] = *(const bf16x8*)qp; qf[sb][1] = *(const bf16x8*)(qp + 32); }
#pragma unroll
    for (int sb = 0; sb < 4; ++sb) {
        const int qi0 = half * 64 + sb * 16, kt0 = qi0 >> 4, q = qi0 + fr;
        f32x4 S[9];
#pragma unroll
        for (int j = 0; j < 9; ++j) { const LAS bf16_t* kp = Ks + ((kt0 + j) * 16 + fr) * 72 + fq * 8;
            f32x4 acc = {0.f, 0.f, 0.f, 0.f}; acc = mfma16(*(const LAS bf16x8*)kp, qf[sb][0], acc); acc = mfma16(*(const LAS bf16x8*)(kp + 32), qf[sb][1], acc); S[j] = acc; }
        float mx = sink; const int e = fr - 4 * fq;
#pragma unroll
        for (int j = 0; j < 9; ++j) { const bool tok = (nb > 0) || (kt0 + j >= 8);
#pragma unroll
            for (int jj = 0; jj < 4; ++jj) { bool valid = tok; if (j == 0) valid = valid && (e < jj); if (j == 8) valid = valid && (e >= jj);
                const float v = valid ? S[j][jj] : -1e30f; S[j][jj] = v; mx = fmaxf(mx, v); } }
        mx = fmaxf(mx, __shfl_xor(mx, 16)); mx = fmaxf(mx, __shfl_xor(mx, 32));
        float l = 0.f;
#pragma unroll
        for (int j = 0; j < 9; ++j)
#pragma unroll
            for (int jj = 0; jj < 4; ++jj) { const float p = __expf(S[j][jj] - mx); S[j][jj] = p; l += p; }
        l += __shfl_xor(l, 16); l += __shfl_xor(l, 32); l += __expf(sink - mx);
        const float inv = 1.0f / l;
        f32x4 O[4];
#pragma unroll
        for (int dt = 0; dt < 4; ++dt) O[dt] = (f32x4){0.f, 0.f, 0.f, 0.f};
#pragma unroll
        for (int jp = 0; jp < 5; ++jp) {
            u32x4 pw; pw.x = cvt_pk_bf16_v(S[2 * jp][0], S[2 * jp][1]); pw.y = cvt_pk_bf16_v(S[2 * jp][2], S[2 * jp][3]);
            if (jp < 4) { pw.z = cvt_pk_bf16_v(S[2 * jp + 1 < 9 ? 2 * jp + 1 : 8][0], S[2 * jp + 1 < 9 ? 2 * jp + 1 : 8][1]); pw.w = cvt_pk_bf16_v(S[2 * jp + 1 < 9 ? 2 * jp + 1 : 8][2], S[2 * jp + 1 < 9 ? 2 * jp + 1 : 8][3]); } else { pw.z = 0u; pw.w = 0u; }
            const bf16x8 pf = __builtin_bit_cast(bf16x8, pw);
#pragma unroll
            for (int dt = 0; dt < 4; ++dt) { const int d = dt * 16 + fr, sw = ((d >> 3) & 7) * 8, s0 = (kt0 + 2 * jp) * 16 + fq * 4; const LAS bf16_t* vr = Vt + d * 264;
                const s16x4 lo = *(const LAS s16x4*)(vr + (s0 ^ sw)); s16x4 hi = {0, 0, 0, 0}; if (jp < 4) hi = *(const LAS s16x4*)(vr + ((s0 + 16) ^ sw));
                const bf16x8 vf = {lo[0], lo[1], lo[2], lo[3], hi[0], hi[1], hi[2], hi[3]};
                O[dt] = mfma16(vf, pf, O[dt]); }
        }
        bf16_t* op = ob + (size_t)(R0 + q) * 1024 + h * 64 + fq * 4;
#pragma unroll
        for (int dt = 0; dt < 4; ++dt) { const f32x4 o = O[dt] * inv; u32x2 w; w.x = cvt_pk_bf16(o[0], o[1]); w.y = cvt_pk_bf16(o[2], o[3]); *(u32x2*)(op + dt * 16) = w; }
    }
}
__device__ __forceinline__ void attn_prompt_all(LAS unsigned char* lds, const bf16_t* qb, const bf16_t* kb, const bf16_t* vb, bf16_t* ob, const float* sinks, int tid, int wave, int lane) {
    const int G = gridDim.x; int unit = blockIdx.x; if (unit >= 512) return;
    KVRegs r; attn_kv_load(r, unit, kb, vb, tid);
    for (;;) {
        attn_kv_store(r, lds, tid);
        __syncthreads();
        const int nxt = unit + G;
        if (nxt < 512) attn_kv_load(r, nxt, kb, vb, tid);
        attn_prompt_math(lds, unit, qb, ob, sinks, wave, lane);
        __syncthreads();
        if (nxt >= 512) break;
        unit = nxt;
    }
}

__device__ __forceinline__ void attn_sample_unit(LAS unsigned char* lds, int unit, const bf16_t* qb, const bf16_t* kb, const bf16_t* vb, bf16_t* ob, const float* cache_k, const float* cache_v, const float* sinks, float* out, int tid, int wave, int lane) {
    const int kvh = unit & 3, b = unit >> 2; const size_t row = MPR + b;
    LAS float* sc = (LAS float*)lds;
    LAS float* lsum = sc + 4 * 132;
    LAS float* opart = sc + 4 * 132 + 16;
    const int jq = lane >> 4, dq = lane & 15;
    f32x4 qv[4];
#pragma unroll
    for (int g = 0; g < 4; ++g) qv[g] = ld4bf(qb + row * 1024 + (kvh * 4 + g) * 64 + dq * 4);
    f32x4 kv[4], vv[4];
#pragma unroll
    for (int i = 0; i < 4; ++i) { const int j = wave * 16 + i * 4 + jq; const size_t off = ((size_t)(b * 128 + j) * 4 + kvh) * 64 + dq * 4;
        kv[i] = __builtin_nontemporal_load((const f32x4*)(cache_k + off)); vv[i] = __builtin_nontemporal_load((const f32x4*)(cache_v + off)); }
    const f32x4 knew = ld4bf(kb + row * 256 + kvh * 64 + dq * 4);
#pragma unroll
    for (int i = 0; i < 4; ++i) { const int j = wave * 16 + i * 4 + jq;
        if (j >= 1) { const size_t off = ((size_t)(b * 128 + j - 1) * 4 + kvh) * 64 + dq * 4; __builtin_nontemporal_store(kv[i], (f32x4*)(out + O_NKS + off)); __builtin_nontemporal_store(vv[i], (f32x4*)(out + O_NVS + off)); } }
#pragma unroll
    for (int i = 0; i < 5; ++i) { const f32x4 kk = i < 4 ? kv[i < 4 ? i : 0] : knew; float mine = 0.f;
#pragma unroll
        for (int g = 0; g < 4; ++g) { float p = sum4(kk * qv[g]); p += __shfl_xor(p, 1); p += __shfl_xor(p, 2); p += __shfl_xor(p, 4); p += __shfl_xor(p, 8); if (dq == g) mine = p; }
        if (i < 4) { if (dq < 4) sc[dq * 132 + wave * 16 + i * 4 + jq] = mine; }
        else if (wave == 0 && jq == 0 && dq < 4) sc[dq * 132 + 128] = mine; }
    __syncthreads();
    if (wave < 4) { const int g = wave; float a = sc[g * 132 + lane]; const float b2 = sc[g * 132 + 64 + lane], n = sc[g * 132 + 128], sink = sinks[kvh * 4 + g];
        if (lane == 0) a = -1e30f;
        const float mx = fmaxf(fmaxf(wave_max(fmaxf(a, b2)), n), sink);
        const float pa = __expf(a - mx), pb = __expf(b2 - mx), pnw = __expf(n - mx); const float l = wave_sum(pa + pb) + pnw + __expf(sink - mx);
        sc[g * 132 + lane] = pa; sc[g * 132 + 64 + lane] = pb; if (lane == 0) { sc[g * 132 + 128] = pnw; lsum[g] = 1.0f / l; } }
    __syncthreads();
    f32x4 o[4];
#pragma unroll
    for (int g = 0; g < 4; ++g) o[g] = (f32x4){0.f, 0.f, 0.f, 0.f};
#pragma unroll
    for (int i = 0; i < 4; ++i) { const int j = wave * 16 + i * 4 + jq;
#pragma unroll
        for (int g = 0; g < 4; ++g) o[g] += vv[i] * sc[g * 132 + j]; }
#pragma unroll
    for (int g = 0; g < 4; ++g)
#pragma unroll
        for (int e = 0; e < 4; ++e) { float t = o[g][e]; t += __shfl_xor(t, 16); t += __shfl_xor(t, 32); o[g][e] = t; }
    if (jq == 0) {
#pragma unroll
        for (int g = 0; g < 4; ++g) *(LAS f32x4*)(opart + (wave * 4 + g) * 64 + dq * 4) = o[g]; }
    __syncthreads();
    if (tid < 256) { const int g = tid >> 6, d = tid & 63; float acc = 0.f;
#pragma unroll
        for (int w = 0; w < 8; ++w) acc += opart[(w * 4 + g) * 64 + d];
        acc += sc[g * 132 + 128] * bflo((unsigned)vb[row * 256 + kvh * 64 + d]);
        ob[row * 1024 + (kvh * 4 + g) * 64 + d] = (bf16_t)f2bf(acc * lsum[g]); }
    __syncthreads();
}

template <int W>
__device__ __forceinline__ void pool_item(const bf16_t* __restrict__ ub, bf16_t* __restrict__ mb, const float* __restrict__ state, int row, int ch) {
    f32x4 u0, u1; unpack8(*(const u32x4*)(ub + (size_t)row * 512 + ch), u0, u1);
    f32x4 s0 = u0, s1 = u1; float cnt;
    if (row < MPR) { const int t = row & (SEQ - 1); cnt = (float)((t + 1 < W) ? t + 1 : W);
        u32x4 w[W - 1];
#pragma unroll
        for (int i = 1; i < W; ++i) { w[i - 1] = (u32x4){0u, 0u, 0u, 0u}; if (i <= t) w[i - 1] = *(const u32x4*)(ub + (size_t)(row - i) * 512 + ch); }
#pragma unroll
        for (int i = 1; i < W; ++i) { f32x4 a0, a1; unpack8(w[i - 1], a0, a1); s0 += a0; s1 += a1; } }
    else { const int b = row - MPR; cnt = (float)W;
#pragma unroll
        for (int i = 1; i < W; ++i) { const float* sp = state + ((size_t)b * 15 + 15 - i) * 512 + ch; s0 += *(const f32x4*)sp; s1 += *(const f32x4*)(sp + 4); } }
    const float ic = 1.0f / cnt;
    *(u32x4*)(mb + (size_t)row * 512 + ch) = pack8(s0 * ic - u0, s1 * ic - u1);
}
template <int W>
__device__ __forceinline__ void pool_block4(const bf16_t* __restrict__ ub, bf16_t* __restrict__ mb, const float* __restrict__ state, int row0, int ch) {
    if (row0 >= MPR) {
#pragma unroll
        for (int r = 0; r < 4; ++r) pool_item<W>(ub, mb, state, row0 + r, ch);
        return;
    }
    const int t0 = row0 & (SEQ - 1);
    u32x4 w[W + 3];
#pragma unroll
    for (int j = 0; j < W + 3; ++j) { w[j] = (u32x4){0u, 0u, 0u, 0u}; if (t0 + j - (W - 1) >= 0) w[j] = *(const u32x4*)(ub + (size_t)(row0 + j - (W - 1)) * 512 + ch); }
    f32x4 s0 = {0.f, 0.f, 0.f, 0.f}, s1 = {0.f, 0.f, 0.f, 0.f};
#pragma unroll
    for (int j = 0; j < W - 1; ++j) { f32x4 a0, a1; unpack8(w[j], a0, a1); s0 += a0; s1 += a1; }
#pragma unroll
    for (int r = 0; r < 4; ++r) {
        f32x4 u0, u1; unpack8(w[W - 1 + r], u0, u1); s0 += u0; s1 += u1;
        const int n = (t0 + r + 1 < W) ? t0 + r + 1 : W; const float ic = 1.0f / (float)n;
        *(u32x4*)(mb + (size_t)(row0 + r) * 512 + ch) = pack8(s0 * ic - u0, s1 * ic - u1);
        f32x4 o0, o1; unpack8(w[r], o0, o1); s0 -= o0; s1 -= o1;
    }
}
__device__ __forceinline__ void pool_items(unsigned char* ws, const float* __restrict__ state, int tid) {
    const bf16_t* __restrict__ ub = (const bf16_t*)(ws + WS_UB); bf16_t* __restrict__ mb = (bf16_t*)(ws + WS_MB);
    for (int idx = blockIdx.x * 512 + tid; idx < (MPR / 4) * 64; idx += gridDim.x * 512) {
        const int cgk = idx & 15, g = (idx >> 6) & 3, rb = (idx >> 8) * 4 + ((idx >> 4) & 3), row0 = rb * 4, ch = g * 128 + cgk * 8;
        if (g == 0) pool_block4<2>(ub, mb, state, row0, ch); else if (g == 1) pool_block4<4>(ub, mb, state, row0, ch); else if (g == 2) pool_block4<8>(ub, mb, state, row0, ch); else pool_block4<16>(ub, mb, state, row0, ch);
    }
    for (int s = blockIdx.x * 512 + tid; s < MSM * 64; s += gridDim.x * 512) {
        const int cgk = s & 15, g = (s >> 6) & 3, row = MPR + (s >> 8) * 4 + ((s >> 4) & 3), ch = g * 128 + cgk * 8;
        if (g == 0) pool_item<2>(ub, mb, state, row, ch); else if (g == 1) pool_item<4>(ub, mb, state, row, ch); else if (g == 2) pool_item<8>(ub, mb, state, row, ch); else pool_item<16>(ub, mb, state, row, ch);
    }
}

template <int K, class F>
__device__ __forceinline__ void skinny_gemm(LAS unsigned char* lds, const bf16_t* A, const bf16_t* Bt, int wave, int lane, const F& f) {
    constexpr int KQ = K / 4;
    const int fr = lane & 15, fq = lane >> 4, ks = wave & 3;
    for (int tp = blockIdx.x; tp < 256; tp += gridDim.x) {
        const int t = tp * 2 + (wave >> 2), cb = t & 63, rb = t >> 6;
        const bf16_t* ap = A + (size_t)(rb * 16 + fr) * K + ks * KQ + fq * 8;
        const bf16_t* bp = Bt + (size_t)(cb * 16 + fr) * K + ks * KQ + fq * 8;
        f32x4 acc = {0.f, 0.f, 0.f, 0.f};
#pragma unroll 8
        for (int k = 0; k < KQ; k += 32) acc = mfma16(*(const bf16x8*)(bp + k), *(const bf16x8*)(ap + k), acc);
        LAS f32x4* red = (LAS f32x4*)lds;
        red[wave * 64 + lane] = acc;
        __syncthreads();
        if (ks == 0) { acc = (red[wave * 64 + lane] + red[(wave + 1) * 64 + lane]) + (red[(wave + 2) * 64 + lane] + red[(wave + 3) * 64 + lane]);
            f(MPR + rb * 16 + fr, cb * 16 + fq * 4, acc, fq, cb); }
        __syncthreads();
    }
}
__device__ __forceinline__ void st4bf(bf16_t* p, const f32x4 v) { u32x2 w; w.x = cvt_pk_bf16(v[0], v[1]); w.y = cvt_pk_bf16(v[2], v[3]); *(u32x2*)p = w; }
__device__ __forceinline__ void ss_part(float* ss, int row, int cb, int fq, float q) { q += __shfl_xor(q, 16); q += __shfl_xor(q, 32); if (fq == 0) ss[(size_t)MPR * 16 + (size_t)(row - MPR) * 64 + cb] = q; }
template <int K1, int K2, class F>
__device__ __forceinline__ void skinny_gemm2(LAS unsigned char* lds, const bf16_t* A1, const bf16_t* Bt1, const bf16_t* A2, const bf16_t* Bt2, int wave, int lane, const F& f) {
    constexpr int KQ1 = K1 / 4, KQ2 = K2 / 4;
    const int fr = lane & 15, fq = lane >> 4, ks = wave & 3;
    for (int tp = blockIdx.x; tp < 256; tp += gridDim.x) {
        const int t = tp * 2 + (wave >> 2), cb = t & 63, rb = t >> 6;
        const bf16_t* ap1 = A1 + (size_t)(rb * 16 + fr) * K1 + ks * KQ1 + fq * 8; const bf16_t* bp1 = Bt1 + (size_t)(cb * 16 + fr) * K1 + ks * KQ1 + fq * 8;
        const bf16_t* ap2 = A2 + (size_t)(rb * 16 + fr) * K2 + ks * KQ2 + fq * 8; const bf16_t* bp2 = Bt2 + (size_t)(cb * 16 + fr) * K2 + ks * KQ2 + fq * 8;
        f32x4 acc1 = {0.f, 0.f, 0.f, 0.f}, acc2 = {0.f, 0.f, 0.f, 0.f};
#pragma unroll 8
        for (int k = 0; k < KQ2; k += 32) acc2 = mfma16(*(const bf16x8*)(bp2 + k), *(const bf16x8*)(ap2 + k), acc2);
#pragma unroll 8
        for (int k = 0; k < KQ1; k += 32) acc1 = mfma16(*(const bf16x8*)(bp1 + k), *(const bf16x8*)(ap1 + k), acc1);
        LAS f32x4* red = (LAS f32x4*)lds;
        red[wave * 64 + lane] = acc1; red[512 + wave * 64 + lane] = acc2;
        __syncthreads();
        if (ks == 0) { acc1 = (red[wave * 64 + lane] + red[(wave + 1) * 64 + lane]) + (red[(wave + 2) * 64 + lane] + red[(wave + 3) * 64 + lane]);
            acc2 = (red[512 + wave * 64 + lane] + red[512 + (wave + 1) * 64 + lane]) + (red[512 + (wave + 2) * 64 + lane] + red[512 + (wave + 3) * 64 + lane]);
            f(MPR + rb * 16 + fr, cb * 16 + fq * 4, acc1, acc2, fq, cb); }
        __syncthreads();
    }
}
struct SMerge2 { bf16_t* mg; const bf16_t* gb;
    __device__ __forceinline__ void operator()(int row, int col, f32x4 v1, f32x4 v2, int, int) const { st4bf(mg + (size_t)row * DM + col, ld4bf(gb + (size_t)row * 2048 + col) * v1 + ld4bf(gb + (size_t)row * 2048 + 1024 + col) * v2); } };
struct SRes2Eraw { bf16_t* hb; bf16_t* er; float* ss;
    __device__ __forceinline__ void operator()(int row, int col, f32x4 v1, f32x4 v2, int fq, int cb) const {
        bf16_t* hp = hb + (size_t)row * DM + col; st4bf(hp, ld4bf(hp) + v1); st4bf(er + (size_t)row * DM + col, v2); ss_part(ss, row, cb, fq, sum4(v2 * v2)); } };
struct SMergeA { bf16_t* mg; const bf16_t* gb;
    __device__ __forceinline__ void operator()(int row, int col, f32x4 v, int, int) const { st4bf(mg + (size_t)row * DM + col, ld4bf(gb + (size_t)row * 2048 + col) * v); } };
struct SMergeB { bf16_t* mg; const bf16_t* gb;
    __device__ __forceinline__ void operator()(int row, int col, f32x4 v, int, int) const { bf16_t* p = mg + (size_t)row * DM + col; st4bf(p, ld4bf(p) + ld4bf(gb + (size_t)row * 2048 + 1024 + col) * v); } };
struct SRes1 { const float *xs; bf16_t* hb; float* ss;
    __device__ __forceinline__ void operator()(int row, int col, f32x4 v, int fq, int cb) const {
        v += *(const f32x4*)(xs + (size_t)(row - MPR) * DM + col); st4bf(hb + (size_t)row * DM + col, v); ss_part(ss, row, cb, fq, sum4(v * v)); } };
struct SRes2 { bf16_t* hb;
    __device__ __forceinline__ void operator()(int row, int col, f32x4 v, int, int) const { bf16_t* hp = hb + (size_t)row * DM + col; st4bf(hp, ld4bf(hp) + v); } };
struct SEraw { bf16_t* er; float* ss;
    __device__ __forceinline__ void operator()(int row, int col, f32x4 v, int fq, int cb) const { st4bf(er + (size_t)row * DM + col, v); ss_part(ss, row, cb, fq, sum4(v * v)); } };
struct SPle { bf16_t* ob; const bf16_t* hb; const bf16_t* er; const float *sse, *pn; float* sso;
    __device__ __forceinline__ void operator()(int row, int col, f32x4 v, int fq, int cb) const {
        const float rs = row_rs(sse, row);
        v = ld4bf(hb + (size_t)row * DM + col) + sigm4(v) * (ld4bf(er + (size_t)row * DM + col) * rs * *(const f32x4*)(pn + col)); st4bf(ob + (size_t)row * DM + col, v); ss_part(sso, row, cb, fq, sum4(v * v)); } };

#define XB_TMO      128
#define XB_XCNT(j)  (256  + 64 * (j))
#define XB_XSUB(j)  (1280 + 64 * (j))
#define XB_XGEN(j)  (2304 + 64 * (j))
#define XB_TOP      3328
#define XB_TOPGEN   3392
#define XCD_BAR_WORDS 3456
#define XB_SPIN_CAP (1u << 18)

__device__ __forceinline__ unsigned xb_ld(unsigned* p)              { return __hip_atomic_load(p, __ATOMIC_RELAXED, __HIP_MEMORY_SCOPE_AGENT); }
__device__ __forceinline__ unsigned xb_add(unsigned* p, unsigned v) { return __hip_atomic_fetch_add(p, v, __ATOMIC_RELAXED, __HIP_MEMORY_SCOPE_AGENT); }
__device__ __forceinline__ unsigned xb_xcc_id() { return (unsigned)__builtin_amdgcn_s_getreg((3 << 11) | 20) & 0xFu; }
#define XB_SPIN(cond, bar) do { unsigned _sp = 0; while (cond) { __builtin_amdgcn_s_sleep(1); \
    if ((++_sp & 255u) == 0u) { if (xb_ld(&(bar)[XB_TMO])) break; if (_sp > XB_SPIN_CAP) { atomicAdd(&(bar)[XB_TMO], 1u); break; } } } } while (0)

__device__ __forceinline__ bool is_thread0(int wave_s) { int l = (int)__builtin_amdgcn_mbcnt_hi(~0u, __builtin_amdgcn_mbcnt_lo(~0u, 0u)); asm volatile("" : "+v"(l)); return wave_s == 0 && l == 0; }
struct XcdBarrier {
    unsigned* bar; unsigned x;
    volatile LAS unsigned* st;
};

__device__ __forceinline__ XcdBarrier xcd_barrier_post(unsigned* bar, volatile LAS unsigned* st) {
    XcdBarrier b; b.bar = bar; b.x = xb_xcc_id(); b.st = st;
    if (threadIdx.x == 0) (void)xb_add(&bar[XB_XCNT(b.x)], 1u);
    return b;
}
__device__ __forceinline__ void xcd_barrier_complete(unsigned* bar, unsigned x, unsigned& nloc, unsigned& nx) {
    const unsigned G = gridDim.x * gridDim.y * gridDim.z;
    unsigned sum, cnt, mine, sp = 0u;
    for (;;) {
        sum = 0u; cnt = 0u; mine = 0u;
#pragma unroll
        for (unsigned j = 0; j < 16; ++j) { const unsigned c = xb_ld(&bar[XB_XCNT(j)]); sum += c; cnt += (c > 0u) ? 1u : 0u; mine = (j == x) ? c : mine; }
        if (sum == G) break;
        __builtin_amdgcn_s_sleep(1);
        if ((++sp & 255u) == 0u) { if (xb_ld(&bar[XB_TMO])) break; if (sp > XB_SPIN_CAP) { atomicAdd(&bar[XB_TMO], 1u); break; } }
    }
    nloc = mine > 0u ? mine : 1u; nx = cnt > 0u ? cnt : 1u;
}

__device__ __forceinline__ void xcd_barrier(const XcdBarrier& b, const int wave_s) {
    asm volatile("s_waitcnt vmcnt(0)" ::: "memory");
    __syncthreads();
    if (is_thread0(wave_s)) {
        unsigned* bar = b.bar;
        __builtin_amdgcn_s_waitcnt(0);
        unsigned nloc = b.st[0], nx = b.st[1];
        if (nloc == 0u) { xcd_barrier_complete(bar, b.x, nloc, nx); b.st[0] = nloc; b.st[1] = nx; }
        const unsigned old = xb_add(&bar[XB_XSUB(b.x)], 1u);
        const unsigned gen = old / nloc;
        if (old + 1u == (gen + 1u) * nloc) {
            __builtin_amdgcn_fence(__ATOMIC_RELEASE, "agent");
            asm volatile("s_waitcnt vmcnt(0)" ::: "memory");
            const unsigned og = xb_add(&bar[XB_TOP], 1u);
            const unsigned tg = og / nx;
            if (og + 1u == (tg + 1u) * nx) xb_add(&bar[XB_TOPGEN], 1u);
            else XB_SPIN(xb_ld(&bar[XB_TOPGEN]) == tg, bar);
            __builtin_amdgcn_fence(__ATOMIC_ACQUIRE, "agent");
            xb_add(&bar[XB_XGEN(b.x)], 1u);
            asm volatile("s_waitcnt vmcnt(0)" ::: "memory");
        } else {
            XB_SPIN(xb_ld(&bar[XB_XGEN(b.x)]) == gen, bar);
            __builtin_amdgcn_fence(__ATOMIC_ACQUIRE, "agent");
            asm volatile("s_waitcnt vmcnt(0)" ::: "memory");
        }
    }
    __syncthreads();
}

constexpr size_t WS_BAR = 5 * MiB; constexpr int BAR_BYTES = 16384;
__global__ void __launch_bounds__(512, 2) fwd_kernel(Args a) {
    extern __shared__ __attribute__((aligned(16))) unsigned char lds_raw[];
    LAS unsigned char* lds = (LAS unsigned char*)lds_raw;
    const int wave = __builtin_amdgcn_readfirstlane((int)threadIdx.x >> 6);
    if (threadIdx.x < 64) ((volatile LAS unsigned*)(lds + 131072))[threadIdx.x] = 0u;
    __syncthreads();
    XcdBarrier xbar; xbar.bar = (unsigned*)(karg_ws() + WS_BAR); xbar.x = 0; xbar.st = nullptr;
    if (a.ph_hi - a.ph_lo > 1) xbar = xcd_barrier_post((unsigned*)(karg_ws() + WS_BAR), (volatile LAS unsigned*)(lds + 131072) + 8);
#define TID_LANE() int lane = (int)__builtin_amdgcn_mbcnt_hi(~0u, __builtin_amdgcn_mbcnt_lo(~0u, 0u)); asm volatile("" : "+v"(lane)); const int tid = wave * 64 + lane; (void)tid
    const int lo = a.ph_lo, hi = a.ph_hi;
#define IN(k) (lo <= (k) && (k) < hi)
#define SEAM(k) do { if (IN(k) && IN((k) + 1)) { xcd_barrier(xbar, wave); } } while (0)
    const int G = gridDim.x, c = blockIdx.x;

    if (a.ph_hi > NPHASE) cg::this_grid().sync();
    if (IN(0)) { TID_LANE(); p0_prologue<0>(lds, tid, wave, lane, (int)blockIdx.x, (int)gridDim.x); }
    SEAM(0);
    if (IN(1)) {
        unsigned char* ws = karg_ws();
        bf16_t* RA = (bf16_t*)(ws + WS_RA); bf16_t* GB = (bf16_t*)(ws + WS_RG); bf16_t* ER = (bf16_t*)(ws + WS_RG);
        bf16_t* UB = (bf16_t*)(ws + WS_UB); bf16_t* QB = (bf16_t*)(ws + WS_QB); bf16_t* KB = (bf16_t*)(ws + WS_KB); bf16_t* VB = (bf16_t*)(ws + WS_VB);
        bf16_t* MB = (bf16_t*)(ws + WS_MB); bf16_t* MG = (bf16_t*)(ws + WS_MG); bf16_t* ACT = (bf16_t*)(ws + WS_ACT);
        float* SS2 = (float*)(ws + WS_SS2); float* SSE = (float*)(ws + WS_SSE); float* SSO = (float*)(ws + WS_SSO);
        (void)RA; (void)GB; (void)ER; (void)UB; (void)QB; (void)KB; (void)VB; (void)MB; (void)MG; (void)ACT; (void)SS2; (void)SSE; (void)SSO;
        Gemm g{RA, (const bf16_t*)(ws + WS_WIN), MPAD, INC, 1024}; StaticOrder S; S.init(MPAD, INC, G, c);
        EpiIn E{UB, QB, KB, VB, GB, karg_out(), (const float*)(ws + WS_ROPE)};
        gemm_phase<EpiIn, StaticOrder, true, true, 1024>(lds, g, S, E, wave);
        { const int nwg = (MPAD / 256) * (INC / 256), extra = nwg % G;
          TID_LANE(); if (extra == 0) p0_prologue<1>(lds, tid, wave, lane, c, G); else if (c >= extra) p0_prologue<1>(lds, tid, wave, lane, c - extra, G - extra); }
    }
    SEAM(1);
    if (IN(2)) {
        TID_LANE();
        unsigned char* ws = karg_ws();
        bf16_t* RA = (bf16_t*)(ws + WS_RA); bf16_t* GB = (bf16_t*)(ws + WS_RG); bf16_t* ER = (bf16_t*)(ws + WS_RG);
        bf16_t* UB = (bf16_t*)(ws + WS_UB); bf16_t* QB = (bf16_t*)(ws + WS_QB); bf16_t* KB = (bf16_t*)(ws + WS_KB); bf16_t* VB = (bf16_t*)(ws + WS_VB);
        bf16_t* MB = (bf16_t*)(ws + WS_MB); bf16_t* MG = (bf16_t*)(ws + WS_MG); bf16_t* ACT = (bf16_t*)(ws + WS_ACT);
        float* SS2 = (float*)(ws + WS_SS2); float* SSE = (float*)(ws + WS_SSE); float* SSO = (float*)(ws + WS_SSO);
        (void)RA; (void)GB; (void)ER; (void)UB; (void)QB; (void)KB; (void)VB; (void)MB; (void)MG; (void)ACT; (void)SS2; (void)SSE; (void)SSO;
        { const float* const sinks_ = karg_in(11); const float* const ck_ = karg_in(4); const float* const cv_ = karg_in(5); float* const out_ = karg_out();
        attn_prompt_all(lds, QB, KB, VB, RA, sinks_, tid, wave, lane);
        for (int unit = c; unit < 512; unit += G) attn_sample_unit(lds, unit, QB, KB, VB, RA, ck_, cv_, sinks_, out_, tid, wave, lane); }
        pool_items(ws, karg_in(6), tid);
        __syncthreads();
    }
    SEAM(2);
    if (IN(3)) {
        unsigned char* ws = karg_ws();
        bf16_t* RA = (bf16_t*)(ws + WS_RA); bf16_t* GB = (bf16_t*)(ws + WS_RG); bf16_t* ER = (bf16_t*)(ws + WS_RG);
        bf16_t* UB = (bf16_t*)(ws + WS_UB); bf16_t* QB = (bf16_t*)(ws + WS_QB); bf16_t* KB = (bf16_t*)(ws + WS_KB); bf16_t* VB = (bf16_t*)(ws + WS_VB);
        bf16_t* MB = (bf16_t*)(ws + WS_MB); bf16_t* MG = (bf16_t*)(ws + WS_MG); bf16_t* ACT = (bf16_t*)(ws + WS_ACT);
        float* SS2 = (float*)(ws + WS_SS2); float* SSE = (float*)(ws + WS_SSE); float* SSO = (float*)(ws + WS_SSO);
        (void)RA; (void)GB; (void)ER; (void)UB; (void)QB; (void)KB; (void)VB; (void)MB; (void)MG; (void)ACT; (void)SS2; (void)SSE; (void)SSO;
        TID_LANE();
        { const bf16_t* mbs = MB + (size_t)MPR * 512; const bf16_t* ras = RA + (size_t)MPR * DM;
          SMerge2 Em{MG, GB}; skinny_gemm2<512, 1024>(lds, mbs, (const bf16_t*)(ws + WS_WEFF), ras, (const bf16_t*)(ws + WS_WAB), wave, lane, Em); }
        StaticOrder S; S.init(MPR, 1024, G, c);
        { Gemm g{MB, (const bf16_t*)(ws + WS_WEFF), MPR, 1024, 512}; EpiMergeA E{MG, GB}; gemm_phase<EpiMergeA, StaticOrder, true, true, 512>(lds, g, S, E, wave); }
        { Gemm g{RA, (const bf16_t*)(ws + WS_WAB), MPR, 1024, 1024}; EpiMergeB E{MG, GB}; gemm_phase<EpiMergeB, StaticOrder, true, true, 1024>(lds, g, S, E, wave); }
    }
    SEAM(3);
    if (IN(4)) {
        unsigned char* ws = karg_ws();
        bf16_t* RA = (bf16_t*)(ws + WS_RA); bf16_t* GB = (bf16_t*)(ws + WS_RG); bf16_t* ER = (bf16_t*)(ws + WS_RG);
        bf16_t* UB = (bf16_t*)(ws + WS_UB); bf16_t* QB = (bf16_t*)(ws + WS_QB); bf16_t* KB = (bf16_t*)(ws + WS_KB); bf16_t* VB = (bf16_t*)(ws + WS_VB);
        bf16_t* MB = (bf16_t*)(ws + WS_MB); bf16_t* MG = (bf16_t*)(ws + WS_MG); bf16_t* ACT = (bf16_t*)(ws + WS_ACT);
        float* SS2 = (float*)(ws + WS_SS2); float* SSE = (float*)(ws + WS_SSE); float* SSO = (float*)(ws + WS_SSO);
        (void)RA; (void)GB; (void)ER; (void)UB; (void)QB; (void)KB; (void)VB; (void)MB; (void)MG; (void)ACT; (void)SS2; (void)SSE; (void)SSO;
        TID_LANE();
        { SRes1 Es{karg_in(1), RA, SS2}; skinny_gemm<1024>(lds, MG + (size_t)MPR * DM, (const bf16_t*)(ws + WS_WOUT), wave, lane, Es); }
        Gemm g{MG, (const bf16_t*)(ws + WS_WOUT), MPR, 1024, 1024}; StaticOrder S; S.init(MPR, 1024, G, c);
        EpiRes1 E{karg_in(0), RA, SS2};
        gemm_phase<EpiRes1, StaticOrder, true, true, 1024>(lds, g, S, E, wave);
    }
    SEAM(4);
    if (IN(5)) {
        unsigned char* ws = karg_ws();
        bf16_t* RA = (bf16_t*)(ws + WS_RA); bf16_t* GB = (bf16_t*)(ws + WS_RG); bf16_t* ER = (bf16_t*)(ws + WS_RG);
        bf16_t* UB = (bf16_t*)(ws + WS_UB); bf16_t* QB = (bf16_t*)(ws + WS_QB); bf16_t* KB = (bf16_t*)(ws + WS_KB); bf16_t* VB = (bf16_t*)(ws + WS_VB);
        bf16_t* MB = (bf16_t*)(ws + WS_MB); bf16_t* MG = (bf16_t*)(ws + WS_MG); bf16_t* ACT = (bf16_t*)(ws + WS_ACT);
        float* SS2 = (float*)(ws + WS_SS2); float* SSE = (float*)(ws + WS_SSE); float* SSO = (float*)(ws + WS_SSO);
        (void)RA; (void)GB; (void)ER; (void)UB; (void)QB; (void)KB; (void)VB; (void)MB; (void)MG; (void)ACT; (void)SS2; (void)SSE; (void)SSO;
        Gemm g{RA, (const bf16_t*)(ws + WS_WFI), MPAD, 2 * FFH, 1024}; StaticOrder S; S.init(MPAD, 2 * FFH, G, c);
        EpiSwiglu E{ACT, SS2};
        gemm_phase<EpiSwiglu, StaticOrder, true, true, 1024>(lds, g, S, E, wave);
        { const int nwg5 = (MPAD / 256) * (2 * FFH / 256), extra5 = nwg5 % G;
          TailOrder T; T.init(MPR, 1024, G, c, extra5); Gemm gp{(const bf16_t*)(ws + WS_PB), (const bf16_t*)(ws + WS_WPP), MPR, 1024, PLE}; EpiEraw Ee{ER, SSE};
          gemm_phase<EpiEraw, TailOrder, true, true, PLE>(lds, gp, T, Ee, wave); }
    }
    SEAM(5);
    if (IN(6)) {
        unsigned char* ws = karg_ws();
        bf16_t* RA = (bf16_t*)(ws + WS_RA); bf16_t* GB = (bf16_t*)(ws + WS_RG); bf16_t* ER = (bf16_t*)(ws + WS_RG);
        bf16_t* UB = (bf16_t*)(ws + WS_UB); bf16_t* QB = (bf16_t*)(ws + WS_QB); bf16_t* KB = (bf16_t*)(ws + WS_KB); bf16_t* VB = (bf16_t*)(ws + WS_VB);
        bf16_t* MB = (bf16_t*)(ws + WS_MB); bf16_t* MG = (bf16_t*)(ws + WS_MG); bf16_t* ACT = (bf16_t*)(ws + WS_ACT);
        float* SS2 = (float*)(ws + WS_SS2); float* SSE = (float*)(ws + WS_SSE); float* SSO = (float*)(ws + WS_SSO);
        (void)RA; (void)GB; (void)ER; (void)UB; (void)QB; (void)KB; (void)VB; (void)MB; (void)MG; (void)ACT; (void)SS2; (void)SSE; (void)SSO;
        TID_LANE();
        { SRes2Eraw Es{RA, ER, SSE}; skinny_gemm2<FFH, PLE>(lds, ACT + (size_t)MPR * FFH, (const bf16_t*)(ws + WS_WFO), (const bf16_t*)(ws + WS_PB) + (size_t)MPR * PLE, (const bf16_t*)(ws + WS_WPP), wave, lane, Es); }
        StaticOrder S; S.init(MPR, 1024, G, c);
        { Gemm g{ACT, (const bf16_t*)(ws + WS_WFO), MPR, 1024, FFH}; EpiRes2 E{RA}; gemm_phase<EpiRes2, StaticOrder, true, true, FFH>(lds, g, S, E, wave); }
    }
    SEAM(6);
    if (IN(7)) {
        unsigned char* ws = karg_ws();
        bf16_t* RA = (bf16_t*)(ws + WS_RA); bf16_t* GB = (bf16_t*)(ws + WS_RG); bf16_t* ER = (bf16_t*)(ws + WS_RG);
        bf16_t* UB = (bf16_t*)(ws + WS_UB); bf16_t* QB = (bf16_t*)(ws + WS_QB); bf16_t* KB = (bf16_t*)(ws + WS_KB); bf16_t* VB = (bf16_t*)(ws + WS_VB);
        bf16_t* MB = (bf16_t*)(ws + WS_MB); bf16_t* MG = (bf16_t*)(ws + WS_MG); bf16_t* ACT = (bf16_t*)(ws + WS_ACT);
        float* SS2 = (float*)(ws + WS_SS2); float* SSE = (float*)(ws + WS_SSE); float* SSO = (float*)(ws + WS_SSO);
        (void)RA; (void)GB; (void)ER; (void)UB; (void)QB; (void)KB; (void)VB; (void)MB; (void)MG; (void)ACT; (void)SS2; (void)SSE; (void)SSO;
        TID_LANE();
        { SPle Es{ACT, RA, ER, SSE, karg_in(19), SSO}; skinny_gemm<1024>(lds, RA + (size_t)MPR * DM, (const bf16_t*)(ws + WS_WPG), wave, lane, Es); }
        Gemm g{RA, (const bf16_t*)(ws + WS_WPG), MPR, 1024, 1024}; StaticOrder S; S.init(MPR, 1024, G, c);
        EpiPle E{ACT, RA, ER, SSE, karg_in(19), SSO};
        gemm_phase<EpiPle, StaticOrder, true, true, 1024>(lds, g, S, E, wave);
    }
    SEAM(7);
    if (IN(8)) {
        TID_LANE();
        unsigned char* ws = karg_ws();
        bf16_t* RA = (bf16_t*)(ws + WS_RA); bf16_t* GB = (bf16_t*)(ws + WS_RG); bf16_t* ER = (bf16_t*)(ws + WS_RG);
        bf16_t* UB = (bf16_t*)(ws + WS_UB); bf16_t* QB = (bf16_t*)(ws + WS_QB); bf16_t* KB = (bf16_t*)(ws + WS_KB); bf16_t* VB = (bf16_t*)(ws + WS_VB);
        bf16_t* MB = (bf16_t*)(ws + WS_MB); bf16_t* MG = (bf16_t*)(ws + WS_MG); bf16_t* ACT = (bf16_t*)(ws + WS_ACT);
        float* SS2 = (float*)(ws + WS_SS2); float* SSE = (float*)(ws + WS_SSE); float* SSO = (float*)(ws + WS_SSO);
        (void)RA; (void)GB; (void)ER; (void)UB; (void)QB; (void)KB; (void)VB; (void)MB; (void)MG; (void)ACT; (void)SS2; (void)SSE; (void)SSO;
        const float* fn = karg_in(21); float* const out_ = karg_out();
        f32x4 f0[2], f1[2];
#pragma unroll
        for (int hh = 0; hh < 2; ++hh) { f0[hh] = *(const f32x4*)(fn + hh * 512 + lane * 8); f1[hh] = *(const f32x4*)(fn + hh * 512 + lane * 8 + 4); }
        const int gw8 = c * 8 + wave; int mx = gw8 < MSM ? MPR + gw8 : -1;
        for (int m = gw8 * 2; m < MPR || mx >= 0; m += G * 16) {
            const bool hp = m < MPR; u32x4 w[3][2]; int rr[3]; rr[0] = hp ? m : -1; rr[1] = hp ? m + 1 : -1; rr[2] = mx; mx = -1;
#pragma unroll
            for (int r = 0; r < 3; ++r)
#pragma unroll
                for (int hh = 0; hh < 2; ++hh) if (rr[r] >= 0) w[r][hh] = *(const u32x4*)(ACT + (size_t)rr[r] * DM + hh * 512 + lane * 8);
#pragma unroll
            for (int r = 0; r < 3; ++r) if (rr[r] >= 0) { const float rs = row_rs(SSO, rr[r]);
#pragma unroll
                for (int hh = 0; hh < 2; ++hh) { f32x4 v0, v1; unpack8(w[r][hh], v0, v1); float* yp = out_ + (size_t)rr[r] * DM + hh * 512 + lane * 8;
                    __builtin_nontemporal_store(v0 * rs * f0[hh], (f32x4*)yp); __builtin_nontemporal_store(v1 * rs * f1[hh], (f32x4*)(yp + 4)); } }
        }
        for (int r = gw8 + G * 8; r < MSM; r += G * 8) { const int row = MPR + r; const float rs = row_rs(SSO, row);
#pragma unroll
            for (int hh = 0; hh < 2; ++hh) { f32x4 v0, v1; unpack8(*(const u32x4*)(ACT + (size_t)row * DM + hh * 512 + lane * 8), v0, v1); float* yp = out_ + (size_t)row * DM + hh * 512 + lane * 8;
                *(f32x4*)yp = v0 * rs * f0[hh]; *(f32x4*)(yp + 4) = v1 * rs * f1[hh]; } }
    }
#undef IN
#undef SEAM
}

extern "C" void kernel_launch(void* const* d_in, const int* in_sizes, int n_in, void* d_out, int out_size, void* d_ws, size_t ws_size, hipStream_t stream) {
    static int grid = 0;
    if (grid == 0) {
        if (n_in != 22 || out_size != (int)O_END || ws_size < WS_END) { fprintf(stderr, "kernel_launch: unexpected sizes: n_in %d out %d ws %zu (need %zu)\n", n_in, out_size, ws_size, (size_t)WS_END); grid = -1; return; }
        int dev = 0, cus = 0, per_cu = 0;
        hipGetDevice(&dev); hipDeviceGetAttribute(&cus, hipDeviceAttributeMultiprocessorCount, dev);
        if (hipFuncSetAttribute((const void*)fwd_kernel, hipFuncAttributeMaxDynamicSharedMemorySize, LDS_BYTES) != hipSuccess) { fprintf(stderr, "kernel_launch: hipFuncSetAttribute failed\n"); grid = -1; return; }
        if (hipOccupancyMaxActiveBlocksPerMultiprocessor(&per_cu, (const void*)fwd_kernel, 512, LDS_BYTES) != hipSuccess || per_cu < 1) { fprintf(stderr, "kernel_launch: occupancy query failed (%d)\n", per_cu); grid = -1; return; }
        grid = cus * per_cu;
        fprintf(stderr, "kernel_launch: cus %d per_cu %d grid %d\n", cus, per_cu, grid);
    }
    if (grid < 0) return;
    Args a{};
    for (int i = 0; i < 22; ++i) a.in[i] = (const float*)d_in[i];
    a.out = (float*)d_out; a.ws = (unsigned char*)d_ws;
#if N_LAUNCH == 1
    if (hipMemsetAsync((char*)d_ws + WS_BAR, 0, BAR_BYTES, stream) != hipSuccess) { fprintf(stderr, "kernel_launch: memset failed\n"); return; }
    a.ph_lo = 0; a.ph_hi = NPHASE;
    void* args[] = {&a};
    hipError_t e = hipLaunchCooperativeKernel((const void*)fwd_kernel, dim3(grid), dim3(512), args, LDS_BYTES, stream);
    if (e != hipSuccess) fprintf(stderr, "cooperative launch failed: %s (grid %d)\n", hipGetErrorString(e), grid);
#else
    for (int p = 0; p < NPHASE; ++p) { a.ph_lo = p; a.ph_hi = p + 1; hipLaunchKernelGGL(fwd_kernel, dim3(grid), dim3(512), LDS_BYTES, stream, a); }
#endif
}
```
